# Optimizing an MI355X kernel written in HIP

```python
import jax, jax.numpy as jnp
from jax import lax
import numpy as np

D_MODEL = 1024
BATCH = 8
SEQ = 2048
DEPTH = 2
DEC_BATCH = 128
DEC_SEQ = 4
PAST_LEN = 16384
PAGE_SIZE = 128

D_MIX = D_MODEL
D_RWKV = D_MIX // 2
HEAD_DIM = 64
N_HEADS_R = D_RWKV // HEAD_DIM
D_CONV = D_MIX - D_RWKV
N_CONV_GROUPS = 8
CONV_W = 31
LORA_W = 64
LORA_A = 64
P_RWKV = 4 * D_RWKV + LORA_W + LORA_A
P_CONV = 3 * D_CONV
P_IN = P_RWKV + P_CONV
RMS_EPS = 1e-6
RWKV_GN_EPS = 64e-5
CONV_GN_EPS = 1e-5

kernel_name = "hymba_rwkv7_conformer_conv_decode_step"


def _rms_norm(x, g):
    xf = x.astype(jnp.float32)
    y = xf * lax.rsqrt(jnp.mean(jnp.square(xf), axis=-1, keepdims=True) + RMS_EPS)
    return (y * g.astype(jnp.float32)).astype(x.dtype)


def _group_norm(x, n_groups, g, b, eps):
    xf = x.astype(jnp.float32)
    xg = xf.reshape(xf.shape[:-1] + (n_groups, xf.shape[-1] // n_groups))
    mean = jnp.mean(xg, axis=-1, keepdims=True)
    var = jnp.mean(jnp.square(xg - mean), axis=-1, keepdims=True)
    y = ((xg - mean) * lax.rsqrt(var + eps)).reshape(xf.shape)
    return y * g.astype(jnp.float32) + b.astype(jnp.float32)


def _heads(t):
    return t.reshape(t.shape[:-1] + (N_HEADS_R, HEAD_DIM))


def _wkv7(S0, r, decay, k, v, kk, a):
    def step(S, inp):
        r_t, w_t, k_t, v_t, kk_t, a_t = inp
        Sk = jnp.einsum('bhvk,bhk->bhv', S, kk_t)
        S = (S * w_t[:, :, None, :]
             - Sk[..., None] * (kk_t * a_t)[:, :, None, :]
             + v_t[..., None] * k_t[:, :, None, :])
        y_t = jnp.einsum('bhvk,bhk->bhv', S, r_t)
        return S, y_t
    xs = tuple(jnp.moveaxis(t, 1, 0) for t in (r, decay, k, v, kk, a))
    S, y = lax.scan(step, S0, xs)
    return jnp.moveaxis(y, 0, 1), S


def _layer(x, c, s_shift, s_wkv, s_conv,
           w_ada, b_ada, g_pre, g_post, w_in, mu, w0, w_up, a0, a_up, k_k, k_a, r_k,
           gn_r_g, gn_r_b, w_dw, b_dw, gn_c_g, gn_c_b, w_out):
    dt = x.dtype
    B, T, _ = x.shape
    mod = jax.nn.silu(c) @ w_ada + b_ada
    shift, scale, gate = jnp.split(mod, 3, axis=-1)
    h = _rms_norm(x, g_pre) * (1 + scale[:, None]) + shift[:, None]
    u = h @ w_in
    u_r, u_c = u[..., :P_RWKV], u[..., P_RWKV:]

    u_prev0 = s_shift.astype(dt) @ w_in[:, :P_RWKV]
    u_prev = jnp.concatenate([u_prev0[:, None], u_r[:, :-1]], axis=1)
    u_r = u_r + (u_prev - u_r) * mu
    r = u_r[..., 0 * D_RWKV:1 * D_RWKV]
    k = u_r[..., 1 * D_RWKV:2 * D_RWKV]
    v = u_r[..., 2 * D_RWKV:3 * D_RWKV]
    g_r = u_r[..., 3 * D_RWKV:4 * D_RWKV]
    w_lo = u_r[..., 4 * D_RWKV:4 * D_RWKV + LORA_W]
    a_lo = u_r[..., 4 * D_RWKV + LORA_W:]
    w_log = -jax.nn.softplus(-(w0 + jnp.tanh(w_lo) @ w_up).astype(jnp.float32)) - 0.5
    decay = jnp.exp(-jnp.exp(w_log))
    a = jax.nn.sigmoid((a0 + a_lo @ a_up).astype(jnp.float32))
    kf = k.astype(jnp.float32)
    kk = _heads(kf * k_k.astype(jnp.float32))
    kk = kk / jnp.maximum(jnp.sqrt(jnp.sum(jnp.square(kk), axis=-1, keepdims=True)), 1e-12)
    k_mod = kf * (1 + (a - 1) * k_a.astype(jnp.float32))
    rh = _heads(r.astype(jnp.float32))
    kh = _heads(k_mod)
    vh = _heads(v.astype(jnp.float32))
    y, S_new = _wkv7(s_wkv.astype(jnp.float32), rh, _heads(decay), kh, vh, kk, _heads(a))
    y = _group_norm(y.reshape(B, T, D_RWKV), N_HEADS_R, gn_r_g, gn_r_b, RWKV_GN_EPS)
    bonus = jnp.sum(rh * kh * r_k.astype(jnp.float32), axis=-1, keepdims=True) * vh
    y_r = (y + bonus.reshape(B, T, D_RWKV)) * jax.nn.silu(g_r.astype(jnp.float32))

    glu_a = u_c[..., :D_CONV]
    glu_b = u_c[..., D_CONV:2 * D_CONV]
    g_c = u_c[..., 2 * D_CONV:]
    glu = glu_a * jax.nn.sigmoid(glu_b)
    buf = jnp.concatenate([s_conv.astype(dt), glu], axis=1)
    conv = lax.conv_general_dilated(
        buf, w_dw[:, None, :], window_strides=(1,), padding='VALID',
        dimension_numbers=('NWC', 'WIO', 'NWC'), feature_group_count=D_CONV) + b_dw
    y_c = jax.nn.silu(_group_norm(conv, N_CONV_GROUPS, gn_c_g, gn_c_b, CONV_GN_EPS)) \
        * jax.nn.silu(g_c.astype(jnp.float32))

    mix = jnp.concatenate([y_r, y_c], axis=-1).astype(dt) @ w_out
    x = x + gate[:, None] * _rms_norm(mix, g_post)
    return x, h[:, -1], S_new, buf[:, -(CONV_W - 1):]


def _trunk(x, c, st_shift, st_wkv, st_conv, layer_w):
    shifts, wkvs, convs = [], [], []
    for l in range(DEPTH):
        x, s1, s2, s3 = _layer(x, c, st_shift[l], st_wkv[l], st_conv[l],
                               *[p[l] for p in layer_w])
        shifts.append(s1)
        wkvs.append(s2)
        convs.append(s3)
    return x, jnp.stack(shifts), jnp.stack(wkvs), jnp.stack(convs)


def setup_inputs(seed: int = 0) -> dict:
    key = jax.random.key(seed)
    ks = jax.random.split(key, 32)
    f = jnp.float32
    nrm = lambda k, shape, s: jax.random.normal(k, shape, f) * s
    return {
        "x_prompt": nrm(ks[0], (BATCH, SEQ, D_MODEL), 1.0),
        "x_sample": nrm(ks[1], (DEC_BATCH, DEC_SEQ, D_MODEL), 1.0),
        "c_prompt": nrm(ks[2], (BATCH, D_MODEL), 1.0),
        "c_sample": nrm(ks[3], (DEC_BATCH, D_MODEL), 1.0),
        "state_shift": nrm(ks[4], (DEPTH, DEC_BATCH, D_MODEL), 1.0),
        "state_wkv": nrm(ks[5], (DEPTH, DEC_BATCH, N_HEADS_R, HEAD_DIM, HEAD_DIM), 0.1),
        "state_conv": nrm(ks[6], (DEPTH, DEC_BATCH, CONV_W - 1, D_CONV), 0.5),
        "w_ada": nrm(ks[7], (DEPTH, D_MODEL, 3 * D_MODEL), 0.5 * D_MODEL ** -0.5),
        "b_ada": nrm(ks[8], (DEPTH, 3 * D_MODEL), 0.01),
        "g_pre": 1.0 + nrm(ks[9], (DEPTH, D_MODEL), 0.01),
        "g_post": 1.0 + nrm(ks[10], (DEPTH, D_MODEL), 0.01),
        "w_in": nrm(ks[11], (DEPTH, D_MODEL, P_IN), D_MODEL ** -0.5),
        "mu": jax.random.uniform(ks[12], (DEPTH, P_RWKV), f),
        "w0": jax.random.uniform(ks[13], (DEPTH, D_RWKV), f, -4.0, 1.0),
        "w_up": nrm(ks[14], (DEPTH, LORA_W, D_RWKV), 0.5 * LORA_W ** -0.5),
        "a0": nrm(ks[15], (DEPTH, D_RWKV), 0.1),
        "a_up": nrm(ks[16], (DEPTH, LORA_A, D_RWKV), LORA_A ** -0.5),
        "k_k": 0.85 + nrm(ks[17], (DEPTH, D_RWKV), 0.02),
        "k_a": 1.0 + nrm(ks[18], (DEPTH, D_RWKV), 0.02),
        "r_k": nrm(ks[19], (DEPTH, N_HEADS_R, HEAD_DIM), 0.1),
        "gn_r_g": 1.0 + nrm(ks[20], (DEPTH, D_RWKV), 0.01),
        "gn_r_b": nrm(ks[21], (DEPTH, D_RWKV), 0.01),
        "w_dw": nrm(ks[22], (DEPTH, CONV_W, D_CONV), CONV_W ** -0.5),
        "b_dw": nrm(ks[23], (DEPTH, D_CONV), 0.01),
        "gn_c_g": 1.0 + nrm(ks[24], (DEPTH, D_CONV), 0.01),
        "gn_c_b": nrm(ks[25], (DEPTH, D_CONV), 0.01),
        "w_out": nrm(ks[26], (DEPTH, D_MIX, D_MODEL), D_MIX ** -0.5),
    }


def reference(x_prompt, x_sample, c_prompt, c_sample, state_shift, state_wkv, state_conv,
              w_ada, b_ada, g_pre, g_post, w_in, mu, w0, w_up, a0, a_up, k_k, k_a, r_k,
              gn_r_g, gn_r_b, w_dw, b_dw, gn_c_g, gn_c_b, w_out):
    layer_w = (w_ada, b_ada, g_pre, g_post, w_in, mu, w0, w_up, a0, a_up, k_k, k_a, r_k,
               gn_r_g, gn_r_b, w_dw, b_dw, gn_c_g, gn_c_b, w_out)
    B = x_prompt.shape[0]
    z_shift = jnp.zeros((DEPTH, B, D_MODEL), x_prompt.dtype)
    z_wkv = jnp.zeros((DEPTH, B, N_HEADS_R, HEAD_DIM, HEAD_DIM), jnp.float32)
    z_conv = jnp.zeros((DEPTH, B, CONV_W - 1, D_CONV), x_prompt.dtype)
    y_prompt, shift_p, wkv_p, conv_p = _trunk(x_prompt, c_prompt, z_shift, z_wkv, z_conv, layer_w)
    y_sample, shift_s, wkv_s, conv_s = _trunk(x_sample, c_sample, state_shift, state_wkv,
                                              state_conv, layer_w)
    return (y_prompt, y_sample, shift_p, wkv_p, conv_p, shift_s, wkv_s, conv_s)
```

```cpp
#include <hip/hip_runtime.h>
#include <hip/hip_cooperative_groups.h>
#include <cstdio>
namespace cg = cooperative_groups;

#ifndef MULTI_LAUNCH
#define MULTI_LAUNCH 1
#endif

typedef _Float16 hf;
typedef hf hf8 __attribute__((ext_vector_type(8)));
typedef hf hf4 __attribute__((ext_vector_type(4)));
typedef hf hf2 __attribute__((ext_vector_type(2)));
typedef float f32x4 __attribute__((ext_vector_type(4)));

constexpr int D = 1024;
constexpr int NTOKP = 16384, NTOKS = 512, NTOK = 16896, NSEQ = 136;
constexpr int PIN = 3712, PRW = 2176;
constexpr int MROWS = NTOK + 128;
constexpr int MPAD = 17152;
constexpr int NTHR = 512;
constexpr int GRID = 256;

constexpr size_t WS_WTIN = 0;
constexpr size_t WS_WTOUT = WS_WTIN + (size_t)2 * PIN * D * 2;
constexpr size_t WS_WUPT = WS_WTOUT + (size_t)2 * D * D * 2;
constexpr size_t WS_AUPT = WS_WUPT + (size_t)2 * 512 * 64 * 2;
constexpr size_t WS_MOD = WS_AUPT + (size_t)2 * 512 * 64 * 2;
constexpr size_t WS_H = WS_MOD + (size_t)NSEQ * 6144 * 4;
constexpr size_t WS_U = WS_H + (size_t)MPAD * D * 2;
constexpr size_t WS_EA = WS_U + (size_t)MROWS * PIN * 2;
constexpr size_t WS_MIX = WS_EA + (size_t)NTOK * D * 2;
constexpr size_t WS_END = WS_MIX + (size_t)NTOK * D * 2;

constexpr size_t O_Y = 0;
constexpr size_t O_SHIFT_P = (size_t)NTOK * D;
constexpr size_t O_WKV_P = O_SHIFT_P + 2 * 8 * 1024;
constexpr size_t O_CONV_P = O_WKV_P + (size_t)2 * 8 * 8 * 4096;
constexpr size_t O_SHIFT_S = O_CONV_P + (size_t)2 * 8 * 30 * 512;
constexpr size_t O_WKV_S = O_SHIFT_S + (size_t)2 * 128 * 1024;
constexpr size_t O_CONV_S = O_WKV_S + (size_t)2 * 128 * 8 * 4096;
constexpr size_t O_END = O_CONV_S + (size_t)2 * 128 * 30 * 512;

constexpr int LDS_BYTES = 112 * 1024;

struct Params {
    const float *x_prompt, *x_sample, *c_prompt, *c_sample, *state_shift, *state_wkv, *state_conv;
    const float *w_ada, *b_ada, *g_pre, *g_post, *w_in, *mu, *w0, *w_up, *a0, *a_up, *k_k, *k_a, *r_k;
    const float *gn_r_g, *gn_r_b, *w_dw, *b_dw, *gn_c_g, *gn_c_b, *w_out;
    float* out;
    unsigned char* ws;
};

__device__ __forceinline__ float wave_sum(float v) {
#pragma unroll
    for (int o = 32; o > 0; o >>= 1) v += __shfl_xor(v, o);
    return v;
}
template <int CTRL>
__device__ __forceinline__ float dpp_mov(float v) {
    return __builtin_bit_cast(float, __builtin_amdgcn_update_dpp(0, __builtin_bit_cast(int, v), CTRL, 0xf, 0xf, false));
}
__device__ __forceinline__ float row_allreduce16(float v) {
    v += dpp_mov<0x128>(v);
    v += dpp_mov<0x124>(v);
    v += dpp_mov<0x122>(v);
    v += dpp_mov<0x121>(v);
    return v;
}
__device__ __forceinline__ float sigm(float x) { return 1.f / (1.f + __expf(-x)); }
__device__ __forceinline__ float silu(float x) { return x / (1.f + __expf(-x)); }
__device__ __forceinline__ float tanh_fast(float x) { float t = __expf(2.f * x); return 1.f - 2.f / (t + 1.f); }

__device__ __forceinline__ int seq_of(int tk) { return tk < NTOKP ? (tk >> 11) : 8 + ((tk - NTOKP) >> 2); }
__device__ __forceinline__ bool is_last_tok(int tk) { return tk < NTOKP ? ((tk & 2047) == 2047) : (((tk - NTOKP) & 3) == 3); }
__device__ __forceinline__ int prev_row(int tk) {
    if (tk < NTOKP) return (tk & 2047) ? tk - 1 : -1;
    int s = tk - NTOKP;
    return (s & 3) ? tk - 1 : NTOK + (s >> 2);
}
__device__ __forceinline__ const float* x0_row(const Params& p, int tk) {
    return tk < NTOKP ? p.x_prompt + (size_t)tk * D : p.x_sample + (size_t)(tk - NTOKP) * D;
}

__device__ void p0_transpose(const float* __restrict__ W, int K, int N, hf* __restrict__ WT, int item, float* lds) {
    const int nb = N / 64;
    const int kb = item / nb, nbk = item % nb, k0 = kb * 64, n0 = nbk * 64;
    const int tid = threadIdx.x;
#pragma unroll
    for (int i = 0; i < 8; ++i) {
        int kk = (tid >> 6) + 8 * i, c = tid & 63;
        lds[kk * 65 + c] = W[(size_t)(k0 + kk) * N + n0 + c];
    }
    __syncthreads();
    const int n = tid >> 3, kc = (tid & 7) * 8;
    hf8 o;
#pragma unroll
    for (int j = 0; j < 8; ++j) o[j] = (hf)lds[(kc + j) * 65 + n];
    *(hf8*)(WT + (size_t)(n0 + n) * K + k0 + kc) = o;
    __syncthreads();
}

__device__ void p0_adaln(const Params& p, int item, unsigned char* smem) {
    hf* SC = (hf*)smem;
    hf* Wt = SC + 144 * 72;
    float* MOD = (float*)(p.ws + WS_MOD);
    const int gc0 = item * 32;
    const int l = gc0 / 3072, lc0 = gc0 % 3072;
    const float* W = p.w_ada + (size_t)l * 1024 * 3072;
    const int tid = threadIdx.x, lane = tid & 63, wave = tid >> 6;
    const int nt = wave & 1, mg = wave >> 1;
    const int mt0 = (mg == 0) ? 0 : (2 * mg + 1);
    const int nmt = (mg == 0) ? 3 : 2;
    f32x4 acc[3];
#pragma unroll
    for (int i = 0; i < 3; ++i) acc[i] = (f32x4){0.f, 0.f, 0.f, 0.f};
    for (int kt = 0; kt < 16; ++kt) {
        const int k0 = kt * 64;
        for (int i = 0; i < 17; ++i) {
            int e = tid + 512 * i, row = e >> 6, k = e & 63;
            const float* cr = row < 8 ? p.c_prompt + row * 1024 : p.c_sample + (row - 8) * 1024;
            SC[row * 72 + k] = (hf)silu(cr[k0 + k]);
        }
        { int row = 136 + (tid >> 6), k = tid & 63; SC[row * 72 + k] = (hf)0.f; }
#pragma unroll
        for (int i = 0; i < 4; ++i) {
            int e = tid + 512 * i, kk = e >> 5, n = e & 31;
            Wt[n * 72 + kk] = (hf)W[(size_t)(k0 + kk) * 3072 + lc0 + n];
        }
        __syncthreads();
#pragma unroll
        for (int ks = 0; ks < 2; ++ks) {
            hf8 bfrag = *(const hf8*)(Wt + (nt * 16 + (lane & 15)) * 72 + ks * 32 + (lane >> 4) * 8);
#pragma unroll
            for (int i = 0; i < 3; ++i) {
                if (i < nmt) {
                    hf8 afrag = *(const hf8*)(SC + ((mt0 + i) * 16 + (lane & 15)) * 72 + ks * 32 + (lane >> 4) * 8);
                    acc[i] = __builtin_amdgcn_mfma_f32_16x16x32_f16(bfrag, afrag, acc[i], 0, 0, 0);
                }
            }
        }
        __syncthreads();
    }
#pragma unroll
    for (int i = 0; i < 3; ++i) {
        if (i < nmt) {
            int row = (mt0 + i) * 16 + (lane & 15);
            if (row < NSEQ) {
#pragma unroll
                for (int j = 0; j < 4; ++j) {
                    int gc = gc0 + nt * 16 + (lane >> 4) * 4 + j;
                    MOD[(size_t)row * 6144 + gc] = acc[i][j] + p.b_ada[gc];
                }
            }
        }
    }
}

__device__ void phase0(const Params& p, unsigned char* smem) {
    constexpr int I_ADA = 192;
    constexpr int I_WIN = 16 * 58;
    constexpr int I_WOUT = 16 * 16;
    constexpr int I_LORA = 8;
    constexpr int NITEMS = I_ADA + 2 * (I_WIN + I_WOUT + 2 * I_LORA);
    for (int it = blockIdx.x; it < NITEMS; it += gridDim.x) {
        int r = it;
        if (r < I_ADA) { p0_adaln(p, r, smem); continue; }
        r -= I_ADA;
        const int l = r / (I_WIN + I_WOUT + 2 * I_LORA);
        r = r % (I_WIN + I_WOUT + 2 * I_LORA);
        float* lds = (float*)smem;
        if (r < I_WIN) { p0_transpose(p.w_in + (size_t)l * D * PIN, D, PIN, (hf*)(p.ws + WS_WTIN) + (size_t)l * PIN * D, r, lds); continue; }
        r -= I_WIN;
        if (r < I_WOUT) { p0_transpose(p.w_out + (size_t)l * D * D, D, D, (hf*)(p.ws + WS_WTOUT) + (size_t)l * D * D, r, lds); continue; }
        r -= I_WOUT;
        if (r < I_LORA) { p0_transpose(p.w_up + (size_t)l * 64 * 512, 64, 512, (hf*)(p.ws + WS_WUPT) + (size_t)l * 512 * 64, r, lds); continue; }
        r -= I_LORA;
        p0_transpose(p.a_up + (size_t)l * 64 * 512, 64, 512, (hf*)(p.ws + WS_AUPT) + (size_t)l * 512 * 64, r, lds);
    }
}

__device__ void phase1(const Params& p, int l) {
    const int lane = threadIdx.x & 63, wave = threadIdx.x >> 6;
    hf* H = (hf*)(p.ws + WS_H);
    const float* MOD = (const float*)(p.ws + WS_MOD);
    for (int tk = blockIdx.x * 8 + wave; tk < MROWS; tk += gridDim.x * 8) {
        if (tk >= NTOK) {
            const int bs = tk - NTOK;
            const float* s = p.state_shift + ((size_t)l * 128 + bs) * D;
#pragma unroll
            for (int j = 0; j < 4; ++j) {
                f32x4 v = *(const f32x4*)(s + 256 * j + 4 * lane);
                hf4 o = {(hf)v.x, (hf)v.y, (hf)v.z, (hf)v.w};
                *(hf4*)(H + (size_t)tk * D + 256 * j + 4 * lane) = o;
            }
            continue;
        }
        const int sq = seq_of(tk);
        const float* xr = x0_row(p, tk);
        f32x4 x[4];
#pragma unroll
        for (int j = 0; j < 4; ++j) x[j] = *(const f32x4*)(xr + 256 * j + 4 * lane);
        if (l == 1) {
            const hf* mo = (const hf*)(p.out + O_Y + (size_t)tk * D);
            f32x4 m[4];
            float ss = 0.f;
#pragma unroll
            for (int j = 0; j < 4; ++j) {
                hf4 t = *(const hf4*)(mo + 256 * j + 4 * lane);
                m[j] = (f32x4){(float)t.x, (float)t.y, (float)t.z, (float)t.w};
                ss += m[j].x * m[j].x + m[j].y * m[j].y + m[j].z * m[j].z + m[j].w * m[j].w;
            }
            const float rs = rsqrtf(wave_sum(ss) * (1.f / D) + 1e-6f);
#pragma unroll
            for (int j = 0; j < 4; ++j) {
                f32x4 gp = *(const f32x4*)(p.g_post + 256 * j + 4 * lane);
                f32x4 gt = *(const f32x4*)(MOD + (size_t)sq * 6144 + 2048 + 256 * j + 4 * lane);
                x[j] = x[j] + gt * (m[j] * rs * gp);
            }
        }
        float ss = 0.f;
#pragma unroll
        for (int j = 0; j < 4; ++j) ss += x[j].x * x[j].x + x[j].y * x[j].y + x[j].z * x[j].z + x[j].w * x[j].w;
        const float rs = rsqrtf(wave_sum(ss) * (1.f / D) + 1e-6f);
        const bool last = is_last_tok(tk);
        float* so = nullptr;
        if (last) so = (sq < 8) ? p.out + O_SHIFT_P + ((size_t)l * 8 + sq) * D : p.out + O_SHIFT_S + ((size_t)l * 128 + (sq - 8)) * D;
#pragma unroll
        for (int j = 0; j < 4; ++j) {
            f32x4 g = *(const f32x4*)(p.g_pre + (size_t)l * D + 256 * j + 4 * lane);
            f32x4 sh = *(const f32x4*)(MOD + (size_t)sq * 6144 + l * 3072 + 256 * j + 4 * lane);
            f32x4 sc = *(const f32x4*)(MOD + (size_t)sq * 6144 + l * 3072 + 1024 + 256 * j + 4 * lane);
            f32x4 h = (x[j] * rs * g) * (1.f + sc) + sh;
            hf4 o = {(hf)h.x, (hf)h.y, (hf)h.z, (hf)h.w};
            *(hf4*)(H + (size_t)tk * D + 256 * j + 4 * lane) = o;
            if (last) *(f32x4*)(so + 256 * j + 4 * lane) = h;
        }
    }
}

constexpr int G_BM = 256, G_BN = 128, G_BK = 64, G_LD = 72;
constexpr int G_ASZ = G_BM * G_LD, G_BSZ = G_BN * G_LD;
template <int EPI>
__device__ void gemm_tile(const hf* __restrict__ A, const hf* __restrict__ Bt, hf* __restrict__ C, int m0, int n0, int mlimit, int ldc, unsigned char* smem) {
    hf* As = (hf*)smem;
    hf* Bs = As + 2 * G_ASZ;
    const int tid = threadIdx.x, lane = tid & 63, wave = tid >> 6;
    const int wm = wave >> 1, wn = wave & 1;
    const int fr = lane & 15, fq = lane >> 4;
    f32x4 acc[4][4];
#pragma unroll
    for (int i = 0; i < 4; ++i)
#pragma unroll
        for (int j = 0; j < 4; ++j) acc[i][j] = (f32x4){0.f, 0.f, 0.f, 0.f};
    hf8 ra[4], rb[2];
    const int lrow = tid >> 3, lkc = (tid & 7) * 8;
    auto gload = [&](int kt) {
#pragma unroll
        for (int i = 0; i < 4; ++i) ra[i] = *(const hf8*)(A + (size_t)(m0 + lrow + 64 * i) * D + kt * G_BK + lkc);
#pragma unroll
        for (int i = 0; i < 2; ++i) rb[i] = *(const hf8*)(Bt + (size_t)(n0 + lrow + 64 * i) * D + kt * G_BK + lkc);
    };
    auto lstore = [&](int buf) {
#pragma unroll
        for (int i = 0; i < 4; ++i) *(hf8*)(As + buf * G_ASZ + (lrow + 64 * i) * G_LD + lkc) = ra[i];
#pragma unroll
        for (int i = 0; i < 2; ++i) *(hf8*)(Bs + buf * G_BSZ + (lrow + 64 * i) * G_LD + lkc) = rb[i];
    };
    gload(0);
    lstore(0);
    __syncthreads();
    constexpr int NKT = D / G_BK;
    for (int kt = 0; kt < NKT; ++kt) {
        const int buf = kt & 1;
        if (kt + 1 < NKT) gload(kt + 1);
        const hf* as = As + buf * G_ASZ + (wm * 64 + fr) * G_LD + fq * 8;
        const hf* bs = Bs + buf * G_BSZ + (wn * 64 + fr) * G_LD + fq * 8;
#pragma unroll
        for (int ks = 0; ks < 2; ++ks) {
            hf8 af[4], bf[4];
#pragma unroll
            for (int i = 0; i < 4; ++i) af[i] = *(const hf8*)(as + i * 16 * G_LD + ks * 32);
#pragma unroll
            for (int i = 0; i < 4; ++i) bf[i] = *(const hf8*)(bs + i * 16 * G_LD + ks * 32);
#pragma unroll
            for (int i = 0; i < 4; ++i)
#pragma unroll
                for (int j = 0; j < 4; ++j)
                    acc[i][j] = __builtin_amdgcn_mfma_f32_16x16x32_f16(bf[j], af[i], acc[i][j], 0, 0, 0);
        }
        if (kt + 1 < NKT) lstore(buf ^ 1);
        __syncthreads();
    }
#pragma unroll
    for (int i = 0; i < 4; ++i) {
        const int row = m0 + wm * 64 + i * 16 + fr;
        if (row < mlimit) {
#pragma unroll
            for (int j = 0; j < 4; ++j) {
                const int col = n0 + wn * 64 + j * 16 + fq * 4;
                hf4 o = {(hf)acc[i][j][0], (hf)acc[i][j][1], (hf)acc[i][j][2], (hf)acc[i][j][3]};
                *(hf4*)(C + (size_t)row * ldc + col) = o;
            }
        }
    }
}

__device__ void phase2(const Params& p, int l, unsigned char* smem) {
    const hf* A = (const hf*)(p.ws + WS_H);
    const hf* Bt = (const hf*)(p.ws + WS_WTIN) + (size_t)l * PIN * D;
    hf* U = (hf*)(p.ws + WS_U);
    constexpr int NMT = MPAD / G_BM, NNT = PIN / G_BN;
    for (int t = blockIdx.x; t < NMT * NNT; t += gridDim.x) {
        const int mt = t / NNT, nt = t % NNT;
        gemm_tile<0>(A, Bt, U, mt * G_BM, nt * G_BN, MROWS, PIN, smem);
    }
}
__device__ void phase5b(const Params& p, int l, unsigned char* smem) {
    const hf* A = (const hf*)(p.ws + WS_MIX);
    const hf* Bt = (const hf*)(p.ws + WS_WTOUT) + (size_t)l * D * D;
    hf* C = (hf*)(p.out + O_Y) + l * 1024;
    constexpr int NMT = NTOK / G_BM, NNT = D / G_BN;
    for (int t = blockIdx.x; t < NMT * NNT; t += gridDim.x) {
        const int mt = t / NNT, nt = t % NNT;
        gemm_tile<1>(A, Bt, C, mt * G_BM, nt * G_BN, NTOK, 2048, smem);
    }
}

__device__ void p3_lora(const Params& p, int l, int item) {
    const int lane = threadIdx.x & 63, wave = threadIdx.x >> 6;
    const int fr = lane & 15, fq = lane >> 4;
    const hf* U = (const hf*)(p.ws + WS_U);
    hf* EA = (hf*)(p.ws + WS_EA);
    hf* KKB = (hf*)(p.ws + WS_H);
    const hf* WupT = (const hf*)(p.ws + WS_WUPT) + (size_t)l * 512 * 64;
    const hf* AupT = (const hf*)(p.ws + WS_AUPT) + (size_t)l * 512 * 64;
    const float* mu = p.mu + (size_t)l * PRW;
    const int tk0 = item * 128 + wave * 16;
    hf8 aw[2], aa[2];
    {
        const int tk = tk0 + fr, pr = prev_row(tk);
#pragma unroll
        for (int ks = 0; ks < 2; ++ks) {
            const int kb = ks * 32 + fq * 8;
            hf8 cw = *(const hf8*)(U + (size_t)tk * PIN + 2048 + kb);
            hf8 ca = *(const hf8*)(U + (size_t)tk * PIN + 2112 + kb);
            hf8 pw = {0, 0, 0, 0, 0, 0, 0, 0}, pa = {0, 0, 0, 0, 0, 0, 0, 0};
            if (pr >= 0) {
                pw = *(const hf8*)(U + (size_t)pr * PIN + 2048 + kb);
                pa = *(const hf8*)(U + (size_t)pr * PIN + 2112 + kb);
            }
#pragma unroll
            for (int j = 0; j < 8; ++j) {
                float c = (float)cw[j], q = (float)pw[j];
                float v = c + (q - c) * mu[2048 + kb + j];
                aw[ks][j] = (hf)tanh_fast(v);
                c = (float)ca[j]; q = (float)pa[j];
                v = c + (q - c) * mu[2112 + kb + j];
                aa[ks][j] = (hf)v;
            }
        }
    }
    int prw[4];
#pragma unroll
    for (int j = 0; j < 4; ++j) prw[j] = prev_row(tk0 + fq * 4 + j);
    for (int h = 0; h < 8; ++h) {
        float av[4][4], kv[4][4], ss[4] = {0.f, 0.f, 0.f, 0.f};
#pragma unroll
        for (int nt = 0; nt < 4; ++nt) {
            const int n0 = h * 64 + nt * 16;
            f32x4 cw = {0.f, 0.f, 0.f, 0.f}, ca = {0.f, 0.f, 0.f, 0.f};
#pragma unroll
            for (int ks = 0; ks < 2; ++ks) {
                hf8 bw = *(const hf8*)(WupT + (size_t)(n0 + fr) * 64 + ks * 32 + fq * 8);
                hf8 ba = *(const hf8*)(AupT + (size_t)(n0 + fr) * 64 + ks * 32 + fq * 8);
                cw = __builtin_amdgcn_mfma_f32_16x16x32_f16(aw[ks], bw, cw, 0, 0, 0);
                ca = __builtin_amdgcn_mfma_f32_16x16x32_f16(aa[ks], ba, ca, 0, 0, 0);
            }
            const int col = n0 + fr;
            const float w0c = p.w0[l * 512 + col], a0c = p.a0[l * 512 + col], kkc = p.k_k[l * 512 + col], muk = mu[512 + col];
#pragma unroll
            for (int j = 0; j < 4; ++j) {
                const int tk = tk0 + fq * 4 + j;
                const float e = 0.60653066f * sigm(w0c + cw[j]);
                const float a = sigm(a0c + ca[j]);
                EA[(size_t)tk * D + col] = (hf)e;
                EA[(size_t)tk * D + 512 + col] = (hf)a;
                float kc = (float)U[(size_t)tk * PIN + 512 + col];
                float kp = prw[j] >= 0 ? (float)U[(size_t)prw[j] * PIN + 512 + col] : 0.f;
                float k = kc + (kp - kc) * muk;
                float kkr = k * kkc;
                av[nt][j] = a;
                kv[nt][j] = kkr;
                ss[j] += kkr * kkr;
            }
        }
#pragma unroll
        for (int j = 0; j < 4; ++j) {
            float s = row_allreduce16(ss[j]);
            float inv = 1.f / fmaxf(sqrtf(s), 1e-12f);
            const int tk = tk0 + fq * 4 + j;
#pragma unroll
            for (int nt = 0; nt < 4; ++nt) {
                const int col = h * 64 + nt * 16 + fr;
                float kk = kv[nt][j] * inv;
                KKB[(size_t)tk * D + col] = (hf)kk;
                KKB[(size_t)tk * D + 512 + col] = (hf)(kk * av[nt][j]);
            }
        }
    }
}

template <int NT>
__device__ __forceinline__ void conv_taps(const float* G, const float* w, float bias, float* acc) {
#pragma unroll
    for (int i = 0; i < NT; ++i) acc[i] = bias;
#pragma unroll
    for (int r = 0; r < NT + 30; ++r) {
        const float g = G[r * 64];
#pragma unroll
        for (int i = 0; i < NT; ++i) {
            const int j = r - i;
            if (j >= 0 && j <= 30) acc[i] = fmaf(w[j], g, acc[i]);
        }
    }
}

__device__ void p3_conv_prompt(const Params& p, int l, int item, unsigned char* smem) {
    float* G = (float*)smem;
    const int g = item & 7, tt = (item >> 3) & 31, b = item >> 8;
    const int c0 = g * 64, t0 = tt * 64;
    const hf* U = (const hf*)(p.ws + WS_U);
    hf* MIX = (hf*)(p.ws + WS_MIX);
    const int tid = threadIdx.x;
    for (int e = tid; e < 94 * 32; e += NTHR) {
        const int r = e >> 5, cp = (e & 31) * 2;
        const int t = t0 - 30 + r;
        float g0 = 0.f, g1 = 0.f;
        if (t >= 0) {
            const hf* u = U + (size_t)(b * 2048 + t) * PIN + PRW + c0 + cp;
            hf2 ua = *(const hf2*)u, ub = *(const hf2*)(u + 512);
            g0 = (float)ua.x * sigm((float)ub.x);
            g1 = (float)ua.y * sigm((float)ub.y);
        }
        G[r * 64 + cp] = g0;
        G[r * 64 + cp + 1] = g1;
    }
    __syncthreads();
    const int c = tid & 63, tq = tid >> 6;
    const int ch = c0 + c;
    float w[31];
#pragma unroll
    for (int j = 0; j < 31; ++j) w[j] = p.w_dw[((size_t)l * 31 + j) * 512 + ch];
    float acc[8];
    conv_taps<8>(G + (tq * 8) * 64 + c, w, p.b_dw[l * 512 + ch], acc);
    const float gg = p.gn_c_g[l * 512 + ch], gb = p.gn_c_b[l * 512 + ch];
#pragma unroll
    for (int i = 0; i < 8; ++i) {
        const int tk = b * 2048 + t0 + tq * 8 + i;
        const float mean = wave_sum(acc[i]) * (1.f / 64.f);
        const float d = acc[i] - mean;
        const float var = wave_sum(d * d) * (1.f / 64.f);
        const float yn = d * rsqrtf(var + 1e-5f) * gg + gb;
        const float gc = (float)U[(size_t)tk * PIN + PRW + 1024 + ch];
        MIX[(size_t)tk * D + 512 + ch] = (hf)(silu(yn) * silu(gc));
    }
    if (tt == 31) {
        float* oc = p.out + O_CONV_P + ((size_t)l * 8 + b) * 30 * 512;
        for (int e = tid; e < 30 * 64; e += NTHR) {
            const int r = e >> 6, cc = e & 63;
            oc[(size_t)r * 512 + c0 + cc] = G[(64 + r) * 64 + cc];
        }
    }
    __syncthreads();
}

__device__ void p3_conv_sample(const Params& p, int l, int item, unsigned char* smem) {
    float* G = (float*)smem;
    const int g = item & 7, s0 = (item >> 3) * 4;
    const int c0 = g * 64;
    const hf* U = (const hf*)(p.ws + WS_U);
    hf* MIX = (hf*)(p.ws + WS_MIX);
    const int tid = threadIdx.x;
    for (int e = tid; e < 4 * 34 * 64; e += NTHR) {
        const int cc = e & 63, r = (e >> 6) % 34, sl = (e >> 6) / 34;
        const int bs = s0 + sl;
        float v;
        if (r < 30) v = p.state_conv[(((size_t)l * 128 + bs) * 30 + r) * 512 + c0 + cc];
        else {
            const hf* u = U + (size_t)(NTOKP + bs * 4 + (r - 30)) * PIN + PRW + c0 + cc;
            v = (float)u[0] * sigm((float)u[512]);
        }
        G[e] = v;
    }
    __syncthreads();
    const int c = tid & 63, wv = tid >> 6;
    const int sl = wv >> 1, tp = (wv & 1) * 2;
    const int ch = c0 + c, bs = s0 + sl;
    float w[31];
#pragma unroll
    for (int j = 0; j < 31; ++j) w[j] = p.w_dw[((size_t)l * 31 + j) * 512 + ch];
    float acc[2];
    conv_taps<2>(G + (sl * 34 + tp) * 64 + c, w, p.b_dw[l * 512 + ch], acc);
    const float gg = p.gn_c_g[l * 512 + ch], gb = p.gn_c_b[l * 512 + ch];
#pragma unroll
    for (int i = 0; i < 2; ++i) {
        const int tk = NTOKP + bs * 4 + tp + i;
        const float mean = wave_sum(acc[i]) * (1.f / 64.f);
        const float d = acc[i] - mean;
        const float var = wave_sum(d * d) * (1.f / 64.f);
        const float yn = d * rsqrtf(var + 1e-5f) * gg + gb;
        const float gc = (float)U[(size_t)tk * PIN + PRW + 1024 + ch];
        MIX[(size_t)tk * D + 512 + ch] = (hf)(silu(yn) * silu(gc));
    }
    for (int e = tid; e < 4 * 30 * 64; e += NTHR) {
        const int cc = e & 63, r = (e >> 6) % 30, s2 = (e >> 6) / 30;
        p.out[O_CONV_S + (((size_t)l * 128 + s0 + s2) * 30 + r) * 512 + c0 + cc] = G[(s2 * 34 + 4 + r) * 64 + cc];
    }
    __syncthreads();
}

__device__ void phase3(const Params& p, int l, unsigned char* smem) {
    constexpr int I_LORA = NTOK / 128;
    constexpr int I_CP = 8 * 32 * 8;
    constexpr int I_CS = 32 * 8;
    for (int it = blockIdx.x; it < I_LORA + I_CP + I_CS; it += gridDim.x) {
        int r = it;
        if (r < I_LORA) { p3_lora(p, l, r); continue; }
        r -= I_LORA;
        if (r < I_CP) { p3_conv_prompt(p, l, r, smem); continue; }
        r -= I_CP;
        p3_conv_sample(p, l, r, smem);
    }
}

constexpr int R_CH = 16;
__device__ void phase4(const Params& p, int l, unsigned char* smem) {
    float* OP = (float*)smem;
    float* VB = OP + 2 * R_CH * 5 * 64;
    const int tid = threadIdx.x, lane = tid & 63, wave = tid >> 6;
    const hf* U = (const hf*)(p.ws + WS_U);
    const hf* EA = (const hf*)(p.ws + WS_EA);
    const hf* KKB = (const hf*)(p.ws + WS_H);
    hf* MIX = (hf*)(p.ws + WS_MIX);
    const float* mu = p.mu + (size_t)l * PRW;
    const int blk = blockIdx.x;
    const int xcd = blk & 7, idx = blk >> 3;
    const int rg = idx & 3;
    const int pbh = xcd * 8 + (idx >> 2);
    const int pb = pbh >> 3, ph = pbh & 7;
    constexpr int NCHP = 2048 / R_CH;
    constexpr int NCH = NCHP + 16;
    auto chunk_tk = [&](int ci) { if (ci < NCHP) return pb * 2048 + ci * R_CH; int id = ((ci - NCHP) * 8 + (idx >> 2)) * 8 + xcd; return NTOKP + (id >> 3) * 4; };
    auto chunk_h = [&](int ci) { if (ci < NCHP) return ph; int id = ((ci - NCHP) * 8 + (idx >> 2)) * 8 + xcd; return id & 7; };
    auto chunk_bs = [&](int ci) { int id = ((ci - NCHP) * 8 + (idx >> 2)) * 8 + xcd; return id >> 3; };

    auto produce = [&](int ci, int buf) {
        const int pw = wave - 4;
        const int tkb = chunk_tk(ci), h = chunk_h(ci);
        const int nt = ci < NCHP ? R_CH : 4;
        const int col = h * 64 + lane;
        const float mur = mu[col], muk = mu[512 + col], muv = mu[1024 + col], ka = p.k_a[l * 512 + col];
        float* op = OP + buf * (R_CH * 5 * 64);
        float* vb = VB + buf * (R_CH * 16);
#pragma unroll
        for (int i = 0; i < 4; ++i) {
            const int t = pw + 4 * i;
            if (t < nt) {
                const int tk = tkb + t, pr = prev_row(tk);
                const hf* ut = U + (size_t)tk * PIN + col;
                float rc = (float)ut[0], kc = (float)ut[512], vc = (float)ut[1024];
                float rp = 0.f, kp = 0.f, vp = 0.f;
                if (pr >= 0) { const hf* up = U + (size_t)pr * PIN + col; rp = (float)up[0]; kp = (float)up[512]; vp = (float)up[1024]; }
                const float e = (float)EA[(size_t)tk * D + col], a = (float)EA[(size_t)tk * D + 512 + col];
                const float kk = (float)KKB[(size_t)tk * D + col], bb = (float)KKB[(size_t)tk * D + 512 + col];
                const float r = rc + (rp - rc) * mur, k = kc + (kp - kc) * muk, v = vc + (vp - vc) * muv;
                op[(t * 5 + 0) * 64 + lane] = r;
                op[(t * 5 + 1) * 64 + lane] = __expf(-e);
                op[(t * 5 + 2) * 64 + lane] = k * (1.f + (a - 1.f) * ka);
                op[(t * 5 + 3) * 64 + lane] = kk;
                op[(t * 5 + 4) * 64 + lane] = bb;
                if ((lane >> 4) == rg) vb[t * 16 + (lane & 15)] = v;
            }
        }
    };

    const int rl = lane >> 4, ks = lane & 15;
    const int srow = rg * 16 + (wave & 3) * 4 + rl;
    f32x4 S = {0.f, 0.f, 0.f, 0.f}, Snext = {0.f, 0.f, 0.f, 0.f};
    if (wave >= 4) produce(0, 0);
    __syncthreads();
    for (int ci = 0; ci < NCH; ++ci) {
        const int buf = ci & 1;
        if (wave >= 4) {
            if (ci + 1 < NCH) produce(ci + 1, buf ^ 1);
        } else {
            if (ci + 1 >= NCHP && ci + 1 < NCH) {
                const int bs = chunk_bs(ci + 1), h = chunk_h(ci + 1);
                Snext = *(const f32x4*)(p.state_wkv + ((((size_t)l * 128 + bs) * 8 + h) * 64 + srow) * 64 + ks * 4);
            }
            if (ci == 0) S = (f32x4){0.f, 0.f, 0.f, 0.f};
            const int tkb = chunk_tk(ci), h = chunk_h(ci);
            const int nt = ci < NCHP ? R_CH : 4;
            const float* op = OP + buf * (R_CH * 5 * 64) + ks * 4;
            const float* vb = VB + buf * (R_CH * 16) + (wave & 3) * 4 + rl;
            hf* yo = MIX + (size_t)tkb * D + h * 64 + srow;
#pragma unroll 4
            for (int t = 0; t < nt; ++t) {
                const f32x4 r4 = *(const f32x4*)(op + (t * 5 + 0) * 64);
                const f32x4 w4 = *(const f32x4*)(op + (t * 5 + 1) * 64);
                const f32x4 m4 = *(const f32x4*)(op + (t * 5 + 2) * 64);
                const f32x4 k4 = *(const f32x4*)(op + (t * 5 + 3) * 64);
                const f32x4 b4 = *(const f32x4*)(op + (t * 5 + 4) * 64);
                const float v = vb[t * 16];
                float sk = S.x * k4.x + S.y * k4.y + S.z * k4.z + S.w * k4.w;
                sk = row_allreduce16(sk);
                S.x = fmaf(v, m4.x, fmaf(-sk, b4.x, S.x * w4.x));
                S.y = fmaf(v, m4.y, fmaf(-sk, b4.y, S.y * w4.y));
                S.z = fmaf(v, m4.z, fmaf(-sk, b4.z, S.z * w4.z));
                S.w = fmaf(v, m4.w, fmaf(-sk, b4.w, S.w * w4.w));
                float y = S.x * r4.x + S.y * r4.y + S.z * r4.z + S.w * r4.w;
                y = row_allreduce16(y);
                if (ks == 0) yo[(size_t)t * D] = (hf)y;
            }
            if (ci == NCHP - 1) {
                *(f32x4*)(p.out + O_WKV_P + ((((size_t)l * 8 + pb) * 8 + ph) * 64 + srow) * 64 + ks * 4) = S;
            } else if (ci >= NCHP) {
                const int bs = chunk_bs(ci);
                *(f32x4*)(p.out + O_WKV_S + ((((size_t)l * 128 + bs) * 8 + h) * 64 + srow) * 64 + ks * 4) = S;
            }
            if (ci + 1 >= NCHP) S = Snext;
        }
        __syncthreads();
    }
}

__device__ void phase5a(const Params& p, int l) {
    const int lane = threadIdx.x & 63, wave = threadIdx.x >> 6;
    const hf* U = (const hf*)(p.ws + WS_U);
    const hf* EA = (const hf*)(p.ws + WS_EA);
    hf* MIX = (hf*)(p.ws + WS_MIX);
    const float* mu = p.mu + (size_t)l * PRW;
    for (int it = blockIdx.x * 8 + wave; it < NTOK * 8; it += gridDim.x * 8) {
        const int tk = it >> 3, h = it & 7;
        const int col = h * 64 + lane;
        const int pr = prev_row(tk);
        const hf* ut = U + (size_t)tk * PIN + col;
        float rc = (float)ut[0], kc = (float)ut[512], vc = (float)ut[1024], gc = (float)ut[1536];
        float rp = 0.f, kp = 0.f, vp = 0.f, gp = 0.f;
        if (pr >= 0) { const hf* up = U + (size_t)pr * PIN + col; rp = (float)up[0]; kp = (float)up[512]; vp = (float)up[1024]; gp = (float)up[1536]; }
        const float r = rc + (rp - rc) * mu[col], k = kc + (kp - kc) * mu[512 + col];
        const float v = vc + (vp - vc) * mu[1024 + col], g = gc + (gp - gc) * mu[1536 + col];
        const float a = (float)EA[(size_t)tk * D + 512 + col];
        const float km = k * (1.f + (a - 1.f) * p.k_a[l * 512 + col]);
        const float y = (float)MIX[(size_t)tk * D + col];
        const float mean = wave_sum(y) * (1.f / 64.f);
        const float d = y - mean;
        const float var = wave_sum(d * d) * (1.f / 64.f);
        const float yn = d * rsqrtf(var + 64e-5f) * p.gn_r_g[l * 512 + col] + p.gn_r_b[l * 512 + col];
        const float bon = wave_sum(r * km * p.r_k[l * 512 + col]) * v;
        MIX[(size_t)tk * D + col] = (hf)((yn + bon) * silu(g));
    }
}

__device__ void phase6(const Params& p) {
    const int lane = threadIdx.x & 63, wave = threadIdx.x >> 6;
    const float* MOD = (const float*)(p.ws + WS_MOD);
    for (int tk = blockIdx.x * 8 + wave; tk < NTOK; tk += gridDim.x * 8) {
        const int sq = seq_of(tk);
        const float* xr = x0_row(p, tk);
        float* yr = p.out + O_Y + (size_t)tk * D;
        const hf* mo = (const hf*)yr;
        f32x4 x[4], m0[4], m1[4];
        float s0 = 0.f, s1 = 0.f;
#pragma unroll
        for (int j = 0; j < 4; ++j) {
            x[j] = *(const f32x4*)(xr + 256 * j + 4 * lane);
            hf4 t0 = *(const hf4*)(mo + 256 * j + 4 * lane);
            hf4 t1 = *(const hf4*)(mo + 1024 + 256 * j + 4 * lane);
            m0[j] = (f32x4){(float)t0.x, (float)t0.y, (float)t0.z, (float)t0.w};
            m1[j] = (f32x4){(float)t1.x, (float)t1.y, (float)t1.z, (float)t1.w};
            s0 += m0[j].x * m0[j].x + m0[j].y * m0[j].y + m0[j].z * m0[j].z + m0[j].w * m0[j].w;
            s1 += m1[j].x * m1[j].x + m1[j].y * m1[j].y + m1[j].z * m1[j].z + m1[j].w * m1[j].w;
        }
        const float r0 = rsqrtf(wave_sum(s0) * (1.f / D) + 1e-6f);
        const float r1 = rsqrtf(wave_sum(s1) * (1.f / D) + 1e-6f);
#pragma unroll
        for (int j = 0; j < 4; ++j) {
            f32x4 gp0 = *(const f32x4*)(p.g_post + 256 * j + 4 * lane);
            f32x4 gp1 = *(const f32x4*)(p.g_post + D + 256 * j + 4 * lane);
            f32x4 gt0 = *(const f32x4*)(MOD + (size_t)sq * 6144 + 2048 + 256 * j + 4 * lane);
            f32x4 gt1 = *(const f32x4*)(MOD + (size_t)sq * 6144 + 3072 + 2048 + 256 * j + 4 * lane);
            f32x4 y = x[j] + gt0 * (m0[j] * r0 * gp0);
            y = y + gt1 * (m1[j] * r1 * gp1);
            *(f32x4*)(yr + 256 * j + 4 * lane) = y;
        }
    }
}

constexpr int NPHASES = 14;
__device__ __forceinline__ void run_phase(const Params& p, int ph, unsigned char* smem) {
    if (ph == 0) { phase0(p, smem); return; }
    if (ph == 13) { phase6(p); return; }
    const int l = (ph - 1) / 6, s = (ph - 1) % 6;
    switch (s) {
        case 0: phase1(p, l); break;
        case 1: phase2(p, l, smem); break;
        case 2: phase3(p, l, smem); break;
        case 3: phase4(p, l, smem); break;
        case 4: phase5a(p, l); break;
        default: phase5b(p, l, smem); break;
    }
}

__global__ void __launch_bounds__(NTHR) fwd_mega(Params p) {
    extern __shared__ __attribute__((aligned(16))) unsigned char smem[];
    cg::grid_group grid = cg::this_grid();
    phase0(p, smem); grid.sync();
    phase1(p, 0); grid.sync();
    phase2(p, 0, smem); grid.sync();
    phase3(p, 0, smem); grid.sync();
    phase4(p, 0, smem); grid.sync();
    phase5a(p, 0); grid.sync();
    phase5b(p, 0, smem); grid.sync();
    phase1(p, 1); grid.sync();
    phase2(p, 1, smem); grid.sync();
    phase3(p, 1, smem); grid.sync();
    phase4(p, 1, smem); grid.sync();
    phase5a(p, 1); grid.sync();
    phase5b(p, 1, smem); grid.sync();
    phase6(p);
}
__global__ void __launch_bounds__(NTHR) fwd_phase(Params p, int ph) {
    extern __shared__ __attribute__((aligned(16))) unsigned char smem[];
    run_phase(p, ph, smem);
}

extern "C" void kernel_launch(void* const* d_in, const int* in_sizes, int n_in, void* d_out, int out_size, void* d_ws, size_t ws_size,
                              hipStream_t stream) {
    static int ok = 0;
    if (ok == 0) {
        ok = 1;
        if (n_in != 27 || (size_t)out_size != O_END || ws_size < WS_END) {
            fprintf(stderr, "kernel_launch: unexpected sizes n_in %d out %d ws %zu (need %zu)\n", n_in, out_size, ws_size, (size_t)WS_END);
            ok = -1;
        }
        int dev = 0, cus = 0, per_cu = 0;
        (void)hipGetDevice(&dev);
        (void)hipDeviceGetAttribute(&cus, hipDeviceAttributeMultiprocessorCount, dev);
        (void)hipFuncSetAttribute((const void*)fwd_mega, hipFuncAttributeMaxDynamicSharedMemorySize, LDS_BYTES);
        (void)hipFuncSetAttribute((const void*)fwd_phase, hipFuncAttributeMaxDynamicSharedMemorySize, LDS_BYTES);
        (void)hipOccupancyMaxActiveBlocksPerMultiprocessor(&per_cu, (const void*)fwd_mega, NTHR, LDS_BYTES);
        if (cus * per_cu < GRID) {
            fprintf(stderr, "kernel_launch: resident capacity %d x %d < grid %d\n", cus, per_cu, GRID);
            ok = -1;
        }
    }
    if (ok < 0) return;
    Params p{};
    const float** pp = (const float**)&p;
    for (int i = 0; i < 27; ++i) pp[i] = (const float*)d_in[i];
    p.out = (float*)d_out;
    p.ws = (unsigned char*)d_ws;
#if MULTI_LAUNCH
    for (int ph = 0; ph < NPHASES; ++ph) hipLaunchKernelGGL(fwd_phase, dim3(GRID), dim3(NTHR), LDS_BYTES, stream, p, ph);
#else
    void* args[] = {&p};
    hipError_t e = hipLaunchCooperativeKernel((const void*)fwd_mega, dim3(GRID), dim3(NTHR), args, LDS_BYTES, stream);
    if (e != hipSuccess) fprintf(stderr, "cooperative launch failed: %s\n", hipGetErrorString(e));
#endif
}
```

```cpp
#include <hip/hip_runtime.h>
#include <hip/hip_cooperative_groups.h>
#include <cstdio>
namespace cg = cooperative_groups;

#ifndef MULTI_LAUNCH
#define MULTI_LAUNCH 0
#endif

typedef _Float16 hf;
typedef hf hf8 __attribute__((ext_vector_type(8)));
typedef hf hf4 __attribute__((ext_vector_type(4)));
typedef hf hf2 __attribute__((ext_vector_type(2)));
typedef float f32x4 __attribute__((ext_vector_type(4)));

constexpr int D = 1024;
constexpr int NTOKP = 16384, NTOKS = 512, NTOK = 16896, NSEQ = 136;
constexpr int PIN = 3712, PRW = 2176;
constexpr int MROWS = NTOK + 128;
constexpr int MPAD = 17152;
constexpr int NTHR = 512;
constexpr int GRID = 256;

constexpr int PINP = 3840;
constexpr size_t WS_WTIN = 0;
constexpr size_t WS_WTOUT = WS_WTIN + (size_t)2 * PINP * D * 2;
constexpr size_t WS_WUPT = WS_WTOUT + (size_t)2 * D * D * 2;
constexpr size_t WS_AUPT = WS_WUPT + (size_t)2 * 512 * 64 * 2;
constexpr size_t WS_MOD = WS_AUPT + (size_t)2 * 512 * 64 * 2;
constexpr size_t WS_H = WS_MOD + (size_t)NSEQ * 6144 * 4;
constexpr size_t WS_U = WS_H + (size_t)MPAD * D * 2;
constexpr size_t WS_EA = WS_U + (size_t)MROWS * PIN * 2;
constexpr size_t WS_MIX = WS_EA + (size_t)NTOK * D * 2;
constexpr size_t WS_BAR = WS_MIX + (size_t)NTOK * D * 2;
constexpr size_t WS_END = WS_BAR + 16384;

constexpr size_t O_Y = 0;
constexpr size_t O_SHIFT_P = (size_t)NTOK * D;
constexpr size_t O_WKV_P = O_SHIFT_P + 2 * 8 * 1024;
constexpr size_t O_CONV_P = O_WKV_P + (size_t)2 * 8 * 8 * 4096;
constexpr size_t O_SHIFT_S = O_CONV_P + (size_t)2 * 8 * 30 * 512;
constexpr size_t O_WKV_S = O_SHIFT_S + (size_t)2 * 128 * 1024;
constexpr size_t O_CONV_S = O_WKV_S + (size_t)2 * 128 * 8 * 4096;
constexpr size_t O_END = O_CONV_S + (size_t)2 * 128 * 30 * 512;

constexpr int LDS_BYTES = 132 * 1024;

struct Params {
    const float *x_prompt, *x_sample, *c_prompt, *c_sample, *state_shift, *state_wkv, *state_conv;
    const float *w_ada, *b_ada, *g_pre, *g_post, *w_in, *mu, *w0, *w_up, *a0, *a_up, *k_k, *k_a, *r_k;
    const float *gn_r_g, *gn_r_b, *w_dw, *b_dw, *gn_c_g, *gn_c_b, *w_out;
    float* out;
    unsigned char* ws;
};

typedef unsigned u32x2 __attribute__((ext_vector_type(2)));
typedef unsigned u32x4 __attribute__((ext_vector_type(4)));
__device__ __forceinline__ void st16_wt(void* p, u32x4 v) { asm volatile("global_store_dwordx4 %0, %1, off sc1\n\ts_nop 1" :: "v"(p), "v"(v) : "memory"); }
__device__ __forceinline__ int tid_() { int t = threadIdx.x; asm volatile("" : "+v"(t)); return t; }
template <int CTRL>
__device__ __forceinline__ float dpp_mov(float v) {
    return __builtin_bit_cast(float, __builtin_amdgcn_update_dpp(0, __builtin_bit_cast(int, v), CTRL, 0xf, 0xf, false));
}
__device__ __forceinline__ float row_allreduce16(float v) {
    v += dpp_mov<0x128>(v);
    v += dpp_mov<0x124>(v);
    v += dpp_mov<0x122>(v);
    v += dpp_mov<0x121>(v);
    return v;
}
__device__ __forceinline__ float wave_sum(float v) {
    v = row_allreduce16(v);
    v += __shfl_xor(v, 16);
    v += __shfl_xor(v, 32);
    return v;
}
__device__ __forceinline__ float wave_sum_all(float v) {
    v = row_allreduce16(v);
    v += __builtin_bit_cast(float, __builtin_amdgcn_update_dpp(0, __builtin_bit_cast(int, v), 0x142, 0xa, 0xf, false));
    v += __builtin_bit_cast(float, __builtin_amdgcn_update_dpp(0, __builtin_bit_cast(int, v), 0x143, 0xc, 0xf, false));
    return __builtin_bit_cast(float, __builtin_amdgcn_readlane(__builtin_bit_cast(int, v), 63));
}
__device__ __forceinline__ float sigm(float x) { return __builtin_amdgcn_rcpf(1.f + __expf(-x)); }
__device__ __forceinline__ float silu(float x) { return x * __builtin_amdgcn_rcpf(1.f + __expf(-x)); }
__device__ __forceinline__ float tanh_fast(float x) { float t = __expf(2.f * x); return 1.f - 2.f * __builtin_amdgcn_rcpf(t + 1.f); }

__device__ __forceinline__ int seq_of(int tk) { return tk < NTOKP ? (tk >> 11) : 8 + ((tk - NTOKP) >> 2); }
__device__ __forceinline__ bool is_last_tok(int tk) { return tk < NTOKP ? ((tk & 2047) == 2047) : (((tk - NTOKP) & 3) == 3); }
__device__ __forceinline__ int prev_row(int tk) {
    if (tk < NTOKP) return (tk & 2047) ? tk - 1 : -1;
    int s = tk - NTOKP;
    return (s & 3) ? tk - 1 : NTOK + (s >> 2);
}
__device__ __forceinline__ const float* x0_row(const Params& p, int tk) {
    return tk < NTOKP ? p.x_prompt + (size_t)tk * D : p.x_sample + (size_t)(tk - NTOKP) * D;
}


#define XB_TMO      128
#define XB_XCNT(j)  (256  + 64 * (j))
#define XB_XSUB(j)  (1280 + 64 * (j))
#define XB_XGEN(j)  (2304 + 64 * (j))
#define XB_TOP      3328
#define XB_TOPGEN   3392
#define XCD_BAR_WORDS 3456
#define XB_SPIN_CAP (1u << 22)
#define LAS __attribute__((address_space(3)))
__device__ __forceinline__ unsigned xb_ld(unsigned* p)              { return __hip_atomic_load(p, __ATOMIC_RELAXED, __HIP_MEMORY_SCOPE_AGENT); }
__device__ __forceinline__ unsigned xb_add(unsigned* p, unsigned v) { return __hip_atomic_fetch_add(p, v, __ATOMIC_RELAXED, __HIP_MEMORY_SCOPE_AGENT); }
__device__ __forceinline__ unsigned xb_xcc_id() { return (unsigned)__builtin_amdgcn_s_getreg((3 << 11) | 20) & 0xFu; }
#define XB_SPIN(cond, bar) do { unsigned _sp = 0; while (cond) { __builtin_amdgcn_s_sleep(1); \
    if ((++_sp & 255u) == 0u) { if (xb_ld(&(bar)[XB_TMO])) break; if (_sp > XB_SPIN_CAP) { atomicAdd(&(bar)[XB_TMO], 1u); break; } } } } while (0)
struct XcdBarrier { unsigned* bar; unsigned x; volatile LAS unsigned* st; };
__device__ __forceinline__ XcdBarrier xcd_barrier_post(unsigned* bar, volatile LAS unsigned* st) {
    XcdBarrier b; b.bar = bar; b.x = xb_xcc_id(); b.st = st;
    if (threadIdx.x == 0) (void)xb_add(&bar[XB_XCNT(b.x)], 1u);
    return b;
}
__device__ __forceinline__ void xcd_barrier_complete(unsigned* bar, unsigned x, unsigned& nloc, unsigned& nx) {
    const unsigned G = gridDim.x * gridDim.y * gridDim.z;
    unsigned sum, cnt, mine, sp = 0u;
    for (;;) {
        sum = 0u; cnt = 0u; mine = 0u;
#pragma unroll
        for (unsigned j = 0; j < 16; ++j) { const unsigned c = xb_ld(&bar[XB_XCNT(j)]); sum += c; cnt += (c > 0u) ? 1u : 0u; mine = (j == x) ? c : mine; }
        if (sum == G) break;
        __builtin_amdgcn_s_sleep(1);
        if ((++sp & 255u) == 0u) { if (xb_ld(&bar[XB_TMO])) break; if (sp > XB_SPIN_CAP) { atomicAdd(&bar[XB_TMO], 1u); break; } }
    }
    nloc = mine > 0u ? mine : 1u; nx = cnt > 0u ? cnt : 1u;
}
__device__ __forceinline__ void xcd_barrier(const XcdBarrier& b) {
    asm volatile("s_waitcnt vmcnt(0)" ::: "memory");
    __syncthreads();
    if (threadIdx.x == 0) {
        unsigned* bar = b.bar;
        __builtin_amdgcn_s_waitcnt(0);
        unsigned nloc = b.st[0], nx = b.st[1];
        if (nloc == 0u) { xcd_barrier_complete(bar, b.x, nloc, nx); b.st[0] = nloc; b.st[1] = nx; }
        const unsigned old = xb_add(&bar[XB_XSUB(b.x)], 1u);
        const unsigned gen = old / nloc;
        if (old + 1u == (gen + 1u) * nloc) {
            __builtin_amdgcn_fence(__ATOMIC_RELEASE, "agent");
            asm volatile("s_waitcnt vmcnt(0)" ::: "memory");
            const unsigned og = xb_add(&bar[XB_TOP], 1u);
            const unsigned tg = og / nx;
            if (og + 1u == (tg + 1u) * nx) xb_add(&bar[XB_TOPGEN], 1u);
            else XB_SPIN(xb_ld(&bar[XB_TOPGEN]) == tg, bar);
            __builtin_amdgcn_fence(__ATOMIC_ACQUIRE, "agent");
            xb_add(&bar[XB_XGEN(b.x)], 1u);
            asm volatile("s_waitcnt vmcnt(0)" ::: "memory");
        } else {
            XB_SPIN(xb_ld(&bar[XB_XGEN(b.x)]) == gen, bar);
            __builtin_amdgcn_fence(__ATOMIC_ACQUIRE, "agent");
            asm volatile("s_waitcnt vmcnt(0)" ::: "memory");
        }
    }
    __syncthreads();
}

__device__ __forceinline__ void p0_transpose(const float* __restrict__ W, int K, int N, hf* __restrict__ WT, int item, float* lds) {
    const int nb = N / 64;
    const int kb = item / nb, nbk = item % nb, k0 = kb * 64, n0 = nbk * 64;
    const int tid = tid_();
#pragma unroll
    for (int i = 0; i < 8; ++i) {
        int kk = (tid >> 6) + 8 * i, c = tid & 63;
        lds[kk * 65 + c] = W[(size_t)(k0 + kk) * N + n0 + c];
    }
    __syncthreads();
    const int n = tid >> 3, kc = (tid & 7) * 8;
    hf8 o;
#pragma unroll
    for (int j = 0; j < 8; ++j) o[j] = (hf)lds[(kc + j) * 65 + n];
    *(hf8*)(WT + (size_t)(n0 + n) * K + k0 + kc) = o;
    __syncthreads();
}

__device__ __forceinline__ void p0_adaln(const Params& p, int item, unsigned char* smem) {
    hf* SC = (hf*)smem;
    hf* Wt = SC + 144 * 72;
    float* MOD = (float*)(p.ws + WS_MOD);
    const int gc0 = item * 32;
    const int l = gc0 / 3072, lc0 = gc0 % 3072;
    const float* W = p.w_ada + (size_t)l * 1024 * 3072;
    const int tid = tid_(), lane = tid & 63, wave = tid >> 6;
    const int nt = wave & 1, mg = wave >> 1;
    const int mt0 = (mg == 0) ? 0 : (2 * mg + 1);
    const int nmt = (mg == 0) ? 3 : 2;
    f32x4 acc[3];
#pragma unroll
    for (int i = 0; i < 3; ++i) acc[i] = (f32x4){0.f, 0.f, 0.f, 0.f};
    float cv[17], wv[4];
    auto gload = [&](int kt) {
        const int k0 = kt * 64;
#pragma unroll
        for (int i = 0; i < 17; ++i) {
            const int e = tid + 512 * i, row = e >> 6, k = e & 63;
            const float* cr = row < 8 ? p.c_prompt + row * 1024 : p.c_sample + (row - 8) * 1024;
            cv[i] = cr[k0 + k];
        }
#pragma unroll
        for (int i = 0; i < 4; ++i) {
            const int e = tid + 512 * i, kk = e >> 5, n = e & 31;
            wv[i] = W[(size_t)(k0 + kk) * 3072 + lc0 + n];
        }
    };
    gload(0);
    { int row = 136 + (tid >> 6), k = tid & 63; SC[row * 72 + k] = (hf)0.f; }
    for (int kt = 0; kt < 16; ++kt) {
#pragma unroll
        for (int i = 0; i < 17; ++i) {
            const int e = tid + 512 * i, row = e >> 6, k = e & 63;
            SC[row * 72 + k] = (hf)silu(cv[i]);
        }
#pragma unroll
        for (int i = 0; i < 4; ++i) {
            const int e = tid + 512 * i, kk = e >> 5, n = e & 31;
            Wt[n * 72 + kk] = (hf)wv[i];
        }
        __syncthreads();
        if (kt + 1 < 16) gload(kt + 1);
#pragma unroll
        for (int ks = 0; ks < 2; ++ks) {
            hf8 bfrag = *(const hf8*)(Wt + (nt * 16 + (lane & 15)) * 72 + ks * 32 + (lane >> 4) * 8);
#pragma unroll
            for (int i = 0; i < 3; ++i) {
                if (i < nmt) {
                    hf8 afrag = *(const hf8*)(SC + ((mt0 + i) * 16 + (lane & 15)) * 72 + ks * 32 + (lane >> 4) * 8);
                    acc[i] = __builtin_amdgcn_mfma_f32_16x16x32_f16(bfrag, afrag, acc[i], 0, 0, 0);
                }
            }
        }
        __syncthreads();
    }
#pragma unroll
    for (int i = 0; i < 3; ++i) {
        if (i < nmt) {
            int row = (mt0 + i) * 16 + (lane & 15);
            if (row < NSEQ) {
#pragma unroll
                for (int j = 0; j < 4; ++j) {
                    int gc = gc0 + nt * 16 + (lane >> 4) * 4 + j;
                    MOD[(size_t)row * 6144 + gc] = acc[i][j] + p.b_ada[gc];
                }
            }
        }
    }
}

__device__ __forceinline__ void phase0(const Params& p, unsigned char* smem) {
    constexpr int I_ADA = 192;
    constexpr int I_WIN = 16 * 58;
    constexpr int I_WOUT = 16 * 16;
    constexpr int I_LORA = 8;
    constexpr int NITEMS = I_ADA + 2 * (I_WIN + I_WOUT + 2 * I_LORA);
    constexpr int NTR = NITEMS - I_ADA;
    constexpr int EXTRA = 6;
    auto transpose_item = [&](int r) {
        const int l = r / (I_WIN + I_WOUT + 2 * I_LORA);
        r = r % (I_WIN + I_WOUT + 2 * I_LORA);
        float* lds = (float*)smem;
        if (r < I_WIN) { p0_transpose(p.w_in + (size_t)l * D * PIN, D, PIN, (hf*)(p.ws + WS_WTIN) + (size_t)l * PINP * D, r, lds); return; }
        r -= I_WIN;
        if (r < I_WOUT) { p0_transpose(p.w_out + (size_t)l * D * D, D, D, (hf*)(p.ws + WS_WTOUT) + (size_t)l * D * D, r, lds); return; }
        r -= I_WOUT;
        if (r < I_LORA) { p0_transpose(p.w_up + (size_t)l * 64 * 512, 64, 512, (hf*)(p.ws + WS_WUPT) + (size_t)l * 512 * 64, r, lds); return; }
        r -= I_LORA;
        p0_transpose(p.a_up + (size_t)l * 64 * 512, 64, 512, (hf*)(p.ws + WS_AUPT) + (size_t)l * 512 * 64, r, lds);
    };
    const int nb = gridDim.x, b = blockIdx.x;
    const int nfree = nb > I_ADA ? nb - I_ADA : 0;
    const int nextra = min(nfree * EXTRA, NTR);
    for (int it = b; it < I_ADA; it += nb) p0_adaln(p, it, smem);
    if (b >= I_ADA) for (int i = 0; i < EXTRA; ++i) { const int r = (b - I_ADA) + nfree * i; if (r < nextra) transpose_item(r); }
    for (int r = nextra + b; r < NTR; r += nb) transpose_item(r);
}

__device__ __forceinline__ void phase1(const Params& p, int l) {
    const int tid = tid_(); const int lane = tid & 63, wave = tid >> 6;
    hf* H = (hf*)(p.ws + WS_H);
    const float* MOD = (const float*)(p.ws + WS_MOD);
    auto coff = [&](int q) { return 512 * (q >> 1) + 8 * lane + 4 * (q & 1); };
    for (int tk = blockIdx.x * 8 + wave; tk < MROWS; tk += gridDim.x * 8) {
        if (tk >= NTOK) {
            const int bs = tk - NTOK;
            const float* s = p.state_shift + ((size_t)l * 128 + bs) * D;
#pragma unroll
            for (int j = 0; j < 2; ++j) {
                const f32x4 v0 = *(const f32x4*)(s + coff(2 * j)), v1 = *(const f32x4*)(s + coff(2 * j + 1));
                const hf8 o = {(hf)v0.x, (hf)v0.y, (hf)v0.z, (hf)v0.w, (hf)v1.x, (hf)v1.y, (hf)v1.z, (hf)v1.w};
                st16_wt(H + (size_t)tk * D + coff(2 * j), __builtin_bit_cast(u32x4, o));
            }
            continue;
        }
        const int sq = seq_of(tk);
        const float* xr = x0_row(p, tk);
        f32x4 x[4];
#pragma unroll
        for (int q = 0; q < 4; ++q) x[q] = *(const f32x4*)(xr + coff(q));
        if (l == 1) {
            const hf* mo = (const hf*)(p.out + O_Y + (size_t)tk * D);
            f32x4 m[4];
            float ss = 0.f;
#pragma unroll
            for (int q = 0; q < 4; ++q) {
                hf4 t = *(const hf4*)(mo + coff(q));
                m[q] = (f32x4){(float)t.x, (float)t.y, (float)t.z, (float)t.w};
                ss += m[q].x * m[q].x + m[q].y * m[q].y + m[q].z * m[q].z + m[q].w * m[q].w;
            }
            const float rs = rsqrtf(wave_sum_all(ss) * (1.f / D) + 1e-6f);
#pragma unroll
            for (int q = 0; q < 4; ++q) {
                f32x4 gp = *(const f32x4*)(p.g_post + coff(q));
                f32x4 gt = *(const f32x4*)(MOD + (size_t)sq * 6144 + 2048 + coff(q));
                x[q] = x[q] + gt * (m[q] * rs * gp);
            }
        }
        float ss = 0.f;
#pragma unroll
        for (int q = 0; q < 4; ++q) ss += x[q].x * x[q].x + x[q].y * x[q].y + x[q].z * x[q].z + x[q].w * x[q].w;
        const float rs = rsqrtf(wave_sum_all(ss) * (1.f / D) + 1e-6f);
        const bool last = is_last_tok(tk);
        float* so = nullptr;
        if (last) so = (sq < 8) ? p.out + O_SHIFT_P + ((size_t)l * 8 + sq) * D : p.out + O_SHIFT_S + ((size_t)l * 128 + (sq - 8)) * D;
        f32x4 h[4];
#pragma unroll
        for (int q = 0; q < 4; ++q) {
            f32x4 g = *(const f32x4*)(p.g_pre + (size_t)l * D + coff(q));
            f32x4 sh = *(const f32x4*)(MOD + (size_t)sq * 6144 + l * 3072 + coff(q));
            f32x4 sc = *(const f32x4*)(MOD + (size_t)sq * 6144 + l * 3072 + 1024 + coff(q));
            h[q] = (x[q] * rs * g) * (1.f + sc) + sh;
            if (last) *(f32x4*)(so + coff(q)) = h[q];
        }
#pragma unroll
        for (int j = 0; j < 2; ++j) {
            const f32x4 v0 = h[2 * j], v1 = h[2 * j + 1];
            const hf8 o = {(hf)v0.x, (hf)v0.y, (hf)v0.z, (hf)v0.w, (hf)v1.x, (hf)v1.y, (hf)v1.z, (hf)v1.w};
            st16_wt(H + (size_t)tk * D + coff(2 * j), __builtin_bit_cast(u32x4, o));
        }
    }
}

constexpr int G_BM = 256, G_BN = 128, G_BK = 64, G_LD = 72;
constexpr int G_ASZ = G_BM * G_LD, G_BSZ = G_BN * G_LD;
template <int EPI>
__device__ __forceinline__ void gemm_tile(const hf* __restrict__ A, const hf* __restrict__ Bt, hf* __restrict__ C, int m0, int n0, int mlimit, int ldc, unsigned char* smem) {
    hf* As = (hf*)smem;
    hf* Bs = As + 2 * G_ASZ;
    const int tid = tid_(), lane = tid & 63, wave = tid >> 6;
    const int wm = wave >> 1, wn = wave & 1;
    const int fr = lane & 15, fq = lane >> 4;
    f32x4 acc[4][4];
#pragma unroll
    for (int i = 0; i < 4; ++i)
#pragma unroll
        for (int j = 0; j < 4; ++j) acc[i][j] = (f32x4){0.f, 0.f, 0.f, 0.f};
    hf8 ra[4], rb[2];
    const int lrow = tid >> 3, lkc = (tid & 7) * 8;
    auto gload = [&](int kt) {
#pragma unroll
        for (int i = 0; i < 4; ++i) ra[i] = *(const hf8*)(A + (size_t)(m0 + lrow + 64 * i) * D + kt * G_BK + lkc);
#pragma unroll
        for (int i = 0; i < 2; ++i) rb[i] = *(const hf8*)(Bt + (size_t)(n0 + lrow + 64 * i) * D + kt * G_BK + lkc);
    };
    auto lstore = [&](int buf) {
#pragma unroll
        for (int i = 0; i < 4; ++i) *(hf8*)(As + buf * G_ASZ + (lrow + 64 * i) * G_LD + lkc) = ra[i];
#pragma unroll
        for (int i = 0; i < 2; ++i) *(hf8*)(Bs + buf * G_BSZ + (lrow + 64 * i) * G_LD + lkc) = rb[i];
    };
    gload(0);
    lstore(0);
    __syncthreads();
    constexpr int NKT = D / G_BK;
    for (int kt = 0; kt < NKT; ++kt) {
        const int buf = kt & 1;
        if (kt + 1 < NKT) gload(kt + 1);
        const hf* as = As + buf * G_ASZ + (wm * 64 + fr) * G_LD + fq * 8;
        const hf* bs = Bs + buf * G_BSZ + (wn * 64 + fr) * G_LD + fq * 8;
#pragma unroll
        for (int ks = 0; ks < 2; ++ks) {
            hf8 af[4], bf[4];
#pragma unroll
            for (int i = 0; i < 4; ++i) af[i] = *(const hf8*)(as + i * 16 * G_LD + ks * 32);
#pragma unroll
            for (int i = 0; i < 4; ++i) bf[i] = *(const hf8*)(bs + i * 16 * G_LD + ks * 32);
#pragma unroll
            for (int i = 0; i < 4; ++i)
#pragma unroll
                for (int j = 0; j < 4; ++j)
                    acc[i][j] = __builtin_amdgcn_mfma_f32_16x16x32_f16(bf[j], af[i], acc[i][j], 0, 0, 0);
        }
        if (kt + 1 < NKT) lstore(buf ^ 1);
        __syncthreads();
    }
#pragma unroll
    for (int i = 0; i < 4; ++i) {
        const int row = m0 + wm * 64 + i * 16 + fr;
        if (row < mlimit) {
#pragma unroll
            for (int j = 0; j < 4; ++j) {
                const int col = n0 + wn * 64 + j * 16 + fq * 4;
                hf4 o = {(hf)acc[i][j][0], (hf)acc[i][j][1], (hf)acc[i][j][2], (hf)acc[i][j][3]};
                *(hf4*)(C + (size_t)row * ldc + col) = o;
            }
        }
    }
}

constexpr int Q_BM = 256, Q_BK = 64, Q_HALF = 128, Q_NXCD = 8, Q_WGM = 8, Q_HT = Q_HALF * Q_BK;
__device__ __forceinline__ int q_lds_byte(int r, int c) {
    int st = (r >> 4) * 2 + (c >> 5), rr = r & 15, cc = c & 31, ob = rr * 64 + cc * 2;
    return st * 1024 + (ob ^ (((ob >> 9) & 1) << 5));
}
__device__ __forceinline__ void q_stage_rc(int b, int& R, int& C) {
    int st = b / 1024, sb = b % 1024, swz = sb ^ (((sb >> 9) & 1) << 5);
    R = (st >> 1) * 16 + swz / 64; C = (st & 1) * 32 + (swz % 64) / 2;
}
__device__ __forceinline__ void q_tile_of(int wgid, int nM, int nN, int& pm, int& pn) {
    const int nwg = nM * nN;
    { const int q = nwg / Q_NXCD, r = nwg % Q_NXCD, xcd = wgid % Q_NXCD, off = wgid / Q_NXCD; wgid = (xcd < r ? xcd * (q + 1) : r * (q + 1) + (xcd - r) * q) + off; }
    const int nig = Q_WGM * nN, gid = wgid / nig, fm = gid * Q_WGM, gsz = min(nM - fm, Q_WGM);
    pm = fm + ((wgid % nig) % gsz); pn = (wgid % nig) / gsz;
}
__device__ __forceinline__ void gemm256(const hf* __restrict__ A, const hf* __restrict__ Bt, hf* __restrict__ C, int brow, int bcol, int mlimit, int nlimit, int ldc, unsigned char* smem) {
    constexpr int K = D;
    hf* shm = (hf*)smem;
    const int qtid = tid_();
#define SA(b,h) (shm+((b)*2+(h))*Q_HT)
#define SB(b,h) (shm+(4+(b)*2+(h))*Q_HT)
#define STAGE(P,BASE,br,kt) do{const char* _gb=(const char*)((BASE)+(long)(br)*K+(long)(kt)*Q_BK); \
    __builtin_amdgcn_global_load_lds((const unsigned*)(_gb+so0),(unsigned*)((char*)(P)+qtid*16),16,0,0); \
    __builtin_amdgcn_global_load_lds((const unsigned*)(_gb+so1),(unsigned*)((char*)(P)+qtid*16+8192),16,0,0);}while(0)
#define LDA(dst,b,h) _Pragma("unroll") for(int m=0;m<4;++m) _Pragma("unroll") for(int k=0;k<2;++k) \
    dst[m][k]=*reinterpret_cast<const hf8*>((char*)SA(b,h)+q_lds_byte(wr*64+m*16+fr,k*32+fq*8))
#define LDB(dst,b,h) _Pragma("unroll") for(int n=0;n<2;++n) _Pragma("unroll") for(int k=0;k<2;++k) \
    dst[n][k]=*reinterpret_cast<const hf8*>((char*)SB(b,h)+q_lds_byte(wc*32+n*16+fr,k*32+fq*8))
#define MMA(ai,bj,At,Bt_) do{__builtin_amdgcn_s_setprio(1); \
    _Pragma("unroll") for(int m=0;m<4;++m) _Pragma("unroll") for(int n=0;n<2;++n) _Pragma("unroll") for(int k=0;k<2;++k) \
      acc[ai][bj][m][n]=__builtin_amdgcn_mfma_f32_16x16x32_f16(Bt_[n][k],At[m][k],acc[ai][bj][m][n],0,0,0); \
    __builtin_amdgcn_s_setprio(0);}while(0)
#define WAIT_V(n) asm volatile("s_waitcnt vmcnt(" #n ")":::"memory")
#define WAIT_L(n) asm volatile("s_waitcnt lgkmcnt(" #n ")":::"memory")
#define BAR __builtin_amdgcn_s_barrier()
#define SCHED __builtin_amdgcn_sched_barrier(0)
    const int wid = qtid >> 6, lane = qtid & 63, wr = wid >> 2, wc = wid & 3, fr = lane & 15, fq = lane >> 4;
    unsigned so0, so1;
    { int r_, c_; q_stage_rc(qtid * 16, r_, c_); so0 = (unsigned)(r_ * K + c_) * 2u; q_stage_rc(qtid * 16 + 8192, r_, c_); so1 = (unsigned)(r_ * K + c_) * 2u; }
    f32x4 acc[2][2][4][2] = {};
    hf8 At[4][2], B0[2][2], B1[2][2];
    constexpr int nt = K / Q_BK;
    STAGE(SB(0,0),Bt,bcol,0); STAGE(SA(0,0),A,brow,0);
    STAGE(SB(0,1),Bt,bcol+Q_HALF,0); STAGE(SA(0,1),A,brow+Q_HALF,0);
    if(wr==1)BAR;
    WAIT_V(4); BAR;
    STAGE(SB(1,0),Bt,bcol,1); STAGE(SA(1,0),A,brow,1); STAGE(SB(1,1),Bt,bcol+Q_HALF,1);
    WAIT_V(6); BAR;
    for(int t=0;t<nt-2;t+=2){
        LDB(B0,0,0); SCHED; LDA(At,0,0); STAGE(SA(1,1),A,brow+Q_HALF,t+1);
        WAIT_L(8); BAR; WAIT_L(0); MMA(0,0,At,B0); BAR; SCHED;
        LDB(B1,0,1); STAGE(SB(0,0),Bt,bcol,t+2);
        BAR; WAIT_L(0); MMA(0,1,At,B1); BAR;
        LDA(At,0,1); STAGE(SA(0,0),A,brow,t+2);
        BAR; WAIT_L(0); MMA(1,0,At,B0); BAR; SCHED;
        STAGE(SB(0,1),Bt,bcol+Q_HALF,t+2);
        WAIT_V(6); BAR; MMA(1,1,At,B1); BAR;
        LDB(B0,1,0); SCHED; LDA(At,1,0); STAGE(SA(0,1),A,brow+Q_HALF,t+2);
        WAIT_L(8); BAR; WAIT_L(0); MMA(0,0,At,B0); BAR; SCHED;
        LDB(B1,1,1); STAGE(SB(1,0),Bt,bcol,t+3);
        BAR; WAIT_L(0); MMA(0,1,At,B1); BAR;
        LDA(At,1,1); STAGE(SA(1,0),A,brow,t+3);
        BAR; WAIT_L(0); MMA(1,0,At,B0); BAR; SCHED;
        STAGE(SB(1,1),Bt,bcol+Q_HALF,t+3);
        WAIT_V(6); BAR; MMA(1,1,At,B1); BAR;
    }
    { LDB(B0,0,0); LDA(At,0,0); STAGE(SA(1,1),A,brow+Q_HALF,nt-1);
      BAR; WAIT_L(0); MMA(0,0,At,B0); BAR;
      LDB(B1,0,1); BAR; WAIT_L(0); MMA(0,1,At,B1); BAR;
      LDA(At,0,1); WAIT_V(4); BAR; WAIT_L(0); MMA(1,0,At,B0); MMA(1,1,At,B1); BAR; }
    { LDB(B0,1,0); LDA(At,1,0); WAIT_V(2); BAR; WAIT_L(0); MMA(0,0,At,B0); BAR;
      LDB(B1,1,1); WAIT_V(0); BAR; WAIT_L(0); MMA(0,1,At,B1); BAR;
      LDA(At,1,1); BAR; WAIT_L(0); MMA(1,0,At,B0); MMA(1,1,At,B1); BAR; }
    if(wr==0)BAR;
#pragma unroll
    for(int ai=0;ai<2;++ai)
#pragma unroll
    for(int bj=0;bj<2;++bj)
#pragma unroll
    for(int m=0;m<4;++m){
        const int row = brow+ai*Q_HALF+wr*64+m*16+fr;
        const f32x4 a = acc[ai][bj][m][0], b = acc[ai][bj][m][1];
        const hf4 ha = {(hf)a[0], (hf)a[1], (hf)a[2], (hf)a[3]}, hb = {(hf)b[0], (hf)b[1], (hf)b[2], (hf)b[3]};
        const u32x2 ua = __builtin_bit_cast(u32x2, ha), ub = __builtin_bit_cast(u32x2, hb);
        const auto r0 = __builtin_amdgcn_permlane16_swap(ua.x, ub.x, false, false);
        const auto r1 = __builtin_amdgcn_permlane16_swap(ua.y, ub.y, false, false);
        const u32x4 o = {r0[0], r1[0], r0[1], r1[1]};
        const int col = bcol+bj*Q_HALF+wc*32 + ((fq & 1) ? 16 + (fq - 1) * 4 : fq * 4);
        if (row < mlimit && col < nlimit) {
            st16_wt(C + (size_t)row * ldc + col, o);
        }
    }
    __syncthreads();
#undef SA
#undef SB
#undef STAGE
#undef LDA
#undef LDB
#undef MMA
#undef WAIT_V
#undef WAIT_L
#undef BAR
#undef SCHED
}

__device__ __forceinline__ void phase2(const Params& p, int l, unsigned char* smem) {
    const hf* A = (const hf*)(p.ws + WS_H);
    const hf* Bt = (const hf*)(p.ws + WS_WTIN) + (size_t)l * PINP * D;
    hf* U = (hf*)(p.ws + WS_U);
    constexpr int NMT = MPAD / 256, NNT = PINP / 256;
    for (int t = blockIdx.x; t < NMT * NNT; t += gridDim.x) {
        int pm, pn;
        q_tile_of(t, NMT, NNT, pm, pn);
        gemm256(A, Bt, U, pm * 256, pn * 256, MROWS, PIN, PIN, smem);
    }
}
__device__ __forceinline__ void phase5b(const Params& p, int l, unsigned char* smem) {
    const hf* A = (const hf*)(p.ws + WS_MIX);
    const hf* Bt = (const hf*)(p.ws + WS_WTOUT) + (size_t)l * D * D;
    hf* C = (hf*)(p.out + O_Y) + l * 1024;
    for (int t = blockIdx.x; t < 64 * 4; t += gridDim.x) {
        int pm, pn;
        q_tile_of(t, 64, 4, pm, pn);
        gemm256(A, Bt, C, pm * 256, pn * 256, NTOK, D, 2048, smem);
    }
    for (int t = blockIdx.x; t < 256; t += gridDim.x) {
        const int tid = tid_(), lane = tid & 63, wave = tid >> 6;
        const int fr = lane & 15, fq = lane >> 4;
        const int m0 = 16384 + (t >> 5) * 64 + (wave >> 1) * 16, n0 = (t & 31) * 32 + (wave & 1) * 16;
        const hf* ap = A + (size_t)(m0 + fr) * D + fq * 8;
        const hf* bp = Bt + (size_t)(n0 + fr) * D + fq * 8;
        f32x4 acc0 = {0.f, 0.f, 0.f, 0.f}, acc1 = {0.f, 0.f, 0.f, 0.f};
#pragma unroll 8
        for (int k = 0; k < D; k += 64) {
            const hf8 a0 = *(const hf8*)(ap + k), b0 = *(const hf8*)(bp + k);
            const hf8 a1 = *(const hf8*)(ap + k + 32), b1 = *(const hf8*)(bp + k + 32);
            acc0 = __builtin_amdgcn_mfma_f32_16x16x32_f16(b0, a0, acc0, 0, 0, 0);
            acc1 = __builtin_amdgcn_mfma_f32_16x16x32_f16(b1, a1, acc1, 0, 0, 0);
        }
        const f32x4 a = acc0 + acc1;
        hf4 o = {(hf)a[0], (hf)a[1], (hf)a[2], (hf)a[3]};
        *(hf4*)(C + (size_t)(m0 + fr) * 2048 + n0 + fq * 4) = o;
    }
}

__device__ __forceinline__ void p3_lora(const Params& p, int l, int witem) {
    const int lane = tid_() & 63;
    const int fr = lane & 15, fq = lane >> 4;
    const hf* U = (const hf*)(p.ws + WS_U);
    hf* EA = (hf*)(p.ws + WS_EA);
    hf* KKB = (hf*)(p.ws + WS_H);
    const hf* WupT = (const hf*)(p.ws + WS_WUPT) + (size_t)l * 512 * 64;
    const hf* AupT = (const hf*)(p.ws + WS_AUPT) + (size_t)l * 512 * 64;
    const float* mu = p.mu + (size_t)l * PRW;
    const int tk = witem * 16 + fr;
    const int pr = prev_row(tk);
    const float pm = pr >= 0 ? 1.f : 0.f;
    const hf* ut = U + (size_t)tk * PIN;
    const hf* up = U + (size_t)(pr >= 0 ? pr : 0) * PIN;
    hf8 aw[2], aa[2];
#pragma unroll
    for (int ks = 0; ks < 2; ++ks) {
        const int kb = ks * 32 + fq * 8;
        const hf8 cw = *(const hf8*)(ut + 2048 + kb), ca = *(const hf8*)(ut + 2112 + kb);
        const hf8 pw = *(const hf8*)(up + 2048 + kb), pa = *(const hf8*)(up + 2112 + kb);
#pragma unroll
        for (int j = 0; j < 8; ++j) {
            float c = (float)cw[j], q = (float)pw[j] * pm;
            aw[ks][j] = (hf)tanh_fast(c + (q - c) * mu[2048 + kb + j]);
            c = (float)ca[j]; q = (float)pa[j] * pm;
            aa[ks][j] = (hf)(c + (q - c) * mu[2112 + kb + j]);
        }
    }
    auto store_pair = [&](hf* base, int n0, hf4 t0, hf4 t1) {
        const u32x2 ua = __builtin_bit_cast(u32x2, t0), ub = __builtin_bit_cast(u32x2, t1);
        const auto r0 = __builtin_amdgcn_permlane16_swap(ua.x, ub.x, false, false);
        const auto r1 = __builtin_amdgcn_permlane16_swap(ua.y, ub.y, false, false);
        const u32x4 o = {r0[0], r1[0], r0[1], r1[1]};
        const int col = n0 + ((fq & 1) ? 16 + (fq - 1) * 4 : fq * 4);
        st16_wt(base + (size_t)tk * D + col, o);
    };
    for (int h = 0; h < 8; ++h) {
        f32x4 av[4], kv[4];
        hf4 eo[4], ao[4];
        float ss = 0.f;
#pragma unroll
        for (int nt = 0; nt < 4; ++nt) {
            const int n0 = h * 64 + nt * 16;
            f32x4 cw = {0.f, 0.f, 0.f, 0.f}, ca = {0.f, 0.f, 0.f, 0.f};
#pragma unroll
            for (int ks = 0; ks < 2; ++ks) {
                const hf8 bw = *(const hf8*)(WupT + (size_t)(n0 + fr) * 64 + ks * 32 + fq * 8);
                const hf8 ba = *(const hf8*)(AupT + (size_t)(n0 + fr) * 64 + ks * 32 + fq * 8);
                cw = __builtin_amdgcn_mfma_f32_16x16x32_f16(bw, aw[ks], cw, 0, 0, 0);
                ca = __builtin_amdgcn_mfma_f32_16x16x32_f16(ba, aa[ks], ca, 0, 0, 0);
            }
            const int col = n0 + fq * 4;
            const f32x4 w0c = *(const f32x4*)(p.w0 + l * 512 + col), a0c = *(const f32x4*)(p.a0 + l * 512 + col);
            const f32x4 kkc = *(const f32x4*)(p.k_k + l * 512 + col), muk = *(const f32x4*)(mu + 512 + col), kac = *(const f32x4*)(p.k_a + l * 512 + col);
            const hf4 kc4 = *(const hf4*)(ut + 512 + col), kp4 = *(const hf4*)(up + 512 + col);
#pragma unroll
            for (int j = 0; j < 4; ++j) {
                const float e = 0.60653066f * sigm(w0c[j] + cw[j]);
                const float a = sigm(a0c[j] + ca[j]);
                const float kc = (float)kc4[j], kp = (float)kp4[j] * pm;
                const float kl = kc + (kp - kc) * muk[j];
                eo[nt][j] = (hf)e; ao[nt][j] = (hf)(kl * (1.f + (a - 1.f) * kac[j]));
                const float kkr = kl * kkc[j];
                av[nt][j] = a; kv[nt][j] = kkr;
                ss += kkr * kkr;
            }
        }
        store_pair(EA, h * 64, eo[0], eo[1]);
        store_pair(EA, h * 64 + 32, eo[2], eo[3]);
        store_pair(EA + 512, h * 64, ao[0], ao[1]);
        store_pair(EA + 512, h * 64 + 32, ao[2], ao[3]);
        ss += __shfl_xor(ss, 16);
        ss += __shfl_xor(ss, 32);
        const float inv = 1.f / fmaxf(sqrtf(ss), 1e-12f);
        hf4 ko[4], bo[4];
#pragma unroll
        for (int nt = 0; nt < 4; ++nt) {
#pragma unroll
            for (int j = 0; j < 4; ++j) { const float kk = kv[nt][j] * inv; ko[nt][j] = (hf)kk; bo[nt][j] = (hf)(kk * av[nt][j]); }
        }
        store_pair(KKB, h * 64, ko[0], ko[1]);
        store_pair(KKB, h * 64 + 32, ko[2], ko[3]);
        store_pair(KKB + 512, h * 64, bo[0], bo[1]);
        store_pair(KKB + 512, h * 64 + 32, bo[2], bo[3]);
    }
}

template <int NT>
__device__ __forceinline__ void conv_taps(const float* G, const float* w, float bias, float* acc) {
    typedef float cf2 __attribute__((ext_vector_type(2)));
    cf2 W2[32];
#pragma unroll
    for (int j = 0; j < 32; ++j) W2[j] = (cf2){j < 31 ? w[j] : 0.f, j > 0 ? w[j - 1] : 0.f};
    cf2 ap[NT / 2];
#pragma unroll
    for (int pi = 0; pi < NT / 2; ++pi) ap[pi] = (cf2){bias, bias};
#pragma unroll
    for (int r = 0; r < NT + 30; ++r) {
        const float g = G[r * 64];
        const cf2 gg = {g, g};
#pragma unroll
        for (int pi = 0; pi < NT / 2; ++pi) {
            const int j = r - 2 * pi;
            if (j >= 0 && j <= 31) ap[pi] = gg * W2[j] + ap[pi];
        }
    }
#pragma unroll
    for (int pi = 0; pi < NT / 2; ++pi) { acc[2 * pi] = ap[pi].x; acc[2 * pi + 1] = ap[pi].y; }
}

__device__ __forceinline__ void p3_conv_prompt(const Params& p, int l, int item, unsigned char* smem) {
    float* G = (float*)smem;
    hf* T = (hf*)(smem + 286 * 64 * 4) + (tid_() >> 6) * 512;
    const int g = item & 7, tt = (item >> 3) & 7, b = item >> 6;
    const int c0 = g * 64, t0 = tt * 256;
    const hf* U = (const hf*)(p.ws + WS_U);
    hf* MIX = (hf*)(p.ws + WS_MIX);
    const int tid = tid_();
    const int c = tid & 63, tq = tid >> 6;
    const int ch = c0 + c;
    float w[31];
#pragma unroll
    for (int j = 0; j < 31; ++j) w[j] = p.w_dw[((size_t)l * 31 + j) * 512 + ch];
    const float bias = p.b_dw[l * 512 + ch], gg = p.gn_c_g[l * 512 + ch], gb = p.gn_c_b[l * 512 + ch];
    hf gcv[32];
#pragma unroll
    for (int i = 0; i < 32; ++i) gcv[i] = U[(size_t)(b * 2048 + t0 + tq * 32 + i) * PIN + PRW + 1024 + ch];
    {
        hf2 ua[18], ub[18];
#pragma unroll
        for (int i = 0; i < 18; ++i) {
            const int e = min(tid + NTHR * i, 286 * 32 - 1);
            const int r = e >> 5, cp = (e & 31) * 2;
            const int t = max(t0 - 30 + r, 0);
            const hf* u = U + (size_t)(b * 2048 + t) * PIN + PRW + c0 + cp;
            ua[i] = *(const hf2*)u; ub[i] = *(const hf2*)(u + 512);
        }
#pragma unroll
        for (int i = 0; i < 18; ++i) {
            const int e = tid + NTHR * i;
            if (e < 286 * 32) {
                const int r = e >> 5, cp = (e & 31) * 2;
                const float m = (t0 - 30 + r) >= 0 ? 1.f : 0.f;
                G[r * 64 + cp] = m * (float)ua[i].x * sigm((float)ub[i].x);
                G[r * 64 + cp + 1] = m * (float)ua[i].y * sigm((float)ub[i].y);
            }
        }
    }
    __syncthreads();
#pragma unroll
    for (int sub = 0; sub < 4; ++sub) {
        const int tl = tq * 32 + sub * 8;
        float acc[8];
        conv_taps<8>(G + tl * 64 + c, w, bias, acc);
#pragma unroll
        for (int i = 0; i < 8; ++i) {
            const int tk = b * 2048 + t0 + tl + i;
            const float mean = wave_sum_all(acc[i]) * (1.f / 64.f);
            const float var = fmaxf(wave_sum_all(acc[i] * acc[i]) * (1.f / 64.f) - mean * mean, 0.f);
            const float yn = (acc[i] - mean) * rsqrtf(var + 1e-5f) * gg + gb;
            (void)tk;
            T[i * 64 + c] = (hf)(silu(yn) * silu((float)gcv[sub * 8 + i]));
        }
        asm volatile("s_waitcnt lgkmcnt(0)" ::: "memory");
        {
            const int lane = tid & 63, tok = lane >> 3, ch8 = (lane & 7) * 8;
            const u32x4 v = *(const u32x4*)(T + tok * 64 + ch8);
            st16_wt(MIX + (size_t)(b * 2048 + t0 + tl + tok) * D + 512 + c0 + ch8, v);
        }
        asm volatile("s_waitcnt lgkmcnt(0)" ::: "memory");
    }
    if (tt == 7) {
        float* oc = p.out + O_CONV_P + ((size_t)l * 8 + b) * 30 * 512;
        for (int e = tid; e < 30 * 64; e += NTHR) {
            const int r = e >> 6, cc = e & 63;
            oc[(size_t)r * 512 + c0 + cc] = G[(256 + r) * 64 + cc];
        }
    }
    __syncthreads();
}

__device__ __forceinline__ void p3_conv_sample(const Params& p, int l, int item, unsigned char* smem) {
    float* G = (float*)smem;
    const int g = item & 7, s0 = (item >> 3) * 4;
    const int c0 = g * 64;
    const hf* U = (const hf*)(p.ws + WS_U);
    hf* MIX = (hf*)(p.ws + WS_MIX);
    const int tid = tid_();
    {
        float hv[15];
        hf ga[2], gbv[2];
#pragma unroll
        for (int i = 0; i < 15; ++i) {
            const int e = tid + NTHR * i, cc = e & 63, rr = (e >> 6) % 30, sl = (e >> 6) / 30;
            hv[i] = p.state_conv[(((size_t)l * 128 + s0 + sl) * 30 + rr) * 512 + c0 + cc];
        }
#pragma unroll
        for (int i = 0; i < 2; ++i) {
            const int e = tid + NTHR * i, cc = e & 63, tt = (e >> 6) & 3, sl = e >> 8;
            const hf* u = U + (size_t)(NTOKP + (s0 + sl) * 4 + tt) * PIN + PRW + c0 + cc;
            ga[i] = u[0]; gbv[i] = u[512];
        }
#pragma unroll
        for (int i = 0; i < 15; ++i) {
            const int e = tid + NTHR * i, cc = e & 63, rr = (e >> 6) % 30, sl = (e >> 6) / 30;
            G[(sl * 34 + rr) * 64 + cc] = hv[i];
        }
#pragma unroll
        for (int i = 0; i < 2; ++i) {
            const int e = tid + NTHR * i, cc = e & 63, tt = (e >> 6) & 3, sl = e >> 8;
            G[(sl * 34 + 30 + tt) * 64 + cc] = (float)ga[i] * sigm((float)gbv[i]);
        }
    }
    const int c = tid & 63, wv = tid >> 6;
    const int sl = wv >> 1, tp = (wv & 1) * 2;
    const int ch = c0 + c, bs = s0 + sl;
    float w[31];
#pragma unroll
    for (int j = 0; j < 31; ++j) w[j] = p.w_dw[((size_t)l * 31 + j) * 512 + ch];
    hf gcs[2];
#pragma unroll
    for (int i = 0; i < 2; ++i) gcs[i] = U[(size_t)(NTOKP + bs * 4 + tp + i) * PIN + PRW + 1024 + ch];
    __syncthreads();
    float acc[2];
    conv_taps<2>(G + (sl * 34 + tp) * 64 + c, w, p.b_dw[l * 512 + ch], acc);
    const float gg = p.gn_c_g[l * 512 + ch], gb = p.gn_c_b[l * 512 + ch];
#pragma unroll
    for (int i = 0; i < 2; ++i) {
        const int tk = NTOKP + bs * 4 + tp + i;
        const float mean = wave_sum(acc[i]) * (1.f / 64.f);
        const float d = acc[i] - mean;
        const float var = wave_sum(d * d) * (1.f / 64.f);
        const float yn = d * rsqrtf(var + 1e-5f) * gg + gb;
        MIX[(size_t)tk * D + 512 + ch] = (hf)(silu(yn) * silu((float)gcs[i]));
    }
#pragma unroll
    for (int e = tid; e < 4 * 30 * 64; e += NTHR) {
        const int cc = e & 63, r = (e >> 6) % 30, s2 = (e >> 6) / 30;
        p.out[O_CONV_S + (((size_t)l * 128 + s0 + s2) * 30 + r) * 512 + c0 + cc] = G[(s2 * 34 + 4 + r) * 64 + cc];
    }
    __syncthreads();
}

__device__ __forceinline__ void phase3(const Params& p, int l, unsigned char* smem) {
    constexpr int W_LORA = NTOK / 16;
    constexpr int I_CP = 8 * 8 * 8;
    constexpr int I_CS = 32 * 8;
    {
        const int wave = tid_() >> 6;
        const int wi = blockIdx.x + gridDim.x * wave;
        if (wi < W_LORA) p3_lora(p, l, wi);
    }
    for (int it = blockIdx.x; it < I_CP + I_CS; it += gridDim.x) {
        if (it < I_CP) p3_conv_prompt(p, l, it, smem);
        else p3_conv_sample(p, l, it - I_CP, smem);
    }
}

typedef float f32x2 __attribute__((ext_vector_type(2)));
struct WkvS { f32x2 lo, hi; };
__device__ __forceinline__ void wkv_step(WkvS& S, const float* op, float v, float& y) {
    const f32x4 r4 = *(const f32x4*)(op + 0 * 64);
    const f32x4 w4 = *(const f32x4*)(op + 1 * 64);
    const f32x4 m4 = *(const f32x4*)(op + 2 * 64);
    const f32x4 k4 = *(const f32x4*)(op + 3 * 64);
    const f32x4 b4 = *(const f32x4*)(op + 4 * 64);
    f32x2 d = S.lo * k4.lo + S.hi * k4.hi;
    const float sk = row_allreduce16(d.x + d.y);
    const f32x2 nsk = {-sk, -sk}, vv = {v, v};
    S.lo = vv * m4.lo + (nsk * b4.lo + S.lo * w4.lo);
    S.hi = vv * m4.hi + (nsk * b4.hi + S.hi * w4.hi);
    f32x2 e = S.lo * r4.lo + S.hi * r4.hi;
    y = row_allreduce16(e.x + e.y);
}

struct WkvOps { f32x4 r4, w4, m4, k4, b4; float v; };
__device__ __forceinline__ WkvOps wkv_load(const float* op, const float* vb) {
    WkvOps o;
    o.r4 = *(const f32x4*)(op + 0 * 64);
    o.w4 = *(const f32x4*)(op + 1 * 64);
    o.m4 = *(const f32x4*)(op + 2 * 64);
    o.k4 = *(const f32x4*)(op + 3 * 64);
    o.b4 = *(const f32x4*)(op + 4 * 64);
    o.v = *vb;
    return o;
}
struct WkvOpsS { f32x4 r4, m4, k4, b4; float v; };
__device__ __forceinline__ WkvOpsS wkv_load_s(const float* op, const float* vb) {
    WkvOpsS o;
    o.r4 = *(const f32x4*)(op + 0 * 64);
    o.m4 = *(const f32x4*)(op + 2 * 64);
    o.k4 = *(const f32x4*)(op + 3 * 64);
    o.b4 = *(const f32x4*)(op + 4 * 64);
    o.v = *vb;
    return o;
}
__device__ __forceinline__ float wkv_step_part(WkvS& S, const WkvOpsS& o, const f32x4& rprev) {
    f32x2 d = S.lo * o.k4.lo + S.hi * o.k4.hi;
    float s = d.x + d.y;
    const f32x2 vv = {o.v, o.v};
    f32x2 q = S.lo * rprev.lo + S.hi * rprev.hi;
    const f32x2 tl = vv * o.m4.lo + S.lo;
    const f32x2 th = vv * o.m4.hi + S.hi;
    s = row_allreduce16(s);
    const f32x2 nsk = {-s, -s};
    S.lo = nsk * o.b4.lo + tl;
    S.hi = nsk * o.b4.hi + th;
    return q.x + q.y;
}

__device__ __forceinline__ void wkv_step_pipe(WkvS& S, const WkvOps& o, float& eprev, float& enew) {
    f32x2 d = S.lo * o.k4.lo + S.hi * o.k4.hi;
    float s = d.x + d.y, e = eprev;
    s += dpp_mov<0x128>(s); e += dpp_mov<0x128>(e);
    s += dpp_mov<0x124>(s); e += dpp_mov<0x124>(e);
    s += dpp_mov<0x122>(s); e += dpp_mov<0x122>(e);
    s += dpp_mov<0x121>(s); e += dpp_mov<0x121>(e);
    eprev = e;
    const f32x2 nsk = {-s, -s}, vv = {o.v, o.v};
    S.lo = vv * o.m4.lo + (nsk * o.b4.lo + S.lo * o.w4.lo);
    S.hi = vv * o.m4.hi + (nsk * o.b4.hi + S.hi * o.w4.hi);
    f32x2 q = S.lo * o.r4.lo + S.hi * o.r4.hi;
    enew = q.x + q.y;
}

__device__ __forceinline__ void phase4(const Params& p, int l, unsigned char* smem) {
    constexpr int OPS = 324;
    float* OP = (float*)smem;
    float* VB = OP + 2 * 16 * OPS;
    float* YB = VB + 2 * 16 * 16;
    float* VS = YB + 2 * 16 * 16 * 17;
    float* GE = VS + 16 * 64;
    const int tid = tid_(), lane = tid & 63, wave = tid >> 6;
    const hf* U = (const hf*)(p.ws + WS_U);
    const hf* EA = (const hf*)(p.ws + WS_EA);
    const hf* KKB = (const hf*)(p.ws + WS_H);
    hf* MIX = (hf*)(p.ws + WS_MIX);
    const float* mu = p.mu + (size_t)l * PRW;
    const int blk = blockIdx.x;
    const int xcd = blk & 7, idx = blk >> 3;
    const int rg = idx & 3;
    const int pbh = xcd * 8 + (idx >> 2);
    const int pb = pbh >> 3, ph = pbh & 7;
    const bool producer = wave >= 4;
    const int pw = wave & 3;
    const int rl = lane >> 4, ks = lane & 15;
    constexpr int NCHP = 2048 / 16;

    const int cl = lane >> 4, pt = lane & 15;
    const int c4 = pw * 16 + cl * 4;
    const int pcol = ph * 64 + c4;
    const f32x4 mur4 = *(const f32x4*)(mu + pcol), muv4 = *(const f32x4*)(mu + 1024 + pcol);
    const int tkp = pb * 2048 + pt;
    const hf* uc = U + (size_t)tkp * PIN + pcol;
    const hf* eac = EA + (size_t)tkp * D + pcol;
    const hf* kbc = KKB + (size_t)tkp * D + pcol;
    struct PQ { hf4 r, v, rp, vp, e, a, kk, bb; };
    PQ qA, qB;
    auto load_prompt = [&](int ci, PQ& q) {
        const hf* u = uc + (size_t)ci * (16 * PIN);
        q.r = *(const hf4*)u; q.v = *(const hf4*)(u + 1024);
        q.rp = *(const hf4*)(u - PIN); q.vp = *(const hf4*)(u - PIN + 1024);
        const hf* e_ = eac + (size_t)ci * (16 * D);
        q.e = *(const hf4*)e_; q.a = *(const hf4*)(e_ + 512);
        const hf* k_ = kbc + (size_t)ci * (16 * D);
        q.kk = *(const hf4*)k_; q.bb = *(const hf4*)(k_ + 512);
    };
    auto cvt4 = [](hf4 x) { return (f32x4){(float)x.x, (float)x.y, (float)x.z, (float)x.w}; };
    auto scan16 = [](float x) {
        x += dpp_mov<0x111>(x);
        x += dpp_mov<0x112>(x);
        x += dpp_mov<0x114>(x);
        x += dpp_mov<0x118>(x);
        return x;
    };
    auto store_prompt = [&](int ci, int buf, const PQ& q) {
        const float pmask = (ci == 0 && pt == 0) ? 0.f : 1.f;
        const f32x4 rc = cvt4(q.r), vc = cvt4(q.v);
        const f32x4 rp = cvt4(q.rp) * pmask, vp = cvt4(q.vp) * pmask;
        const f32x4 e = cvt4(q.e);
        const f32x4 r = rc + (rp - rc) * mur4, v = vc + (vp - vc) * muv4;
        f32x4 cum;
        cum.x = scan16(e.x); cum.y = scan16(e.y); cum.z = scan16(e.z); cum.w = scan16(e.w);
        const f32x4 cpv = cum - e;
        f32x4 gin, gout, gprev;
        gin.x = __expf(-cum.x); gin.y = __expf(-cum.y); gin.z = __expf(-cum.z); gin.w = __expf(-cum.w);
        gout.x = __expf(cum.x); gout.y = __expf(cum.y); gout.z = __expf(cum.z); gout.w = __expf(cum.w);
        gprev.x = __expf(-cpv.x); gprev.y = __expf(-cpv.y); gprev.z = __expf(-cpv.z); gprev.w = __expf(-cpv.w);
        float* op = OP + buf * (16 * OPS) + pt * OPS + c4;
        *(f32x4*)(op + 0 * 64) = r * gin;
        *(f32x4*)(op + 2 * 64) = cvt4(q.a) * gout;
        *(f32x4*)(op + 3 * 64) = cvt4(q.kk) * gprev;
        *(f32x4*)(op + 4 * 64) = cvt4(q.bb) * gout;
        if (pt == 15) *(f32x4*)(GE + buf * 64 + c4) = gin;
        if (pw == rg) *(f32x4*)(VB + buf * 256 + pt * 16 + cl * 4) = v;
    };
    auto flush_y = [&](int ci, int buf) {
        const int tok = pw * 4 + (lane >> 4), row = lane & 15;
        const float* yb = YB + buf * (16 * 16 * 17) + (tok * 16 + row) * 17;
        float y0 = 0.f, y1 = 0.f, y2 = 0.f, y3 = 0.f;
#pragma unroll
        for (int j = 0; j < 16; j += 4) { y0 += yb[j]; y1 += yb[j + 1]; y2 += yb[j + 2]; y3 += yb[j + 3]; }
        MIX[(size_t)(pb * 2048 + ci * 16 + tok) * D + ph * 64 + rg * 16 + row] = (hf)((y0 + y1) + (y2 + y3));
    };

    WkvS S; S.lo = (f32x2){0.f, 0.f}; S.hi = (f32x2){0.f, 0.f};
    if (producer) { load_prompt(0, qB); store_prompt(0, 0, qB); load_prompt(1, qA); load_prompt(2, qB); }
    __syncthreads();
    auto consume = [&](int buf) {
        const float* op = OP + buf * (16 * OPS) + ks * 4;
        const float* vb = VB + buf * 256 + pw * 4 + rl;
        float* yb = YB + buf * (16 * 16 * 17) + (pw * 4 + rl) * 17 + ks;
        WkvOpsS ring[4];
        ring[0] = wkv_load_s(op, vb);
        ring[1] = wkv_load_s(op + OPS, vb + 16);
        ring[2] = wkv_load_s(op + 2 * OPS, vb + 32);
        f32x4 rprev = {0.f, 0.f, 0.f, 0.f};
#pragma unroll
        for (int t = 0; t < 16; ++t) {
            if (t + 3 < 16) ring[(t + 3) & 3] = wkv_load_s(op + (t + 3) * OPS, vb + (t + 3) * 16);
            __builtin_amdgcn_sched_barrier(0);
            const float e = wkv_step_part(S, ring[t & 3], rprev);
            if (t > 0) yb[(t - 1) * (16 * 17)] = e;
            rprev = ring[t & 3].r4;
            __builtin_amdgcn_sched_barrier(0);
        }
        {
            f32x2 q = S.lo * rprev.lo + S.hi * rprev.hi;
            yb[15 * (16 * 17)] = q.x + q.y;
            const f32x4 ge = *(const f32x4*)(GE + buf * 64 + ks * 4);
            S.lo = S.lo * ge.lo;
            S.hi = S.hi * ge.hi;
        }
    };
#pragma unroll 1
    for (int ci = 0; ci < NCHP; ci += 2) {
        if (producer) {
            store_prompt(ci + 1, 1, qA);
            if (ci + 3 < NCHP) load_prompt(ci + 3, qA);
            if (ci >= 1) flush_y(ci - 1, 1);
        } else consume(0);
        __syncthreads();
        if (producer) {
            if (ci + 2 < NCHP) store_prompt(ci + 2, 0, qB);
            if (ci + 4 < NCHP) load_prompt(ci + 4, qB);
            flush_y(ci, 0);
        } else consume(1);
        __syncthreads();
    }

    f32x4 St[4][4];
    if (producer) {
        flush_y(NCHP - 1, (NCHP - 1) & 1);
        const int id = blk * 4 + pw, bs = id >> 3, h = id & 7;
        const int col = h * 64 + lane;
        const float smur = mu[col], smuk = mu[512 + col], smuv = mu[1024 + col], ska = p.k_a[l * 512 + col];
        const int tk0 = NTOKP + bs * 4;
        const hf* up = U + (size_t)(NTOK + bs) * PIN + col;
        float rp = (float)up[0], kp = (float)up[512], vp = (float)up[1024];
#pragma unroll
        for (int i = 0; i < 4; ++i) {
            const int tk = tk0 + i, t = pw * 4 + i;
            const hf* ut = U + (size_t)tk * PIN + col;
            const float rc = (float)ut[0], kc = (float)ut[512], vc = (float)ut[1024];
            const float e = (float)EA[(size_t)tk * D + col], a = (float)EA[(size_t)tk * D + 512 + col];
            const float kk = (float)KKB[(size_t)tk * D + col], bb = (float)KKB[(size_t)tk * D + 512 + col];
            OP[(t * 5 + 0) * 64 + lane] = rc + (rp - rc) * smur;
            OP[(t * 5 + 1) * 64 + lane] = __expf(-e);
            OP[(t * 5 + 2) * 64 + lane] = a;
            OP[(t * 5 + 3) * 64 + lane] = kk;
            OP[(t * 5 + 4) * 64 + lane] = bb;
            VS[t * 64 + lane] = vc + (vp - vc) * smuv;
            rp = rc; kp = kc; vp = vc;
        }
    } else {
        *(f32x4*)(p.out + O_WKV_P + ((((size_t)l * 8 + pb) * 8 + ph) * 64 + rg * 16 + pw * 4 + rl) * 64 + ks * 4) = (f32x4){S.lo.x, S.lo.y, S.hi.x, S.hi.y};
#pragma unroll
        for (int q = 0; q < 4; ++q) {
            const int id = blk * 4 + q, bs = id >> 3, h = id & 7;
#pragma unroll
            for (int g = 0; g < 4; ++g) {
                const int row = pw * 16 + g * 4 + rl;
                St[q][g] = *(const f32x4*)(p.state_wkv + ((((size_t)l * 128 + bs) * 8 + h) * 64 + row) * 64 + ks * 4);
            }
        }
    }
    __syncthreads();
    if (!producer) {
#pragma unroll
        for (int q = 0; q < 4; ++q) {
            const int id = blk * 4 + q, bs = id >> 3, h = id & 7;
#pragma unroll
            for (int g = 0; g < 4; ++g) {
                const int row = pw * 16 + g * 4 + rl;
                WkvS Sq; Sq.lo = St[q][g].lo; Sq.hi = St[q][g].hi;
                float ykeep = 0.f;
#pragma unroll
                for (int t = 0; t < 4; ++t) {
                    float y;
                    wkv_step(Sq, OP + ((q * 4 + t) * 5) * 64 + ks * 4, VS[(q * 4 + t) * 64 + row], y);
                    ykeep = (ks == t) ? y : ykeep;
                }
                *(f32x4*)(p.out + O_WKV_S + ((((size_t)l * 128 + bs) * 8 + h) * 64 + row) * 64 + ks * 4) = (f32x4){Sq.lo.x, Sq.lo.y, Sq.hi.x, Sq.hi.y};
                if (ks < 4) MIX[(size_t)(NTOKP + bs * 4 + ks) * D + h * 64 + row] = (hf)ykeep;
            }
        }
    }
    __syncthreads();
}

__device__ __forceinline__ void phase5a(const Params& p, int l, hf* DST = nullptr) {
    const int tid = tid_(); const int lane = tid & 63, wave = tid >> 6;
    const hf* U = (const hf*)(p.ws + WS_U);
    const hf* EA = (const hf*)(p.ws + WS_EA);
    hf* MIX = (hf*)(p.ws + WS_MIX);
    hf* OUT = DST ? DST : MIX;
    const float* mu = p.mu + (size_t)l * PRW;
    const int ti = lane >> 4, c4 = (lane & 15) * 4;
    struct It { hf4 uc[4], up[4], a, y; };
    constexpr int NIT = (NTOK / 4) * 8;
    const int stride = gridDim.x * 8;
    auto load = [&](int it, It& q) {
        const int tk = (it >> 3) * 4 + ti, col = (it & 7) * 64 + c4;
        const int pr = prev_row(tk);
        const hf* ut = U + (size_t)tk * PIN + col;
        const hf* up = U + (size_t)(pr >= 0 ? pr : 0) * PIN + col;
#pragma unroll
        for (int c = 0; c < 4; ++c) { if (c == 1) continue; q.uc[c] = *(const hf4*)(ut + 512 * c); q.up[c] = *(const hf4*)(up + 512 * c); }
        q.a = *(const hf4*)(EA + (size_t)tk * D + 512 + col);
        q.y = *(const hf4*)(MIX + (size_t)tk * D + col);
    };
    auto cvt4 = [](hf4 x) { return (f32x4){(float)x.x, (float)x.y, (float)x.z, (float)x.w}; };
    auto compute = [&](int it, const It& q) {
        const int tk = (it >> 3) * 4 + ti, col = (it & 7) * 64 + c4;
        const float pm = prev_row(tk) >= 0 ? 1.f : 0.f;
        const f32x4 mr = *(const f32x4*)(mu + col), mk = *(const f32x4*)(mu + 512 + col), mv = *(const f32x4*)(mu + 1024 + col), mg = *(const f32x4*)(mu + 1536 + col);
        const f32x4 ka = *(const f32x4*)(p.k_a + l * 512 + col), rk = *(const f32x4*)(p.r_k + l * 512 + col);
        const f32x4 gg = *(const f32x4*)(p.gn_r_g + l * 512 + col), gb = *(const f32x4*)(p.gn_r_b + l * 512 + col);
        const f32x4 rc = cvt4(q.uc[0]), vc = cvt4(q.uc[2]), gc = cvt4(q.uc[3]);
        const f32x4 r = rc + (cvt4(q.up[0]) * pm - rc) * mr;
        const f32x4 v = vc + (cvt4(q.up[2]) * pm - vc) * mv, g = gc + (cvt4(q.up[3]) * pm - gc) * mg;
        const f32x4 km = cvt4(q.a);
        const f32x4 y = cvt4(q.y);
        const f32x4 y2 = y * y, bo = r * km * rk;
        float s1 = (y.x + y.y) + (y.z + y.w), s2 = (y2.x + y2.y) + (y2.z + y2.w), s3 = (bo.x + bo.y) + (bo.z + bo.w);
        s1 = row_allreduce16(s1); s2 = row_allreduce16(s2); s3 = row_allreduce16(s3);
        const float mean = s1 * (1.f / 64.f);
        const float var = fmaxf(s2 * (1.f / 64.f) - mean * mean, 0.f);
        const float rs = rsqrtf(var + 64e-5f);
        const f32x4 yn = (y - mean) * rs * gg + gb;
        const f32x4 t = yn + s3 * v;
        hf4 o = {(hf)(t.x * silu(g.x)), (hf)(t.y * silu(g.y)), (hf)(t.z * silu(g.z)), (hf)(t.w * silu(g.w))};
        const u32x2 uo = __builtin_bit_cast(u32x2, o);
        const unsigned n0 = (unsigned)__builtin_amdgcn_update_dpp(0, (int)uo.x, 0x101, 0xf, 0xf, false);
        const unsigned n1 = (unsigned)__builtin_amdgcn_update_dpp(0, (int)uo.y, 0x101, 0xf, 0xf, false);
        if ((lane & 1) == 0) st16_wt(OUT + (size_t)tk * D + col, (u32x4){uo.x, uo.y, n0, n1});
    };
    It qa, qb;
    int it = blockIdx.x * 8 + wave;
    if (it < NIT) load(it, qa);
    while (it < NIT) {
        const int nx = it + stride;
        if (nx < NIT) load(nx, qb);
        compute(it, qa);
        qa = qb;
        it = nx;
    }
}

__device__ __forceinline__ void phase6(const Params& p) {
    const int tid = tid_(); const int lane = tid & 63, wave = tid >> 6;
    const float* MOD = (const float*)(p.ws + WS_MOD);
    struct Row { f32x4 x[4]; hf4 m0[4], m1[4]; };
    const int stride = gridDim.x * 8;
    auto load = [&](int tk, Row& q) {
        const float* xr = x0_row(p, tk);
        const hf* mo = (const hf*)(p.out + O_Y + (size_t)tk * D);
#pragma unroll
        for (int j = 0; j < 4; ++j) {
            q.x[j] = *(const f32x4*)(xr + 256 * j + 4 * lane);
            q.m0[j] = *(const hf4*)(mo + 256 * j + 4 * lane);
            q.m1[j] = *(const hf4*)(mo + 1024 + 256 * j + 4 * lane);
        }
    };
    Row qa, qb;
    int tk = blockIdx.x * 8 + wave;
    if (tk < NTOK) load(tk, qa);
    while (tk < NTOK) {
        const int nx = tk + stride;
        if (nx < NTOK) load(nx, qb);
        const int sq = seq_of(tk);
        float* yr = p.out + O_Y + (size_t)tk * D;
        f32x4 m0[4], m1[4];
        float s0 = 0.f, s1 = 0.f;
#pragma unroll
        for (int j = 0; j < 4; ++j) {
            m0[j] = (f32x4){(float)qa.m0[j].x, (float)qa.m0[j].y, (float)qa.m0[j].z, (float)qa.m0[j].w};
            m1[j] = (f32x4){(float)qa.m1[j].x, (float)qa.m1[j].y, (float)qa.m1[j].z, (float)qa.m1[j].w};
            s0 += m0[j].x * m0[j].x + m0[j].y * m0[j].y + m0[j].z * m0[j].z + m0[j].w * m0[j].w;
            s1 += m1[j].x * m1[j].x + m1[j].y * m1[j].y + m1[j].z * m1[j].z + m1[j].w * m1[j].w;
        }
        const float r0 = rsqrtf(wave_sum_all(s0) * (1.f / D) + 1e-6f);
        const float r1 = rsqrtf(wave_sum_all(s1) * (1.f / D) + 1e-6f);
#pragma unroll
        for (int j = 0; j < 4; ++j) {
            f32x4 gp0 = *(const f32x4*)(p.g_post + 256 * j + 4 * lane);
            f32x4 gp1 = *(const f32x4*)(p.g_post + D + 256 * j + 4 * lane);
            f32x4 gt0 = *(const f32x4*)(MOD + (size_t)sq * 6144 + 2048 + 256 * j + 4 * lane);
            f32x4 gt1 = *(const f32x4*)(MOD + (size_t)sq * 6144 + 3072 + 2048 + 256 * j + 4 * lane);
            f32x4 y = qa.x[j] + gt0 * (m0[j] * r0 * gp0);
            y = y + gt1 * (m1[j] * r1 * gp1);
            *(f32x4*)(yr + 256 * j + 4 * lane) = y;
        }
        qa = qb;
        tk = nx;
    }
}

constexpr int NPHASES = 14;
__device__ __forceinline__ void run_phase(const Params& p, int ph, unsigned char* smem) {
    if (ph == 0) { phase0(p, smem); return; }
    if (ph == 13) { phase6(p); return; }
    const int l = (ph - 1) / 6, s = (ph - 1) % 6;
    switch (s) {
        case 0: phase1(p, l); break;
        case 1: phase2(p, l, smem); break;
        case 2: phase3(p, l, smem); break;
        case 3: phase4(p, l, smem); break;
        case 4: phase5a(p, l); break;
        default: phase5b(p, l, smem); break;
    }
}

#define GSYNC() xcd_barrier(xb)
__global__ void __launch_bounds__(NTHR) fwd_mega(Params p) {
    extern __shared__ __attribute__((aligned(16))) unsigned char smem[];
    volatile LAS unsigned* st = (volatile LAS unsigned*)(smem + LDS_BYTES - 16);
    if (threadIdx.x == 0) { st[0] = 0u; st[1] = 0u; }
    __syncthreads();
    XcdBarrier xb = xcd_barrier_post((unsigned*)(p.ws + WS_BAR), st);
    if (p.ws == nullptr) cg::this_grid().sync();
    phase0(p, smem); GSYNC();
    phase1(p, 0); GSYNC();
    phase2(p, 0, smem); GSYNC();
    phase3(p, 0, smem); GSYNC();
    phase4(p, 0, smem); GSYNC();
    phase5a(p, 0); GSYNC();
    phase5b(p, 0, smem); GSYNC();
    phase1(p, 1); GSYNC();
    phase2(p, 1, smem); GSYNC();
    phase3(p, 1, smem); GSYNC();
    phase4(p, 1, smem); GSYNC();
    phase5a(p, 1); GSYNC();
    phase5b(p, 1, smem); GSYNC();
    phase6(p);
}
__global__ void __launch_bounds__(NTHR) fwd_phase(Params p, int ph) {
    extern __shared__ __attribute__((aligned(16))) unsigned char smem[];
    run_phase(p, ph, smem);
}

extern "C" void kernel_launch(void* const* d_in, const int* in_sizes, int n_in, void* d_out, int out_size, void* d_ws, size_t ws_size,
                              hipStream_t stream) {
    static int ok = 0;
    if (ok == 0) {
        ok = 1;
        if (n_in != 27 || (size_t)out_size != O_END || ws_size < WS_END) {
            fprintf(stderr, "kernel_launch: unexpected sizes n_in %d out %d ws %zu (need %zu)\n", n_in, out_size, ws_size, (size_t)WS_END);
            ok = -1;
        }
        int dev = 0, cus = 0, per_cu = 0;
        (void)hipGetDevice(&dev);
        (void)hipDeviceGetAttribute(&cus, hipDeviceAttributeMultiprocessorCount, dev);
        (void)hipFuncSetAttribute((const void*)fwd_mega, hipFuncAttributeMaxDynamicSharedMemorySize, LDS_BYTES);
        (void)hipFuncSetAttribute((const void*)fwd_phase, hipFuncAttributeMaxDynamicSharedMemorySize, LDS_BYTES);
        (void)hipOccupancyMaxActiveBlocksPerMultiprocessor(&per_cu, (const void*)fwd_mega, NTHR, LDS_BYTES);
        if (cus * per_cu < GRID) {
            fprintf(stderr, "kernel_launch: resident capacity %d x %d < grid %d\n", cus, per_cu, GRID);
            ok = -1;
        }
    }
    if (ok < 0) return;
    Params p{};
    const float** pp = (const float**)&p;
    for (int i = 0; i < 27; ++i) pp[i] = (const float*)d_in[i];
    p.out = (float*)d_out;
    p.ws = (unsigned char*)d_ws;
#if MULTI_LAUNCH
    for (int ph = 0; ph < NPHASES; ++ph) hipLaunchKernelGGL(fwd_phase, dim3(GRID), dim3(NTHR), LDS_BYTES, stream, p, ph);
#else
    (void)hipMemsetAsync((unsigned char*)d_ws + WS_BAR, 0, 16384, stream);
    void* args[] = {&p};
    hipError_t e = hipLaunchCooperativeKernel((const void*)fwd_mega, dim3(GRID), dim3(NTHR), args, LDS_BYTES, stream);
    if (e != hipSuccess) fprintf(stderr, "cooperative launch failed: %s\n", hipGetErrorString(e));
#endif
}
```

```cpp
#include <hip/hip_runtime.h>
#include <hip/hip_cooperative_groups.h>
#include <cstdio>
namespace cg = cooperative_groups;

#ifndef MULTI_LAUNCH
#define MULTI_LAUNCH 0
#endif

typedef _Float16 hf;
typedef hf hf8 __attribute__((ext_vector_type(8)));
typedef hf hf4 __attribute__((ext_vector_type(4)));
typedef hf hf2 __attribute__((ext_vector_type(2)));
typedef float f32x4 __attribute__((ext_vector_type(4)));

constexpr int D = 1024;
constexpr int NTOKP = 16384, NTOKS = 512, NTOK = 16896, NSEQ = 136;
constexpr int PIN = 3712, PRW = 2176;
constexpr int MROWS = NTOK + 128;
constexpr int MPAD = 17152;
constexpr int NTHR = 512;
constexpr int GRID = 256;

constexpr int PINP = 3840;
constexpr size_t WS_WTIN = 0;
constexpr size_t WS_WTOUT = WS_WTIN + (size_t)2 * PINP * D * 2;
constexpr size_t WS_WUPT = WS_WTOUT + (size_t)2 * D * D * 2;
constexpr size_t WS_AUPT = WS_WUPT + (size_t)2 * 512 * 64 * 2;
constexpr size_t WS_MOD = WS_AUPT + (size_t)2 * 512 * 64 * 2;
constexpr size_t WS_H = WS_MOD + (size_t)NSEQ * 6144 * 4;
constexpr size_t WS_U = WS_H + (size_t)MPAD * D * 2;
constexpr size_t WS_EA = WS_U + (size_t)MROWS * PIN * 2;
constexpr size_t WS_MIX = WS_EA + (size_t)NTOK * D * 2;
constexpr size_t WS_BAR = WS_MIX + (size_t)NTOK * D * 2;
constexpr size_t WS_END = WS_BAR + 16384;

constexpr size_t O_Y = 0;
constexpr size_t O_SHIFT_P = (size_t)NTOK * D;
constexpr size_t O_WKV_P = O_SHIFT_P + 2 * 8 * 1024;
constexpr size_t O_CONV_P = O_WKV_P + (size_t)2 * 8 * 8 * 4096;
constexpr size_t O_SHIFT_S = O_CONV_P + (size_t)2 * 8 * 30 * 512;
constexpr size_t O_WKV_S = O_SHIFT_S + (size_t)2 * 128 * 1024;
constexpr size_t O_CONV_S = O_WKV_S + (size_t)2 * 128 * 8 * 4096;
constexpr size_t O_END = O_CONV_S + (size_t)2 * 128 * 30 * 512;

constexpr int LDS_BYTES = 132 * 1024;

struct Params {
    const float *x_prompt, *x_sample, *c_prompt, *c_sample, *state_shift, *state_wkv, *state_conv;
    const float *w_ada, *b_ada, *g_pre, *g_post, *w_in, *mu, *w0, *w_up, *a0, *a_up, *k_k, *k_a, *r_k;
    const float *gn_r_g, *gn_r_b, *w_dw, *b_dw, *gn_c_g, *gn_c_b, *w_out;
    float* out;
    unsigned char* ws;
};

typedef unsigned u32x2 __attribute__((ext_vector_type(2)));
typedef unsigned u32x4 __attribute__((ext_vector_type(4)));
__device__ __forceinline__ void st16_wt(void* p, u32x4 v) { asm volatile("global_store_dwordx4 %0, %1, off sc1\n\ts_nop 1" :: "v"(p), "v"(v) : "memory"); }
__device__ __forceinline__ int tid_() { int t = threadIdx.x; asm volatile("" : "+v"(t)); return t; }
template <int CTRL>
__device__ __forceinline__ float dpp_mov(float v) {
    return __builtin_bit_cast(float, __builtin_amdgcn_update_dpp(0, __builtin_bit_cast(int, v), CTRL, 0xf, 0xf, false));
}
__device__ __forceinline__ float row_allreduce16(float v) {
    v += dpp_mov<0x128>(v);
    v += dpp_mov<0x124>(v);
    v += dpp_mov<0x122>(v);
    v += dpp_mov<0x121>(v);
    return v;
}
__device__ __forceinline__ float wave_sum(float v) {
    v = row_allreduce16(v);
    v += __shfl_xor(v, 16);
    v += __shfl_xor(v, 32);
    return v;
}
__device__ __forceinline__ float wave_sum_all(float v) {
    v = row_allreduce16(v);
    v += __builtin_bit_cast(float, __builtin_amdgcn_update_dpp(0, __builtin_bit_cast(int, v), 0x142, 0xa, 0xf, false));
    v += __builtin_bit_cast(float, __builtin_amdgcn_update_dpp(0, __builtin_bit_cast(int, v), 0x143, 0xc, 0xf, false));
    return __builtin_bit_cast(float, __builtin_amdgcn_readlane(__builtin_bit_cast(int, v), 63));
}
__device__ __forceinline__ float sigm(float x) { return __builtin_amdgcn_rcpf(1.f + __expf(-x)); }
__device__ __forceinline__ float silu(float x) { return x * __builtin_amdgcn_rcpf(1.f + __expf(-x)); }
__device__ __forceinline__ float silu2(float a, float b) { return (a * b) * __builtin_amdgcn_rcpf((1.f + __expf(-a)) * (1.f + __expf(-b))); }
__device__ __forceinline__ float tanh_fast(float x) { float t = __expf(2.f * x); return 1.f - 2.f * __builtin_amdgcn_rcpf(t + 1.f); }

__device__ __forceinline__ int seq_of(int tk) { return tk < NTOKP ? (tk >> 11) : 8 + ((tk - NTOKP) >> 2); }
__device__ __forceinline__ bool is_last_tok(int tk) { return tk < NTOKP ? ((tk & 2047) == 2047) : (((tk - NTOKP) & 3) == 3); }
__device__ __forceinline__ int prev_row(int tk) {
    if (tk < NTOKP) return (tk & 2047) ? tk - 1 : -1;
    int s = tk - NTOKP;
    return (s & 3) ? tk - 1 : NTOK + (s >> 2);
}
__device__ __forceinline__ const float* x0_row(const Params& p, int tk) {
    return tk < NTOKP ? p.x_prompt + (size_t)tk * D : p.x_sample + (size_t)(tk - NTOKP) * D;
}


#define XB_TMO      128
#define XB_XCNT(j)  (256  + 64 * (j))
#define XB_XSUB(j)  (1280 + 64 * (j))
#define XB_XGEN(j)  (2304 + 64 * (j))
#define XB_TOP      3328
#define XB_TOPGEN   3392
#define XCD_BAR_WORDS 3456
#define XB_SPIN_CAP (1u << 22)
#define LAS __attribute__((address_space(3)))
__device__ __forceinline__ unsigned xb_ld(unsigned* p)              { return __hip_atomic_load(p, __ATOMIC_RELAXED, __HIP_MEMORY_SCOPE_AGENT); }
__device__ __forceinline__ unsigned xb_add(unsigned* p, unsigned v) { return __hip_atomic_fetch_add(p, v, __ATOMIC_RELAXED, __HIP_MEMORY_SCOPE_AGENT); }
__device__ __forceinline__ unsigned xb_xcc_id() { return (unsigned)__builtin_amdgcn_s_getreg((3 << 11) | 20) & 0xFu; }
#define XB_SPIN(cond, bar) do { unsigned _sp = 0; while (cond) { __builtin_amdgcn_s_sleep(1); \
    if ((++_sp & 255u) == 0u) { if (xb_ld(&(bar)[XB_TMO])) break; if (_sp > XB_SPIN_CAP) { atomicAdd(&(bar)[XB_TMO], 1u); break; } } } } while (0)
struct XcdBarrier { unsigned* bar; unsigned x; volatile LAS unsigned* st; };
__device__ __forceinline__ XcdBarrier xcd_barrier_post(unsigned* bar, volatile LAS unsigned* st) {
    XcdBarrier b; b.bar = bar; b.x = xb_xcc_id(); b.st = st;
    if (threadIdx.x == 0) (void)xb_add(&bar[XB_XCNT(b.x)], 1u);
    return b;
}
__device__ __forceinline__ void xcd_barrier_complete(unsigned* bar, unsigned x, unsigned& nloc, unsigned& nx) {
    const unsigned G = gridDim.x * gridDim.y * gridDim.z;
    unsigned sum, cnt, mine, sp = 0u;
    for (;;) {
        sum = 0u; cnt = 0u; mine = 0u;
#pragma unroll
        for (unsigned j = 0; j < 16; ++j) { const unsigned c = xb_ld(&bar[XB_XCNT(j)]); sum += c; cnt += (c > 0u) ? 1u : 0u; mine = (j == x) ? c : mine; }
        if (sum == G) break;
        __builtin_amdgcn_s_sleep(1);
        if ((++sp & 255u) == 0u) { if (xb_ld(&bar[XB_TMO])) break; if (sp > XB_SPIN_CAP) { atomicAdd(&bar[XB_TMO], 1u); break; } }
    }
    nloc = mine > 0u ? mine : 1u; nx = cnt > 0u ? cnt : 1u;
}
__device__ __forceinline__ void xcd_barrier(const XcdBarrier& b) {
    asm volatile("s_waitcnt vmcnt(0)" ::: "memory");
    __syncthreads();
    if (threadIdx.x == 0) {
        unsigned* bar = b.bar;
        __builtin_amdgcn_s_waitcnt(0);
        unsigned nloc = b.st[0], nx = b.st[1];
        if (nloc == 0u) { xcd_barrier_complete(bar, b.x, nloc, nx); b.st[0] = nloc; b.st[1] = nx; }
        const unsigned old = xb_add(&bar[XB_XSUB(b.x)], 1u);
        const unsigned gen = old / nloc;
        if (old + 1u == (gen + 1u) * nloc) {
            __builtin_amdgcn_fence(__ATOMIC_RELEASE, "agent");
            asm volatile("s_waitcnt vmcnt(0)" ::: "memory");
            const unsigned og = xb_add(&bar[XB_TOP], 1u);
            const unsigned tg = og / nx;
            if (og + 1u == (tg + 1u) * nx) xb_add(&bar[XB_TOPGEN], 1u);
            else XB_SPIN(xb_ld(&bar[XB_TOPGEN]) == tg, bar);
            __builtin_amdgcn_fence(__ATOMIC_ACQUIRE, "agent");
            xb_add(&bar[XB_XGEN(b.x)], 1u);
            asm volatile("s_waitcnt vmcnt(0)" ::: "memory");
        } else {
            XB_SPIN(xb_ld(&bar[XB_XGEN(b.x)]) == gen, bar);
            __builtin_amdgcn_fence(__ATOMIC_ACQUIRE, "agent");
            asm volatile("s_waitcnt vmcnt(0)" ::: "memory");
        }
    }
    __syncthreads();
}

__device__ __forceinline__ void p0_transpose(const float* __restrict__ W, int K, int N, hf* __restrict__ WT, int item, float* lds) {
    const int nb = N / 64;
    const int kb = item / nb, nbk = item % nb, k0 = kb * 64, n0 = nbk * 64;
    const int tid = tid_();
#pragma unroll
    for (int i = 0; i < 8; ++i) {
        int kk = (tid >> 6) + 8 * i, c = tid & 63;
        lds[kk * 65 + c] = W[(size_t)(k0 + kk) * N + n0 + c];
    }
    __syncthreads();
    const int n = tid >> 3, kc = (tid & 7) * 8;
    hf8 o;
#pragma unroll
    for (int j = 0; j < 8; ++j) o[j] = (hf)lds[(kc + j) * 65 + n];
    *(hf8*)(WT + (size_t)(n0 + n) * K + k0 + kc) = o;
    __syncthreads();
}

__device__ __forceinline__ void p0_adaln(const Params& p, int item, unsigned char* smem) {
    hf* SC = (hf*)smem;
    hf* Wt = SC + 144 * 72;
    float* MOD = (float*)(p.ws + WS_MOD);
    const int gc0 = item * 32;
    const int l = gc0 / 3072, lc0 = gc0 % 3072;
    const float* W = p.w_ada + (size_t)l * 1024 * 3072;
    const int tid = tid_(), lane = tid & 63, wave = tid >> 6;
    const int nt = wave & 1, mg = wave >> 1;
    const int mt0 = (mg == 0) ? 0 : (2 * mg + 1);
    const int nmt = (mg == 0) ? 3 : 2;
    f32x4 acc[3];
#pragma unroll
    for (int i = 0; i < 3; ++i) acc[i] = (f32x4){0.f, 0.f, 0.f, 0.f};
    float cv[17], wv[4];
    auto gload = [&](int kt) {
        const int k0 = kt * 64;
#pragma unroll
        for (int i = 0; i < 17; ++i) {
            const int e = tid + 512 * i, row = e >> 6, k = e & 63;
            const float* cr = row < 8 ? p.c_prompt + row * 1024 : p.c_sample + (row - 8) * 1024;
            cv[i] = cr[k0 + k];
        }
#pragma unroll
        for (int i = 0; i < 4; ++i) {
            const int e = tid + 512 * i, kk = e >> 5, n = e & 31;
            wv[i] = W[(size_t)(k0 + kk) * 3072 + lc0 + n];
        }
    };
    gload(0);
    { int row = 136 + (tid >> 6), k = tid & 63; SC[row * 72 + k] = (hf)0.f; }
    for (int kt = 0; kt < 16; ++kt) {
#pragma unroll
        for (int i = 0; i < 17; ++i) {
            const int e = tid + 512 * i, row = e >> 6, k = e & 63;
            SC[row * 72 + k] = (hf)silu(cv[i]);
        }
#pragma unroll
        for (int i = 0; i < 4; ++i) {
            const int e = tid + 512 * i, kk = e >> 5, n = e & 31;
            Wt[n * 72 + kk] = (hf)wv[i];
        }
        __syncthreads();
        if (kt + 1 < 16) gload(kt + 1);
#pragma unroll
        for (int ks = 0; ks < 2; ++ks) {
            hf8 bfrag = *(const hf8*)(Wt + (nt * 16 + (lane & 15)) * 72 + ks * 32 + (lane >> 4) * 8);
#pragma unroll
            for (int i = 0; i < 3; ++i) {
                if (i < nmt) {
                    hf8 afrag = *(const hf8*)(SC + ((mt0 + i) * 16 + (lane & 15)) * 72 + ks * 32 + (lane >> 4) * 8);
                    acc[i] = __builtin_amdgcn_mfma_f32_16x16x32_f16(bfrag, afrag, acc[i], 0, 0, 0);
                }
            }
        }
        __syncthreads();
    }
#pragma unroll
    for (int i = 0; i < 3; ++i) {
        if (i < nmt) {
            int row = (mt0 + i) * 16 + (lane & 15);
            if (row < NSEQ) {
#pragma unroll
                for (int j = 0; j < 4; ++j) {
                    int gc = gc0 + nt * 16 + (lane >> 4) * 4 + j;
                    MOD[(size_t)row * 6144 + gc] = acc[i][j] + p.b_ada[gc];
                }
            }
        }
    }
}

__device__ __forceinline__ void phase0(const Params& p, unsigned char* smem) {
    constexpr int I_ADA = 192;
    constexpr int I_WIN = 16 * 58;
    constexpr int I_WOUT = 16 * 16;
    constexpr int I_LORA = 8;
    constexpr int NITEMS = I_ADA + 2 * (I_WIN + I_WOUT + 2 * I_LORA);
    constexpr int NTR = NITEMS - I_ADA;
    constexpr int EXTRA = 6;
    auto transpose_item = [&](int r) {
        const int l = r / (I_WIN + I_WOUT + 2 * I_LORA);
        r = r % (I_WIN + I_WOUT + 2 * I_LORA);
        float* lds = (float*)smem;
        if (r < I_WIN) { p0_transpose(p.w_in + (size_t)l * D * PIN, D, PIN, (hf*)(p.ws + WS_WTIN) + (size_t)l * PINP * D, r, lds); return; }
        r -= I_WIN;
        if (r < I_WOUT) { p0_transpose(p.w_out + (size_t)l * D * D, D, D, (hf*)(p.ws + WS_WTOUT) + (size_t)l * D * D, r, lds); return; }
        r -= I_WOUT;
        if (r < I_LORA) { p0_transpose(p.w_up + (size_t)l * 64 * 512, 64, 512, (hf*)(p.ws + WS_WUPT) + (size_t)l * 512 * 64, r, lds); return; }
        r -= I_LORA;
        p0_transpose(p.a_up + (size_t)l * 64 * 512, 64, 512, (hf*)(p.ws + WS_AUPT) + (size_t)l * 512 * 64, r, lds);
    };
    const int nb = gridDim.x, b = blockIdx.x;
    const int nfree = nb > I_ADA ? nb - I_ADA : 0;
    const int nextra = min(nfree * EXTRA, NTR);
    for (int it = b; it < I_ADA; it += nb) p0_adaln(p, it, smem);
    if (b >= I_ADA) for (int i = 0; i < EXTRA; ++i) { const int r = (b - I_ADA) + nfree * i; if (r < nextra) transpose_item(r); }
    for (int r = nextra + b; r < NTR; r += nb) transpose_item(r);
}

__device__ __forceinline__ void phase1(const Params& p, int l) {
    const int tid = tid_(); const int lane = tid & 63, wave = tid >> 6;
    hf* H = (hf*)(p.ws + WS_H);
    const float* MOD = (const float*)(p.ws + WS_MOD);
    auto coff = [&](int q) { return 512 * (q >> 1) + 8 * lane + 4 * (q & 1); };
    for (int tk = blockIdx.x * 8 + wave; tk < MROWS; tk += gridDim.x * 8) {
        if (tk >= NTOK) {
            const int bs = tk - NTOK;
            const float* s = p.state_shift + ((size_t)l * 128 + bs) * D;
#pragma unroll
            for (int j = 0; j < 2; ++j) {
                const f32x4 v0 = *(const f32x4*)(s + coff(2 * j)), v1 = *(const f32x4*)(s + coff(2 * j + 1));
                const hf8 o = {(hf)v0.x, (hf)v0.y, (hf)v0.z, (hf)v0.w, (hf)v1.x, (hf)v1.y, (hf)v1.z, (hf)v1.w};
                st16_wt(H + (size_t)tk * D + coff(2 * j), __builtin_bit_cast(u32x4, o));
            }
            continue;
        }
        const int sq = seq_of(tk);
        const float* xr = x0_row(p, tk);
        f32x4 x[4];
#pragma unroll
        for (int q = 0; q < 4; ++q) x[q] = *(const f32x4*)(xr + coff(q));
        if (l == 1) {
            const hf* mo = (const hf*)(p.out + O_Y + (size_t)tk * D);
            f32x4 m[4];
            float ss = 0.f;
#pragma unroll
            for (int q = 0; q < 4; ++q) {
                hf4 t = *(const hf4*)(mo + coff(q));
                m[q] = (f32x4){(float)t.x, (float)t.y, (float)t.z, (float)t.w};
                ss += m[q].x * m[q].x + m[q].y * m[q].y + m[q].z * m[q].z + m[q].w * m[q].w;
            }
            const float rs = rsqrtf(wave_sum_all(ss) * (1.f / D) + 1e-6f);
#pragma unroll
            for (int q = 0; q < 4; ++q) {
                f32x4 gp = *(const f32x4*)(p.g_post + coff(q));
                f32x4 gt = *(const f32x4*)(MOD + (size_t)sq * 6144 + 2048 + coff(q));
                x[q] = x[q] + gt * (m[q] * rs * gp);
            }
        }
        float ss = 0.f;
#pragma unroll
        for (int q = 0; q < 4; ++q) ss += x[q].x * x[q].x + x[q].y * x[q].y + x[q].z * x[q].z + x[q].w * x[q].w;
        const float rs = rsqrtf(wave_sum_all(ss) * (1.f / D) + 1e-6f);
        const bool last = is_last_tok(tk);
        float* so = nullptr;
        if (last) so = (sq < 8) ? p.out + O_SHIFT_P + ((size_t)l * 8 + sq) * D : p.out + O_SHIFT_S + ((size_t)l * 128 + (sq - 8)) * D;
        f32x4 h[4];
#pragma unroll
        for (int q = 0; q < 4; ++q) {
            f32x4 g = *(const f32x4*)(p.g_pre + (size_t)l * D + coff(q));
            f32x4 sh = *(const f32x4*)(MOD + (size_t)sq * 6144 + l * 3072 + coff(q));
            f32x4 sc = *(const f32x4*)(MOD + (size_t)sq * 6144 + l * 3072 + 1024 + coff(q));
            h[q] = (x[q] * rs * g) * (1.f + sc) + sh;
            if (last) *(f32x4*)(so + coff(q)) = h[q];
        }
#pragma unroll
        for (int j = 0; j < 2; ++j) {
            const f32x4 v0 = h[2 * j], v1 = h[2 * j + 1];
            const hf8 o = {(hf)v0.x, (hf)v0.y, (hf)v0.z, (hf)v0.w, (hf)v1.x, (hf)v1.y, (hf)v1.z, (hf)v1.w};
            st16_wt(H + (size_t)tk * D + coff(2 * j), __builtin_bit_cast(u32x4, o));
        }
    }
}

constexpr int G_BM = 256, G_BN = 128, G_BK = 64, G_LD = 72;
constexpr int G_ASZ = G_BM * G_LD, G_BSZ = G_BN * G_LD;
template <int EPI>
__device__ __forceinline__ void gemm_tile(const hf* __restrict__ A, const hf* __restrict__ Bt, hf* __restrict__ C, int m0, int n0, int mlimit, int ldc, unsigned char* smem) {
    hf* As = (hf*)smem;
    hf* Bs = As + 2 * G_ASZ;
    const int tid = tid_(), lane = tid & 63, wave = tid >> 6;
    const int wm = wave >> 1, wn = wave & 1;
    const int fr = lane & 15, fq = lane >> 4;
    f32x4 acc[4][4];
#pragma unroll
    for (int i = 0; i < 4; ++i)
#pragma unroll
        for (int j = 0; j < 4; ++j) acc[i][j] = (f32x4){0.f, 0.f, 0.f, 0.f};
    hf8 ra[4], rb[2];
    const int lrow = tid >> 3, lkc = (tid & 7) * 8;
    auto gload = [&](int kt) {
#pragma unroll
        for (int i = 0; i < 4; ++i) ra[i] = *(const hf8*)(A + (size_t)(m0 + lrow + 64 * i) * D + kt * G_BK + lkc);
#pragma unroll
        for (int i = 0; i < 2; ++i) rb[i] = *(const hf8*)(Bt + (size_t)(n0 + lrow + 64 * i) * D + kt * G_BK + lkc);
    };
    auto lstore = [&](int buf) {
#pragma unroll
        for (int i = 0; i < 4; ++i) *(hf8*)(As + buf * G_ASZ + (lrow + 64 * i) * G_LD + lkc) = ra[i];
#pragma unroll
        for (int i = 0; i < 2; ++i) *(hf8*)(Bs + buf * G_BSZ + (lrow + 64 * i) * G_LD + lkc) = rb[i];
    };
    gload(0);
    lstore(0);
    __syncthreads();
    constexpr int NKT = D / G_BK;
    for (int kt = 0; kt < NKT; ++kt) {
        const int buf = kt & 1;
        if (kt + 1 < NKT) gload(kt + 1);
        const hf* as = As + buf * G_ASZ + (wm * 64 + fr) * G_LD + fq * 8;
        const hf* bs = Bs + buf * G_BSZ + (wn * 64 + fr) * G_LD + fq * 8;
#pragma unroll
        for (int ks = 0; ks < 2; ++ks) {
            hf8 af[4], bf[4];
#pragma unroll
            for (int i = 0; i < 4; ++i) af[i] = *(const hf8*)(as + i * 16 * G_LD + ks * 32);
#pragma unroll
            for (int i = 0; i < 4; ++i) bf[i] = *(const hf8*)(bs + i * 16 * G_LD + ks * 32);
#pragma unroll
            for (int i = 0; i < 4; ++i)
#pragma unroll
                for (int j = 0; j < 4; ++j)
                    acc[i][j] = __builtin_amdgcn_mfma_f32_16x16x32_f16(bf[j], af[i], acc[i][j], 0, 0, 0);
        }
        if (kt + 1 < NKT) lstore(buf ^ 1);
        __syncthreads();
    }
#pragma unroll
    for (int i = 0; i < 4; ++i) {
        const int row = m0 + wm * 64 + i * 16 + fr;
        if (row < mlimit) {
#pragma unroll
            for (int j = 0; j < 4; ++j) {
                const int col = n0 + wn * 64 + j * 16 + fq * 4;
                hf4 o = {(hf)acc[i][j][0], (hf)acc[i][j][1], (hf)acc[i][j][2], (hf)acc[i][j][3]};
                *(hf4*)(C + (size_t)row * ldc + col) = o;
            }
        }
    }
}

constexpr int Q_BM = 256, Q_BK = 64, Q_HALF = 128, Q_NXCD = 8, Q_WGM = 8, Q_HT = Q_HALF * Q_BK;
__device__ __forceinline__ int q_lds_byte(int r, int c) {
    int st = (r >> 4) * 2 + (c >> 5), rr = r & 15, cc = c & 31, ob = rr * 64 + cc * 2;
    return st * 1024 + (ob ^ (((ob >> 9) & 1) << 5));
}
__device__ __forceinline__ void q_stage_rc(int b, int& R, int& C) {
    int st = b / 1024, sb = b % 1024, swz = sb ^ (((sb >> 9) & 1) << 5);
    R = (st >> 1) * 16 + swz / 64; C = (st & 1) * 32 + (swz % 64) / 2;
}
__device__ __forceinline__ void q_tile_of(int wgid, int nM, int nN, int& pm, int& pn) {
    const int nwg = nM * nN;
    { const int q = nwg / Q_NXCD, r = nwg % Q_NXCD, xcd = wgid % Q_NXCD, off = wgid / Q_NXCD; wgid = (xcd < r ? xcd * (q + 1) : r * (q + 1) + (xcd - r) * q) + off; }
    const int nig = Q_WGM * nN, gid = wgid / nig, fm = gid * Q_WGM, gsz = min(nM - fm, Q_WGM);
    pm = fm + ((wgid % nig) % gsz); pn = (wgid % nig) / gsz;
}
__device__ __forceinline__ void gemm256(const hf* __restrict__ A, const hf* __restrict__ Bt, hf* __restrict__ C, int brow, int bcol, int mlimit, int nlimit, int ldc, unsigned char* smem) {
    constexpr int K = D;
    hf* shm = (hf*)smem;
    const int qtid = tid_();
#define SA(b,h) (shm+((b)*2+(h))*Q_HT)
#define SB(b,h) (shm+(4+(b)*2+(h))*Q_HT)
#define STAGE(P,BASE,br,kt) do{const char* _gb=(const char*)((BASE)+(long)(br)*K+(long)(kt)*Q_BK); \
    __builtin_amdgcn_global_load_lds((const unsigned*)(_gb+so0),(unsigned*)((char*)(P)+qtid*16),16,0,0); \
    __builtin_amdgcn_global_load_lds((const unsigned*)(_gb+so1),(unsigned*)((char*)(P)+qtid*16+8192),16,0,0);}while(0)
#define LDA(dst,b,h) _Pragma("unroll") for(int m=0;m<4;++m) _Pragma("unroll") for(int k=0;k<2;++k) \
    dst[m][k]=*reinterpret_cast<const hf8*>((char*)SA(b,h)+q_lds_byte(wr*64+m*16+fr,k*32+fq*8))
#define LDB(dst,b,h) _Pragma("unroll") for(int n=0;n<2;++n) _Pragma("unroll") for(int k=0;k<2;++k) \
    dst[n][k]=*reinterpret_cast<const hf8*>((char*)SB(b,h)+q_lds_byte(wc*32+n*16+fr,k*32+fq*8))
#define MMA(ai,bj,At,Bt_) do{__builtin_amdgcn_s_setprio(1); \
    _Pragma("unroll") for(int m=0;m<4;++m) _Pragma("unroll") for(int n=0;n<2;++n) _Pragma("unroll") for(int k=0;k<2;++k) \
      acc[ai][bj][m][n]=__builtin_amdgcn_mfma_f32_16x16x32_f16(Bt_[n][k],At[m][k],acc[ai][bj][m][n],0,0,0); \
    __builtin_amdgcn_s_setprio(0);}while(0)
#define WAIT_V(n) asm volatile("s_waitcnt vmcnt(" #n ")":::"memory")
#define WAIT_L(n) asm volatile("s_waitcnt lgkmcnt(" #n ")":::"memory")
#define BAR __builtin_amdgcn_s_barrier()
#define SCHED __builtin_amdgcn_sched_barrier(0)
    const int wid = qtid >> 6, lane = qtid & 63, wr = wid >> 2, wc = wid & 3, fr = lane & 15, fq = lane >> 4;
    unsigned so0, so1;
    { int r_, c_; q_stage_rc(qtid * 16, r_, c_); so0 = (unsigned)(r_ * K + c_) * 2u; q_stage_rc(qtid * 16 + 8192, r_, c_); so1 = (unsigned)(r_ * K + c_) * 2u; }
    f32x4 acc[2][2][4][2] = {};
    hf8 At[4][2], B0[2][2], B1[2][2];
    constexpr int nt = K / Q_BK;
    STAGE(SB(0,0),Bt,bcol,0); STAGE(SA(0,0),A,brow,0);
    STAGE(SB(0,1),Bt,bcol+Q_HALF,0); STAGE(SA(0,1),A,brow+Q_HALF,0);
    if(wr==1)BAR;
    WAIT_V(4); BAR;
    STAGE(SB(1,0),Bt,bcol,1); STAGE(SA(1,0),A,brow,1); STAGE(SB(1,1),Bt,bcol+Q_HALF,1);
    WAIT_V(6); BAR;
    for(int t=0;t<nt-2;t+=2){
        LDB(B0,0,0); SCHED; LDA(At,0,0); STAGE(SA(1,1),A,brow+Q_HALF,t+1);
        WAIT_L(8); BAR; WAIT_L(0); MMA(0,0,At,B0); BAR; SCHED;
        LDB(B1,0,1); STAGE(SB(0,0),Bt,bcol,t+2);
        BAR; WAIT_L(0); MMA(0,1,At,B1); BAR;
        LDA(At,0,1); STAGE(SA(0,0),A,brow,t+2);
        BAR; WAIT_L(0); MMA(1,0,At,B0); BAR; SCHED;
        STAGE(SB(0,1),Bt,bcol+Q_HALF,t+2);
        WAIT_V(6); BAR; MMA(1,1,At,B1); BAR;
        LDB(B0,1,0); SCHED; LDA(At,1,0); STAGE(SA(0,1),A,brow+Q_HALF,t+2);
        WAIT_L(8); BAR; WAIT_L(0); MMA(0,0,At,B0); BAR; SCHED;
        LDB(B1,1,1); STAGE(SB(1,0),Bt,bcol,t+3);
        BAR; WAIT_L(0); MMA(0,1,At,B1); BAR;
        LDA(At,1,1); STAGE(SA(1,0),A,brow,t+3);
        BAR; WAIT_L(0); MMA(1,0,At,B0); BAR; SCHED;
        STAGE(SB(1,1),Bt,bcol+Q_HALF,t+3);
        WAIT_V(6); BAR; MMA(1,1,At,B1); BAR;
    }
    { LDB(B0,0,0); LDA(At,0,0); STAGE(SA(1,1),A,brow+Q_HALF,nt-1);
      BAR; WAIT_L(0); MMA(0,0,At,B0); BAR;
      LDB(B1,0,1); BAR; WAIT_L(0); MMA(0,1,At,B1); BAR;
      LDA(At,0,1); WAIT_V(4); BAR; WAIT_L(0); MMA(1,0,At,B0); MMA(1,1,At,B1); BAR; }
    { LDB(B0,1,0); LDA(At,1,0); WAIT_V(2); BAR; WAIT_L(0); MMA(0,0,At,B0); BAR;
      LDB(B1,1,1); WAIT_V(0); BAR; WAIT_L(0); MMA(0,1,At,B1); BAR;
      LDA(At,1,1); BAR; WAIT_L(0); MMA(1,0,At,B0); MMA(1,1,At,B1); BAR; }
    if(wr==0)BAR;
#pragma unroll
    for(int ai=0;ai<2;++ai)
#pragma unroll
    for(int bj=0;bj<2;++bj)
#pragma unroll
    for(int m=0;m<4;++m){
        const int row = brow+ai*Q_HALF+wr*64+m*16+fr;
        const f32x4 a = acc[ai][bj][m][0], b = acc[ai][bj][m][1];
        const hf4 ha = {(hf)a[0], (hf)a[1], (hf)a[2], (hf)a[3]}, hb = {(hf)b[0], (hf)b[1], (hf)b[2], (hf)b[3]};
        const u32x2 ua = __builtin_bit_cast(u32x2, ha), ub = __builtin_bit_cast(u32x2, hb);
        const auto r0 = __builtin_amdgcn_permlane16_swap(ua.x, ub.x, false, false);
        const auto r1 = __builtin_amdgcn_permlane16_swap(ua.y, ub.y, false, false);
        const u32x4 o = {r0[0], r1[0], r0[1], r1[1]};
        const int col = bcol+bj*Q_HALF+wc*32 + ((fq & 1) ? 16 + (fq - 1) * 4 : fq * 4);
        if (row < mlimit && col < nlimit) {
            st16_wt(C + (size_t)row * ldc + col, o);
        }
    }
    __syncthreads();
#undef SA
#undef SB
#undef STAGE
#undef LDA
#undef LDB
#undef MMA
#undef WAIT_V
#undef WAIT_L
#undef BAR
#undef SCHED
}

__device__ __forceinline__ void phase2(const Params& p, int l, unsigned char* smem) {
    const hf* A = (const hf*)(p.ws + WS_H);
    const hf* Bt = (const hf*)(p.ws + WS_WTIN) + (size_t)l * PINP * D;
    hf* U = (hf*)(p.ws + WS_U);
    constexpr int NMT = MPAD / 256, NNT = PINP / 256;
    for (int t = blockIdx.x; t < NMT * NNT; t += gridDim.x) {
        int pm, pn;
        q_tile_of(t, NMT, NNT, pm, pn);
        gemm256(A, Bt, U, pm * 256, pn * 256, MROWS, PIN, PIN, smem);
    }
}
__device__ __forceinline__ void phase5b(const Params& p, int l, unsigned char* smem) {
    const hf* A = (const hf*)(p.ws + WS_MIX);
    const hf* Bt = (const hf*)(p.ws + WS_WTOUT) + (size_t)l * D * D;
    hf* C = (hf*)(p.out + O_Y) + l * 1024;
    for (int t = blockIdx.x; t < 64 * 4; t += gridDim.x) {
        int pm, pn;
        q_tile_of(t, 64, 4, pm, pn);
        gemm256(A, Bt, C, pm * 256, pn * 256, NTOK, D, 2048, smem);
    }
    for (int t = blockIdx.x; t < 256; t += gridDim.x) {
        const int tid = tid_(), lane = tid & 63, wave = tid >> 6;
        const int fr = lane & 15, fq = lane >> 4;
        const int m0 = 16384 + (t >> 5) * 64 + (wave >> 1) * 16, n0 = (t & 31) * 32 + (wave & 1) * 16;
        const hf* ap = A + (size_t)(m0 + fr) * D + fq * 8;
        const hf* bp = Bt + (size_t)(n0 + fr) * D + fq * 8;
        f32x4 acc0 = {0.f, 0.f, 0.f, 0.f}, acc1 = {0.f, 0.f, 0.f, 0.f};
#pragma unroll 4
        for (int k = 0; k < D; k += 64) {
            const hf8 a0 = *(const hf8*)(ap + k), b0 = *(const hf8*)(bp + k);
            const hf8 a1 = *(const hf8*)(ap + k + 32), b1 = *(const hf8*)(bp + k + 32);
            acc0 = __builtin_amdgcn_mfma_f32_16x16x32_f16(b0, a0, acc0, 0, 0, 0);
            acc1 = __builtin_amdgcn_mfma_f32_16x16x32_f16(b1, a1, acc1, 0, 0, 0);
        }
        const f32x4 a = acc0 + acc1;
        hf4 o = {(hf)a[0], (hf)a[1], (hf)a[2], (hf)a[3]};
        *(hf4*)(C + (size_t)(m0 + fr) * 2048 + n0 + fq * 4) = o;
    }
}

__device__ __forceinline__ void p3_lora(const Params& p, int l, int witem) {
    const int lane = tid_() & 63;
    const int fr = lane & 15, fq = lane >> 4;
    const hf* U = (const hf*)(p.ws + WS_U);
    hf* EA = (hf*)(p.ws + WS_EA);
    hf* KKB = (hf*)(p.ws + WS_H);
    const hf* WupT = (const hf*)(p.ws + WS_WUPT) + (size_t)l * 512 * 64;
    const hf* AupT = (const hf*)(p.ws + WS_AUPT) + (size_t)l * 512 * 64;
    const float* mu = p.mu + (size_t)l * PRW;
    const int tk = witem * 16 + fr;
    const int pr = prev_row(tk);
    const float pm = pr >= 0 ? 1.f : 0.f;
    const hf* ut = U + (size_t)tk * PIN;
    const hf* up = U + (size_t)(pr >= 0 ? pr : 0) * PIN;
    hf8 aw[2], aa[2];
#pragma unroll
    for (int ks = 0; ks < 2; ++ks) {
        const int kb = ks * 32 + fq * 8;
        const hf8 cw = *(const hf8*)(ut + 2048 + kb), ca = *(const hf8*)(ut + 2112 + kb);
        const hf8 pw = *(const hf8*)(up + 2048 + kb), pa = *(const hf8*)(up + 2112 + kb);
#pragma unroll
        for (int j = 0; j < 8; ++j) {
            float c = (float)cw[j], q = (float)pw[j] * pm;
            aw[ks][j] = (hf)tanh_fast(c + (q - c) * mu[2048 + kb + j]);
            c = (float)ca[j]; q = (float)pa[j] * pm;
            aa[ks][j] = (hf)(c + (q - c) * mu[2112 + kb + j]);
        }
    }
    auto store_pair = [&](hf* base, int n0, hf4 t0, hf4 t1) {
        const u32x2 ua = __builtin_bit_cast(u32x2, t0), ub = __builtin_bit_cast(u32x2, t1);
        const auto r0 = __builtin_amdgcn_permlane16_swap(ua.x, ub.x, false, false);
        const auto r1 = __builtin_amdgcn_permlane16_swap(ua.y, ub.y, false, false);
        const u32x4 o = {r0[0], r1[0], r0[1], r1[1]};
        const int col = n0 + ((fq & 1) ? 16 + (fq - 1) * 4 : fq * 4);
        st16_wt(base + (size_t)tk * D + col, o);
    };
    for (int h = 0; h < 8; ++h) {
        f32x4 av[4], kv[4];
        hf4 eo[4], ao[4];
        float ss = 0.f;
#pragma unroll
        for (int nt = 0; nt < 4; ++nt) {
            const int n0 = h * 64 + nt * 16;
            f32x4 cw = {0.f, 0.f, 0.f, 0.f}, ca = {0.f, 0.f, 0.f, 0.f};
#pragma unroll
            for (int ks = 0; ks < 2; ++ks) {
                const hf8 bw = *(const hf8*)(WupT + (size_t)(n0 + fr) * 64 + ks * 32 + fq * 8);
                const hf8 ba = *(const hf8*)(AupT + (size_t)(n0 + fr) * 64 + ks * 32 + fq * 8);
                cw = __builtin_amdgcn_mfma_f32_16x16x32_f16(bw, aw[ks], cw, 0, 0, 0);
                ca = __builtin_amdgcn_mfma_f32_16x16x32_f16(ba, aa[ks], ca, 0, 0, 0);
            }
            const int col = n0 + fq * 4;
            const f32x4 w0c = *(const f32x4*)(p.w0 + l * 512 + col), a0c = *(const f32x4*)(p.a0 + l * 512 + col);
            const f32x4 kkc = *(const f32x4*)(p.k_k + l * 512 + col), muk = *(const f32x4*)(mu + 512 + col), kac = *(const f32x4*)(p.k_a + l * 512 + col);
            const hf4 kc4 = *(const hf4*)(ut + 512 + col), kp4 = *(const hf4*)(up + 512 + col);
            const f32x4 kcf = {(float)kc4.x, (float)kc4.y, (float)kc4.z, (float)kc4.w};
            const f32x4 kpf = (f32x4){(float)kp4.x, (float)kp4.y, (float)kp4.z, (float)kp4.w} * pm;
            const f32x4 kl = kcf + (kpf - kcf) * muk;
            const f32x4 xe = w0c + cw, xa = a0c + ca;
            f32x4 e4, a4;
            e4.x = sigm(xe.x); e4.y = sigm(xe.y); e4.z = sigm(xe.z); e4.w = sigm(xe.w);
            a4.x = sigm(xa.x); a4.y = sigm(xa.y); a4.z = sigm(xa.z); a4.w = sigm(xa.w);
            e4 = e4 * 0.60653066f;
            const f32x4 km = kl * (1.f + (a4 - 1.f) * kac);
            const f32x4 kkr = kl * kkc;
            eo[nt] = (hf4){(hf)e4.x, (hf)e4.y, (hf)e4.z, (hf)e4.w};
            ao[nt] = (hf4){(hf)km.x, (hf)km.y, (hf)km.z, (hf)km.w};
            av[nt] = a4; kv[nt] = kkr;
            const f32x4 k2 = kkr * kkr;
            ss += (k2.x + k2.y) + (k2.z + k2.w);
        }
        store_pair(EA, h * 64, eo[0], eo[1]);
        store_pair(EA, h * 64 + 32, eo[2], eo[3]);
        store_pair(EA + 512, h * 64, ao[0], ao[1]);
        store_pair(EA + 512, h * 64 + 32, ao[2], ao[3]);
        ss += __shfl_xor(ss, 16);
        ss += __shfl_xor(ss, 32);
        const float inv = 1.f / fmaxf(sqrtf(ss), 1e-12f);
        hf4 ko[4], bo[4];
#pragma unroll
        for (int nt = 0; nt < 4; ++nt) {
#pragma unroll
            for (int j = 0; j < 4; ++j) { const float kk = kv[nt][j] * inv; ko[nt][j] = (hf)kk; bo[nt][j] = (hf)(kk * av[nt][j]); }
        }
        store_pair(KKB, h * 64, ko[0], ko[1]);
        store_pair(KKB, h * 64 + 32, ko[2], ko[3]);
        store_pair(KKB + 512, h * 64, bo[0], bo[1]);
        store_pair(KKB + 512, h * 64 + 32, bo[2], bo[3]);
    }
}

template <int NT>
__device__ __forceinline__ void conv_taps(const float* G, const float* w, float bias, float* acc) {
    typedef float cf2 __attribute__((ext_vector_type(2)));
    cf2 W2[32];
#pragma unroll
    for (int j = 0; j < 32; ++j) W2[j] = (cf2){j < 31 ? w[j] : 0.f, j > 0 ? w[j - 1] : 0.f};
    cf2 ap[NT / 2];
#pragma unroll
    for (int pi = 0; pi < NT / 2; ++pi) ap[pi] = (cf2){bias, bias};
#pragma unroll
    for (int r = 0; r < NT + 30; ++r) {
        const float g = G[r * 64];
        const cf2 gg = {g, g};
#pragma unroll
        for (int pi = 0; pi < NT / 2; ++pi) {
            const int j = r - 2 * pi;
            if (j >= 0 && j <= 31) ap[pi] = gg * W2[j] + ap[pi];
        }
    }
#pragma unroll
    for (int pi = 0; pi < NT / 2; ++pi) { acc[2 * pi] = ap[pi].x; acc[2 * pi + 1] = ap[pi].y; }
}

__device__ __forceinline__ void p3_conv_prompt(const Params& p, int l, int item, unsigned char* smem) {
    float* G = (float*)smem;
    hf* T = (hf*)(smem + 286 * 64 * 4) + (tid_() >> 6) * 512;
    const int g = item & 7, tt = (item >> 3) & 7, b = item >> 6;
    const int c0 = g * 64, t0 = tt * 256;
    const hf* U = (const hf*)(p.ws + WS_U);
    hf* MIX = (hf*)(p.ws + WS_MIX);
    const int tid = tid_();
    const int c = tid & 63, tq = tid >> 6;
    const int ch = c0 + c;
    float w[31];
#pragma unroll
    for (int j = 0; j < 31; ++j) w[j] = p.w_dw[((size_t)l * 31 + j) * 512 + ch];
    const float bias = p.b_dw[l * 512 + ch], gg = p.gn_c_g[l * 512 + ch], gb = p.gn_c_b[l * 512 + ch];
    hf gcv[32];
#pragma unroll
    for (int i = 0; i < 32; ++i) gcv[i] = U[(size_t)(b * 2048 + t0 + tq * 32 + i) * PIN + PRW + 1024 + ch];
    {
        hf2 ua[18], ub[18];
#pragma unroll
        for (int i = 0; i < 18; ++i) {
            const int e = min(tid + NTHR * i, 286 * 32 - 1);
            const int r = e >> 5, cp = (e & 31) * 2;
            const int t = max(t0 - 30 + r, 0);
            const hf* u = U + (size_t)(b * 2048 + t) * PIN + PRW + c0 + cp;
            ua[i] = *(const hf2*)u; ub[i] = *(const hf2*)(u + 512);
        }
#pragma unroll
        for (int i = 0; i < 18; ++i) {
            const int e = tid + NTHR * i;
            if (e < 286 * 32) {
                const int r = e >> 5, cp = (e & 31) * 2;
                const float m = (t0 - 30 + r) >= 0 ? 1.f : 0.f;
                G[r * 64 + cp] = m * (float)ua[i].x * sigm((float)ub[i].x);
                G[r * 64 + cp + 1] = m * (float)ua[i].y * sigm((float)ub[i].y);
            }
        }
    }
    __syncthreads();
#pragma unroll
    for (int sub = 0; sub < 4; ++sub) {
        const int tl = tq * 32 + sub * 8;
        float acc[8];
        conv_taps<8>(G + tl * 64 + c, w, bias, acc);
#pragma unroll
        for (int i = 0; i < 8; ++i) {
            const int tk = b * 2048 + t0 + tl + i;
            const float mean = wave_sum_all(acc[i]) * (1.f / 64.f);
            const float var = fmaxf(wave_sum_all(acc[i] * acc[i]) * (1.f / 64.f) - mean * mean, 0.f);
            const float yn = (acc[i] - mean) * rsqrtf(var + 1e-5f) * gg + gb;
            (void)tk;
            T[i * 64 + c] = (hf)silu2(yn, (float)gcv[sub * 8 + i]);
        }
        asm volatile("s_waitcnt lgkmcnt(0)" ::: "memory");
        {
            const int lane = tid & 63, tok = lane >> 3, ch8 = (lane & 7) * 8;
            const u32x4 v = *(const u32x4*)(T + tok * 64 + ch8);
            st16_wt(MIX + (size_t)(b * 2048 + t0 + tl + tok) * D + 512 + c0 + ch8, v);
        }
        asm volatile("s_waitcnt lgkmcnt(0)" ::: "memory");
    }
    if (tt == 7) {
        float* oc = p.out + O_CONV_P + ((size_t)l * 8 + b) * 30 * 512;
        for (int e = tid; e < 30 * 64; e += NTHR) {
            const int r = e >> 6, cc = e & 63;
            oc[(size_t)r * 512 + c0 + cc] = G[(256 + r) * 64 + cc];
        }
    }
    __syncthreads();
}

__device__ __forceinline__ void p3_conv_sample(const Params& p, int l, int item, unsigned char* smem) {
    float* G = (float*)smem;
    const int g = item & 7, s0 = (item >> 3) * 4;
    const int c0 = g * 64;
    const hf* U = (const hf*)(p.ws + WS_U);
    hf* MIX = (hf*)(p.ws + WS_MIX);
    const int tid = tid_();
    {
        float hv[15];
        hf ga[2], gbv[2];
#pragma unroll
        for (int i = 0; i < 15; ++i) {
            const int e = tid + NTHR * i, cc = e & 63, rr = (e >> 6) % 30, sl = (e >> 6) / 30;
            hv[i] = p.state_conv[(((size_t)l * 128 + s0 + sl) * 30 + rr) * 512 + c0 + cc];
        }
#pragma unroll
        for (int i = 0; i < 2; ++i) {
            const int e = tid + NTHR * i, cc = e & 63, tt = (e >> 6) & 3, sl = e >> 8;
            const hf* u = U + (size_t)(NTOKP + (s0 + sl) * 4 + tt) * PIN + PRW + c0 + cc;
            ga[i] = u[0]; gbv[i] = u[512];
        }
#pragma unroll
        for (int i = 0; i < 15; ++i) {
            const int e = tid + NTHR * i, cc = e & 63, rr = (e >> 6) % 30, sl = (e >> 6) / 30;
            G[(sl * 34 + rr) * 64 + cc] = hv[i];
        }
#pragma unroll
        for (int i = 0; i < 2; ++i) {
            const int e = tid + NTHR * i, cc = e & 63, tt = (e >> 6) & 3, sl = e >> 8;
            G[(sl * 34 + 30 + tt) * 64 + cc] = (float)ga[i] * sigm((float)gbv[i]);
        }
    }
    const int c = tid & 63, wv = tid >> 6;
    const int sl = wv >> 1, tp = (wv & 1) * 2;
    const int ch = c0 + c, bs = s0 + sl;
    float w[31];
#pragma unroll
    for (int j = 0; j < 31; ++j) w[j] = p.w_dw[((size_t)l * 31 + j) * 512 + ch];
    hf gcs[2];
#pragma unroll
    for (int i = 0; i < 2; ++i) gcs[i] = U[(size_t)(NTOKP + bs * 4 + tp + i) * PIN + PRW + 1024 + ch];
    __syncthreads();
    float acc[2];
    conv_taps<2>(G + (sl * 34 + tp) * 64 + c, w, p.b_dw[l * 512 + ch], acc);
    const float gg = p.gn_c_g[l * 512 + ch], gb = p.gn_c_b[l * 512 + ch];
#pragma unroll
    for (int i = 0; i < 2; ++i) {
        const int tk = NTOKP + bs * 4 + tp + i;
        const float mean = wave_sum(acc[i]) * (1.f / 64.f);
        const float d = acc[i] - mean;
        const float var = wave_sum(d * d) * (1.f / 64.f);
        const float yn = d * rsqrtf(var + 1e-5f) * gg + gb;
        MIX[(size_t)tk * D + 512 + ch] = (hf)silu2(yn, (float)gcs[i]);
    }
#pragma unroll
    for (int e = tid; e < 4 * 30 * 64; e += NTHR) {
        const int cc = e & 63, r = (e >> 6) % 30, s2 = (e >> 6) / 30;
        p.out[O_CONV_S + (((size_t)l * 128 + s0 + s2) * 30 + r) * 512 + c0 + cc] = G[(s2 * 34 + 4 + r) * 64 + cc];
    }
    __syncthreads();
}

__device__ __forceinline__ void phase3(const Params& p, int l, unsigned char* smem) {
    constexpr int W_LORA = NTOK / 16;
    constexpr int I_CP = 8 * 8 * 8;
    constexpr int I_CS = 32 * 8;
    {
        const int wave = tid_() >> 6;
        const int wi = blockIdx.x + gridDim.x * wave;
        if (wi < W_LORA) p3_lora(p, l, wi);
    }
    for (int it = blockIdx.x; it < I_CP + I_CS; it += gridDim.x) {
        if (it < I_CP) p3_conv_prompt(p, l, it, smem);
        else p3_conv_sample(p, l, it - I_CP, smem);
    }
}

typedef float f32x2 __attribute__((ext_vector_type(2)));
struct WkvS { f32x2 lo, hi; };
__device__ __forceinline__ void wkv_step(WkvS& S, const float* op, float v, float& y) {
    const f32x4 r4 = *(const f32x4*)(op + 0 * 64);
    const f32x4 w4 = *(const f32x4*)(op + 1 * 64);
    const f32x4 m4 = *(const f32x4*)(op + 2 * 64);
    const f32x4 k4 = *(const f32x4*)(op + 3 * 64);
    const f32x4 b4 = *(const f32x4*)(op + 4 * 64);
    f32x2 d = S.lo * k4.lo + S.hi * k4.hi;
    const float sk = row_allreduce16(d.x + d.y);
    const f32x2 nsk = {-sk, -sk}, vv = {v, v};
    S.lo = vv * m4.lo + (nsk * b4.lo + S.lo * w4.lo);
    S.hi = vv * m4.hi + (nsk * b4.hi + S.hi * w4.hi);
    f32x2 e = S.lo * r4.lo + S.hi * r4.hi;
    y = row_allreduce16(e.x + e.y);
}

struct WkvOps { f32x4 r4, w4, m4, k4, b4; float v; };
__device__ __forceinline__ WkvOps wkv_load(const float* op, const float* vb) {
    WkvOps o;
    o.r4 = *(const f32x4*)(op + 0 * 64);
    o.w4 = *(const f32x4*)(op + 1 * 64);
    o.m4 = *(const f32x4*)(op + 2 * 64);
    o.k4 = *(const f32x4*)(op + 3 * 64);
    o.b4 = *(const f32x4*)(op + 4 * 64);
    o.v = *vb;
    return o;
}
struct WkvOpsS { f32x4 r4, m4, k4, b4; float v; };
__device__ __forceinline__ WkvOpsS wkv_load_s(const float* op, const float* vb) {
    WkvOpsS o;
    o.r4 = *(const f32x4*)(op + 0 * 64);
    o.m4 = *(const f32x4*)(op + 2 * 64);
    o.k4 = *(const f32x4*)(op + 3 * 64);
    o.b4 = *(const f32x4*)(op + 4 * 64);
    o.v = *vb;
    return o;
}
__device__ __forceinline__ float wkv_step_part(WkvS& S, const WkvOpsS& o, const f32x4& rprev) {
    f32x2 d = S.lo * o.k4.lo + S.hi * o.k4.hi;
    float s = d.x + d.y;
    const f32x2 vv = {o.v, o.v};
    f32x2 q = S.lo * rprev.lo + S.hi * rprev.hi;
    const f32x2 tl = vv * o.m4.lo + S.lo;
    const f32x2 th = vv * o.m4.hi + S.hi;
    s = row_allreduce16(s);
    const f32x2 nsk = {-s, -s};
    S.lo = nsk * o.b4.lo + tl;
    S.hi = nsk * o.b4.hi + th;
    return q.x + q.y;
}

__device__ __forceinline__ void wkv_step_pipe(WkvS& S, const WkvOps& o, float& eprev, float& enew) {
    f32x2 d = S.lo * o.k4.lo + S.hi * o.k4.hi;
    float s = d.x + d.y, e = eprev;
    s += dpp_mov<0x128>(s); e += dpp_mov<0x128>(e);
    s += dpp_mov<0x124>(s); e += dpp_mov<0x124>(e);
    s += dpp_mov<0x122>(s); e += dpp_mov<0x122>(e);
    s += dpp_mov<0x121>(s); e += dpp_mov<0x121>(e);
    eprev = e;
    const f32x2 nsk = {-s, -s}, vv = {o.v, o.v};
    S.lo = vv * o.m4.lo + (nsk * o.b4.lo + S.lo * o.w4.lo);
    S.hi = vv * o.m4.hi + (nsk * o.b4.hi + S.hi * o.w4.hi);
    f32x2 q = S.lo * o.r4.lo + S.hi * o.r4.hi;
    enew = q.x + q.y;
}

__device__ __forceinline__ void phase4(const Params& p, int l, unsigned char* smem) {
    constexpr int OPS = 324;
    float* OP = (float*)smem;
    float* VB = OP + 2 * 16 * OPS;
    float* YB = VB + 2 * 16 * 16;
    float* VS = YB + 2 * 16 * 16 * 17;
    float* GE = VS + 16 * 64;
    const int tid = tid_(), lane = tid & 63, wave = tid >> 6;
    const hf* U = (const hf*)(p.ws + WS_U);
    const hf* EA = (const hf*)(p.ws + WS_EA);
    const hf* KKB = (const hf*)(p.ws + WS_H);
    hf* MIX = (hf*)(p.ws + WS_MIX);
    const float* mu = p.mu + (size_t)l * PRW;
    const int blk = blockIdx.x;
    const int xcd = blk & 7, idx = blk >> 3;
    const int rg = idx & 3;
    const int pbh = xcd * 8 + (idx >> 2);
    const int pb = pbh >> 3, ph = pbh & 7;
    const bool producer = wave >= 4;
    const int pw = wave & 3;
    const int rl = lane >> 4, ks = lane & 15;
    constexpr int NCHP = 2048 / 16;

    const int cl = lane >> 4, pt = lane & 15;
    const int c4 = pw * 16 + cl * 4;
    const int pcol = ph * 64 + c4;
    const f32x4 mur4 = *(const f32x4*)(mu + pcol), muv4 = *(const f32x4*)(mu + 1024 + pcol);
    const int tkp = pb * 2048 + pt;
    const hf* uc = U + (size_t)tkp * PIN + pcol;
    const hf* eac = EA + (size_t)tkp * D + pcol;
    const hf* kbc = KKB + (size_t)tkp * D + pcol;
    struct PQ { hf4 r, v, rp, vp, e, a, kk, bb; };
    PQ qA, qB;
    auto load_prompt = [&](int ci, PQ& q) {
        const hf* u = uc + (size_t)ci * (16 * PIN);
        q.r = *(const hf4*)u; q.v = *(const hf4*)(u + 1024);
        q.rp = *(const hf4*)(u - PIN); q.vp = *(const hf4*)(u - PIN + 1024);
        const hf* e_ = eac + (size_t)ci * (16 * D);
        q.e = *(const hf4*)e_; q.a = *(const hf4*)(e_ + 512);
        const hf* k_ = kbc + (size_t)ci * (16 * D);
        q.kk = *(const hf4*)k_; q.bb = *(const hf4*)(k_ + 512);
    };
    auto cvt4 = [](hf4 x) { return (f32x4){(float)x.x, (float)x.y, (float)x.z, (float)x.w}; };
    auto scan16 = [](float x) {
        x += dpp_mov<0x111>(x);
        x += dpp_mov<0x112>(x);
        x += dpp_mov<0x114>(x);
        x += dpp_mov<0x118>(x);
        return x;
    };
    auto store_prompt = [&](int ci, int buf, const PQ& q) {
        const float pmask = (ci == 0 && pt == 0) ? 0.f : 1.f;
        const f32x4 rc = cvt4(q.r), vc = cvt4(q.v);
        const f32x4 rp = cvt4(q.rp) * pmask, vp = cvt4(q.vp) * pmask;
        const f32x4 e = cvt4(q.e);
        const f32x4 r = rc + (rp - rc) * mur4, v = vc + (vp - vc) * muv4;
        f32x4 cum;
        cum.x = scan16(e.x); cum.y = scan16(e.y); cum.z = scan16(e.z); cum.w = scan16(e.w);
        const f32x4 cpv = cum - e;
        f32x4 gin, gout, gprev;
        gin.x = __expf(-cum.x); gin.y = __expf(-cum.y); gin.z = __expf(-cum.z); gin.w = __expf(-cum.w);
        gout.x = __expf(cum.x); gout.y = __expf(cum.y); gout.z = __expf(cum.z); gout.w = __expf(cum.w);
        gprev.x = __expf(-cpv.x); gprev.y = __expf(-cpv.y); gprev.z = __expf(-cpv.z); gprev.w = __expf(-cpv.w);
        float* op = OP + buf * (16 * OPS) + pt * OPS + c4;
        *(f32x4*)(op + 0 * 64) = r * gin;
        *(f32x4*)(op + 2 * 64) = cvt4(q.a) * gout;
        *(f32x4*)(op + 3 * 64) = cvt4(q.kk) * gprev;
        *(f32x4*)(op + 4 * 64) = cvt4(q.bb) * gout;
        if (pt == 15) *(f32x4*)(GE + buf * 64 + c4) = gin;
        if (pw == rg) *(f32x4*)(VB + buf * 256 + pt * 16 + cl * 4) = v;
    };
    auto flush_y = [&](int ci, int buf) {
        const int tok = pw * 4 + (lane >> 4), row = lane & 15;
        const float* yb = YB + buf * (16 * 16 * 17) + (tok * 16 + row) * 17;
        float y0 = 0.f, y1 = 0.f, y2 = 0.f, y3 = 0.f;
#pragma unroll
        for (int j = 0; j < 16; j += 4) { y0 += yb[j]; y1 += yb[j + 1]; y2 += yb[j + 2]; y3 += yb[j + 3]; }
        MIX[(size_t)(pb * 2048 + ci * 16 + tok) * D + ph * 64 + rg * 16 + row] = (hf)((y0 + y1) + (y2 + y3));
    };

    WkvS S; S.lo = (f32x2){0.f, 0.f}; S.hi = (f32x2){0.f, 0.f};
    if (producer) { load_prompt(0, qB); store_prompt(0, 0, qB); load_prompt(1, qA); load_prompt(2, qB); }
    __syncthreads();
    auto consume = [&](int buf) {
        const float* op = OP + buf * (16 * OPS) + ks * 4;
        const float* vb = VB + buf * 256 + pw * 4 + rl;
        float* yb = YB + buf * (16 * 16 * 17) + (pw * 4 + rl) * 17 + ks;
        WkvOpsS ring[4];
        ring[0] = wkv_load_s(op, vb);
        ring[1] = wkv_load_s(op + OPS, vb + 16);
        ring[2] = wkv_load_s(op + 2 * OPS, vb + 32);
        f32x4 rprev = {0.f, 0.f, 0.f, 0.f};
#pragma unroll
        for (int t = 0; t < 16; ++t) {
            if (t + 3 < 16) ring[(t + 3) & 3] = wkv_load_s(op + (t + 3) * OPS, vb + (t + 3) * 16);
            __builtin_amdgcn_sched_barrier(0);
            const float e = wkv_step_part(S, ring[t & 3], rprev);
            if (t > 0) yb[(t - 1) * (16 * 17)] = e;
            rprev = ring[t & 3].r4;
            __builtin_amdgcn_sched_barrier(0);
        }
        {
            f32x2 q = S.lo * rprev.lo + S.hi * rprev.hi;
            yb[15 * (16 * 17)] = q.x + q.y;
            const f32x4 ge = *(const f32x4*)(GE + buf * 64 + ks * 4);
            S.lo = S.lo * ge.lo;
            S.hi = S.hi * ge.hi;
        }
    };
#pragma unroll 1
    for (int ci = 0; ci < NCHP; ci += 2) {
        if (producer) {
            store_prompt(ci + 1, 1, qA);
            if (ci + 3 < NCHP) load_prompt(ci + 3, qA);
            if (ci >= 1) flush_y(ci - 1, 1);
        } else consume(0);
        __syncthreads();
        if (producer) {
            if (ci + 2 < NCHP) store_prompt(ci + 2, 0, qB);
            if (ci + 4 < NCHP) load_prompt(ci + 4, qB);
            flush_y(ci, 0);
        } else consume(1);
        __syncthreads();
    }

    f32x4 St[4][4];
    if (producer) {
        flush_y(NCHP - 1, (NCHP - 1) & 1);
        const int id = blk * 4 + pw, bs = id >> 3, h = id & 7;
        const int col = h * 64 + lane;
        const float smur = mu[col], smuk = mu[512 + col], smuv = mu[1024 + col], ska = p.k_a[l * 512 + col];
        const int tk0 = NTOKP + bs * 4;
        const hf* up = U + (size_t)(NTOK + bs) * PIN + col;
        float rp = (float)up[0], kp = (float)up[512], vp = (float)up[1024];
#pragma unroll
        for (int i = 0; i < 4; ++i) {
            const int tk = tk0 + i, t = pw * 4 + i;
            const hf* ut = U + (size_t)tk * PIN + col;
            const float rc = (float)ut[0], kc = (float)ut[512], vc = (float)ut[1024];
            const float e = (float)EA[(size_t)tk * D + col], a = (float)EA[(size_t)tk * D + 512 + col];
            const float kk = (float)KKB[(size_t)tk * D + col], bb = (float)KKB[(size_t)tk * D + 512 + col];
            OP[(t * 5 + 0) * 64 + lane] = rc + (rp - rc) * smur;
            OP[(t * 5 + 1) * 64 + lane] = __expf(-e);
            OP[(t * 5 + 2) * 64 + lane] = a;
            OP[(t * 5 + 3) * 64 + lane] = kk;
            OP[(t * 5 + 4) * 64 + lane] = bb;
            VS[t * 64 + lane] = vc + (vp - vc) * smuv;
            rp = rc; kp = kc; vp = vc;
        }
    } else {
        *(f32x4*)(p.out + O_WKV_P + ((((size_t)l * 8 + pb) * 8 + ph) * 64 + rg * 16 + pw * 4 + rl) * 64 + ks * 4) = (f32x4){S.lo.x, S.lo.y, S.hi.x, S.hi.y};
#pragma unroll
        for (int q = 0; q < 4; ++q) {
            const int id = blk * 4 + q, bs = id >> 3, h = id & 7;
#pragma unroll
            for (int g = 0; g < 4; ++g) {
                const int row = pw * 16 + g * 4 + rl;
                St[q][g] = *(const f32x4*)(p.state_wkv + ((((size_t)l * 128 + bs) * 8 + h) * 64 + row) * 64 + ks * 4);
            }
        }
    }
    __syncthreads();
    if (!producer) {
#pragma unroll
        for (int q = 0; q < 4; ++q) {
            const int id = blk * 4 + q, bs = id >> 3, h = id & 7;
#pragma unroll
            for (int g = 0; g < 4; ++g) {
                const int row = pw * 16 + g * 4 + rl;
                WkvS Sq; Sq.lo = St[q][g].lo; Sq.hi = St[q][g].hi;
                float ykeep = 0.f;
#pragma unroll
                for (int t = 0; t < 4; ++t) {
                    float y;
                    wkv_step(Sq, OP + ((q * 4 + t) * 5) * 64 + ks * 4, VS[(q * 4 + t) * 64 + row], y);
                    ykeep = (ks == t) ? y : ykeep;
                }
                *(f32x4*)(p.out + O_WKV_S + ((((size_t)l * 128 + bs) * 8 + h) * 64 + row) * 64 + ks * 4) = (f32x4){Sq.lo.x, Sq.lo.y, Sq.hi.x, Sq.hi.y};
                if (ks < 4) MIX[(size_t)(NTOKP + bs * 4 + ks) * D + h * 64 + row] = (hf)ykeep;
            }
        }
    }
    __syncthreads();
}

__device__ __forceinline__ void phase5a(const Params& p, int l, hf* DST = nullptr) {
    const int tid = tid_(); const int lane = tid & 63, wave = tid >> 6;
    const hf* U = (const hf*)(p.ws + WS_U);
    const hf* EA = (const hf*)(p.ws + WS_EA);
    hf* MIX = (hf*)(p.ws + WS_MIX);
    hf* OUT = DST ? DST : MIX;
    const float* mu = p.mu + (size_t)l * PRW;
    const int ti = lane >> 4, c4 = (lane & 15) * 4;
    struct It { hf4 uc[4], up[4], a, y; };
    constexpr int NIT = (NTOK / 4) * 8;
    const int stride = gridDim.x * 8;
    auto load = [&](int it, It& q) {
        const int tk = (it >> 3) * 4 + ti, col = (it & 7) * 64 + c4;
        const int pr = prev_row(tk);
        const hf* ut = U + (size_t)tk * PIN + col;
        const hf* up = U + (size_t)(pr >= 0 ? pr : 0) * PIN + col;
#pragma unroll
        for (int c = 0; c < 4; ++c) { if (c == 1) continue; q.uc[c] = *(const hf4*)(ut + 512 * c); q.up[c] = *(const hf4*)(up + 512 * c); }
        q.a = *(const hf4*)(EA + (size_t)tk * D + 512 + col);
        q.y = *(const hf4*)(MIX + (size_t)tk * D + col);
    };
    auto cvt4 = [](hf4 x) { return (f32x4){(float)x.x, (float)x.y, (float)x.z, (float)x.w}; };
    auto compute = [&](int it, const It& q) {
        const int tk = (it >> 3) * 4 + ti, col = (it & 7) * 64 + c4;
        const float pm = prev_row(tk) >= 0 ? 1.f : 0.f;
        const f32x4 mr = *(const f32x4*)(mu + col), mk = *(const f32x4*)(mu + 512 + col), mv = *(const f32x4*)(mu + 1024 + col), mg = *(const f32x4*)(mu + 1536 + col);
        const f32x4 ka = *(const f32x4*)(p.k_a + l * 512 + col), rk = *(const f32x4*)(p.r_k + l * 512 + col);
        const f32x4 gg = *(const f32x4*)(p.gn_r_g + l * 512 + col), gb = *(const f32x4*)(p.gn_r_b + l * 512 + col);
        const f32x4 rc = cvt4(q.uc[0]), vc = cvt4(q.uc[2]), gc = cvt4(q.uc[3]);
        const f32x4 r = rc + (cvt4(q.up[0]) * pm - rc) * mr;
        const f32x4 v = vc + (cvt4(q.up[2]) * pm - vc) * mv, g = gc + (cvt4(q.up[3]) * pm - gc) * mg;
        const f32x4 km = cvt4(q.a);
        const f32x4 y = cvt4(q.y);
        const f32x4 y2 = y * y, bo = r * km * rk;
        float s1 = (y.x + y.y) + (y.z + y.w), s2 = (y2.x + y2.y) + (y2.z + y2.w), s3 = (bo.x + bo.y) + (bo.z + bo.w);
        s1 = row_allreduce16(s1); s2 = row_allreduce16(s2); s3 = row_allreduce16(s3);
        const float mean = s1 * (1.f / 64.f);
        const float var = fmaxf(s2 * (1.f / 64.f) - mean * mean, 0.f);
        const float rs = rsqrtf(var + 64e-5f);
        const f32x4 yn = (y - mean) * rs * gg + gb;
        const f32x4 t = yn + s3 * v;
        hf4 o = {(hf)(t.x * silu(g.x)), (hf)(t.y * silu(g.y)), (hf)(t.z * silu(g.z)), (hf)(t.w * silu(g.w))};
        const u32x2 uo = __builtin_bit_cast(u32x2, o);
        const unsigned n0 = (unsigned)__builtin_amdgcn_update_dpp(0, (int)uo.x, 0x101, 0xf, 0xf, false);
        const unsigned n1 = (unsigned)__builtin_amdgcn_update_dpp(0, (int)uo.y, 0x101, 0xf, 0xf, false);
        if ((lane & 1) == 0) st16_wt(OUT + (size_t)tk * D + col, (u32x4){uo.x, uo.y, n0, n1});
    };
    It qa, qb;
    int it = blockIdx.x * 8 + wave;
    if (it < NIT) load(it, qa);
    while (it < NIT) {
        const int nx = it + stride;
        if (nx < NIT) load(nx, qb);
        compute(it, qa);
        qa = qb;
        it = nx;
    }
}

__device__ __forceinline__ void phase6(const Params& p) {
    const int tid = tid_(); const int lane = tid & 63, wave = tid >> 6;
    const float* MOD = (const float*)(p.ws + WS_MOD);
    struct Row { f32x4 x[4]; hf4 m0[4], m1[4]; };
    const int stride = gridDim.x * 8;
    auto load = [&](int tk, Row& q) {
        const float* xr = x0_row(p, tk);
        const hf* mo = (const hf*)(p.out + O_Y + (size_t)tk * D);
#pragma unroll
        for (int j = 0; j < 4; ++j) {
            q.x[j] = *(const f32x4*)(xr + 256 * j + 4 * lane);
            q.m0[j] = *(const hf4*)(mo + 256 * j + 4 * lane);
            q.m1[j] = *(const hf4*)(mo + 1024 + 256 * j + 4 * lane);
        }
    };
    Row qa, qb;
    int tk = blockIdx.x * 8 + wave;
    if (tk < NTOK) load(tk, qa);
    while (tk < NTOK) {
        const int nx = tk + stride;
        if (nx < NTOK) load(nx, qb);
        const int sq = seq_of(tk);
        float* yr = p.out + O_Y + (size_t)tk * D;
        f32x4 m0[4], m1[4];
        float s0 = 0.f, s1 = 0.f;
#pragma unroll
        for (int j = 0; j < 4; ++j) {
            m0[j] = (f32x4){(float)qa.m0[j].x, (float)qa.m0[j].y, (float)qa.m0[j].z, (float)qa.m0[j].w};
            m1[j] = (f32x4){(float)qa.m1[j].x, (float)qa.m1[j].y, (float)qa.m1[j].z, (float)qa.m1[j].w};
            s0 += m0[j].x * m0[j].x + m0[j].y * m0[j].y + m0[j].z * m0[j].z + m0[j].w * m0[j].w;
            s1 += m1[j].x * m1[j].x + m1[j].y * m1[j].y + m1[j].z * m1[j].z + m1[j].w * m1[j].w;
        }
        const float r0 = rsqrtf(wave_sum_all(s0) * (1.f / D) + 1e-6f);
        const float r1 = rsqrtf(wave_sum_all(s1) * (1.f / D) + 1e-6f);
#pragma unroll
        for (int j = 0; j < 4; ++j) {
            f32x4 gp0 = *(const f32x4*)(p.g_post + 256 * j + 4 * lane);
            f32x4 gp1 = *(const f32x4*)(p.g_post + D + 256 * j + 4 * lane);
            f32x4 gt0 = *(const f32x4*)(MOD + (size_t)sq * 6144 + 2048 + 256 * j + 4 * lane);
            f32x4 gt1 = *(const f32x4*)(MOD + (size_t)sq * 6144 + 3072 + 2048 + 256 * j + 4 * lane);
            f32x4 y = qa.x[j] + gt0 * (m0[j] * r0 * gp0);
            y = y + gt1 * (m1[j] * r1 * gp1);
            *(f32x4*)(yr + 256 * j + 4 * lane) = y;
        }
        qa = qb;
        tk = nx;
    }
}

constexpr int NPHASES = 14;
__device__ __forceinline__ void run_phase(const Params& p, int ph, unsigned char* smem) {
    if (ph == 0) { phase0(p, smem); return; }
    if (ph == 13) { phase6(p); return; }
    const int l = (ph - 1) / 6, s = (ph - 1) % 6;
    switch (s) {
        case 0: phase1(p, l); break;
        case 1: phase2(p, l, smem); break;
        case 2: phase3(p, l, smem); break;
        case 3: phase4(p, l, smem); break;
        case 4: phase5a(p, l); break;
        default: phase5b(p, l, smem); break;
    }
}

#define GSYNC() xcd_barrier(xb)
__global__ void __launch_bounds__(NTHR) fwd_mega(Params p) {
    extern __shared__ __attribute__((aligned(16))) unsigned char smem[];
    volatile LAS unsigned* st = (volatile LAS unsigned*)(smem + LDS_BYTES - 16);
    if (threadIdx.x == 0) { st[0] = 0u; st[1] = 0u; }
    __syncthreads();
    XcdBarrier xb = xcd_barrier_post((unsigned*)(p.ws + WS_BAR), st);
    if (p.ws == nullptr) cg::this_grid().sync();
    phase0(p, smem); GSYNC();
    phase1(p, 0); GSYNC();
    phase2(p, 0, smem); GSYNC();
    phase3(p, 0, smem); GSYNC();
    phase4(p, 0, smem); GSYNC();
    phase5a(p, 0); GSYNC();
    phase5b(p, 0, smem); GSYNC();
    phase1(p, 1); GSYNC();
    phase2(p, 1, smem); GSYNC();
    phase3(p, 1, smem); GSYNC();
    phase4(p, 1, smem); GSYNC();
    phase5a(p, 1); GSYNC();
    phase5b(p, 1, smem); GSYNC();
    phase6(p);
}
__global__ void __launch_bounds__(NTHR) fwd_phase(Params p, int ph) {
    extern __shared__ __attribute__((aligned(16))) unsigned char smem[];
    run_phase(p, ph, smem);
}

extern "C" void kernel_launch(void* const* d_in, const int* in_sizes, int n_in, void* d_out, int out_size, void* d_ws, size_t ws_size,
                              hipStream_t stream) {
    static int ok = 0;
    if (ok == 0) {
        ok = 1;
        if (n_in != 27 || (size_t)out_size != O_END || ws_size < WS_END) {
            fprintf(stderr, "kernel_launch: unexpected sizes n_in %d out %d ws %zu (need %zu)\n", n_in, out_size, ws_size, (size_t)WS_END);
            ok = -1;
        }
        int dev = 0, cus = 0, per_cu = 0;
        (void)hipGetDevice(&dev);
        (void)hipDeviceGetAttribute(&cus, hipDeviceAttributeMultiprocessorCount, dev);
        (void)hipFuncSetAttribute((const void*)fwd_mega, hipFuncAttributeMaxDynamicSharedMemorySize, LDS_BYTES);
        (void)hipFuncSetAttribute((const void*)fwd_phase, hipFuncAttributeMaxDynamicSharedMemorySize, LDS_BYTES);
        (void)hipOccupancyMaxActiveBlocksPerMultiprocessor(&per_cu, (const void*)fwd_mega, NTHR, LDS_BYTES);
        if (cus * per_cu < GRID) {
            fprintf(stderr, "kernel_launch: resident capacity %d x %d < grid %d\n", cus, per_cu, GRID);
            ok = -1;
        }
    }
    if (ok < 0) return;
    Params p{};
    const float** pp = (const float**)&p;
    for (int i = 0; i < 27; ++i) pp[i] = (const float*)d_in[i];
    p.out = (float*)d_out;
    p.ws = (unsigned char*)d_ws;
#if MULTI_LAUNCH
    for (int ph = 0; ph < NPHASES; ++ph) hipLaunchKernelGGL(fwd_phase, dim3(GRID), dim3(NTHR), LDS_BYTES, stream, p, ph);
#else
    (void)hipMemsetAsync((unsigned char*)d_ws + WS_BAR, 0, 16384, stream);
    void* args[] = {&p};
    hipError_t e = hipLaunchCooperativeKernel((const void*)fwd_mega, dim3(GRID), dim3(NTHR), args, LDS_BYTES, stream);
    if (e != hipSuccess) fprintf(stderr, "cooperative launch failed: %s\n", hipGetErrorString(e));
#endif
}
```

```cpp
#include <hip/hip_runtime.h>
#include <hip/hip_cooperative_groups.h>
#include <cstdio>
namespace cg = cooperative_groups;

#ifndef MULTI_LAUNCH
#define MULTI_LAUNCH 0
#endif

typedef _Float16 hf;
typedef hf hf8 __attribute__((ext_vector_type(8)));
typedef hf hf4 __attribute__((ext_vector_type(4)));
typedef hf hf2 __attribute__((ext_vector_type(2)));
typedef float f32x4 __attribute__((ext_vector_type(4)));

constexpr int D = 1024;
constexpr int NTOKP = 16384, NTOKS = 512, NTOK = 16896, NSEQ = 136;
constexpr int PIN = 3712, PRW = 2176;
constexpr int MROWS = NTOK + 128;
constexpr int MPAD = 17152;
constexpr int NTHR = 512;
constexpr int GRID = 256;

constexpr int PINP = 3840;
constexpr size_t WS_WTIN = 0;
constexpr size_t WS_WTOUT = WS_WTIN + (size_t)2 * PINP * D * 2;
constexpr size_t WS_WUPT = WS_WTOUT + (size_t)2 * D * D * 2;
constexpr size_t WS_AUPT = WS_WUPT + (size_t)2 * 512 * 64 * 2;
constexpr size_t WS_MOD = WS_AUPT + (size_t)2 * 512 * 64 * 2;
constexpr size_t WS_H = WS_MOD + (size_t)NSEQ * 6144 * 4;
constexpr size_t WS_U = WS_H + (size_t)MPAD * D * 2;
constexpr size_t WS_EA = WS_U + (size_t)MROWS * PIN * 2;
constexpr size_t WS_MIX = WS_EA + (size_t)NTOK * D * 2;
constexpr size_t WS_BAR = WS_MIX + (size_t)NTOK * D * 2;
constexpr size_t WS_END = WS_BAR + 16384;

constexpr size_t O_Y = 0;
constexpr size_t O_SHIFT_P = (size_t)NTOK * D;
constexpr size_t O_WKV_P = O_SHIFT_P + 2 * 8 * 1024;
constexpr size_t O_CONV_P = O_WKV_P + (size_t)2 * 8 * 8 * 4096;
constexpr size_t O_SHIFT_S = O_CONV_P + (size_t)2 * 8 * 30 * 512;
constexpr size_t O_WKV_S = O_SHIFT_S + (size_t)2 * 128 * 1024;
constexpr size_t O_CONV_S = O_WKV_S + (size_t)2 * 128 * 8 * 4096;
constexpr size_t O_END = O_CONV_S + (size_t)2 * 128 * 30 * 512;

constexpr int LDS_BYTES = 132 * 1024;

struct Params {
    const float *x_prompt, *x_sample, *c_prompt, *c_sample, *state_shift, *state_wkv, *state_conv;
    const float *w_ada, *b_ada, *g_pre, *g_post, *w_in, *mu, *w0, *w_up, *a0, *a_up, *k_k, *k_a, *r_k;
    const float *gn_r_g, *gn_r_b, *w_dw, *b_dw, *gn_c_g, *gn_c_b, *w_out;
    float* out;
    unsigned char* ws;
};

typedef unsigned u32x2 __attribute__((ext_vector_type(2)));
typedef unsigned u32x4 __attribute__((ext_vector_type(4)));
__device__ __forceinline__ void st16_wt(void* p, u32x4 v) { asm volatile("global_store_dwordx4 %0, %1, off sc1\n\ts_nop 1" :: "v"(p), "v"(v) : "memory"); }
__device__ __forceinline__ int tid_() { int t = threadIdx.x; asm volatile("" : "+v"(t)); return t; }
template <int CTRL>
__device__ __forceinline__ float dpp_mov(float v) {
    return __builtin_bit_cast(float, __builtin_amdgcn_update_dpp(0, __builtin_bit_cast(int, v), CTRL, 0xf, 0xf, false));
}
__device__ __forceinline__ float row_allreduce16(float v) {
    v += dpp_mov<0x128>(v);
    v += dpp_mov<0x124>(v);
    v += dpp_mov<0x122>(v);
    v += dpp_mov<0x121>(v);
    return v;
}
__device__ __forceinline__ float wave_sum(float v) {
    v = row_allreduce16(v);
    v += __shfl_xor(v, 16);
    v += __shfl_xor(v, 32);
    return v;
}
__device__ __forceinline__ float wave_sum_all(float v) {
    v = row_allreduce16(v);
    v += __builtin_bit_cast(float, __builtin_amdgcn_update_dpp(0, __builtin_bit_cast(int, v), 0x142, 0xa, 0xf, false));
    v += __builtin_bit_cast(float, __builtin_amdgcn_update_dpp(0, __builtin_bit_cast(int, v), 0x143, 0xc, 0xf, false));
    return __builtin_bit_cast(float, __builtin_amdgcn_readlane(__builtin_bit_cast(int, v), 63));
}
__device__ __forceinline__ float sigm(float x) { return __builtin_amdgcn_rcpf(1.f + __expf(-x)); }
__device__ __forceinline__ float silu(float x) { return x * __builtin_amdgcn_rcpf(1.f + __expf(-x)); }
__device__ __forceinline__ float silu2(float a, float b) { return (a * b) * __builtin_amdgcn_rcpf((1.f + __expf(-a)) * (1.f + __expf(-b))); }
__device__ __forceinline__ float tanh_fast(float x) { float t = __expf(2.f * x); return 1.f - 2.f * __builtin_amdgcn_rcpf(t + 1.f); }

__device__ __forceinline__ int seq_of(int tk) { return tk < NTOKP ? (tk >> 11) : 8 + ((tk - NTOKP) >> 2); }
__device__ __forceinline__ bool is_last_tok(int tk) { return tk < NTOKP ? ((tk & 2047) == 2047) : (((tk - NTOKP) & 3) == 3); }
__device__ __forceinline__ int prev_row(int tk) {
    if (tk < NTOKP) return (tk & 2047) ? tk - 1 : -1;
    int s = tk - NTOKP;
    return (s & 3) ? tk - 1 : NTOK + (s >> 2);
}
__device__ __forceinline__ const float* x0_row(const Params& p, int tk) {
    return tk < NTOKP ? p.x_prompt + (size_t)tk * D : p.x_sample + (size_t)(tk - NTOKP) * D;
}


#define XB_TMO      128
#define XB_XCNT(j)  (256  + 64 * (j))
#define XB_XSUB(j)  (1280 + 64 * (j))
#define XB_XGEN(j)  (2304 + 64 * (j))
#define XB_TOP      3328
#define XB_TOPGEN   3392
#define XCD_BAR_WORDS 3456
#define XB_SPIN_CAP (1u << 22)
#define LAS __attribute__((address_space(3)))
__device__ __forceinline__ unsigned xb_ld(unsigned* p)              { return __hip_atomic_load(p, __ATOMIC_RELAXED, __HIP_MEMORY_SCOPE_AGENT); }
__device__ __forceinline__ unsigned xb_add(unsigned* p, unsigned v) { return __hip_atomic_fetch_add(p, v, __ATOMIC_RELAXED, __HIP_MEMORY_SCOPE_AGENT); }
__device__ __forceinline__ unsigned xb_xcc_id() { return (unsigned)__builtin_amdgcn_s_getreg((3 << 11) | 20) & 0xFu; }
#define XB_SPIN(cond, bar) do { unsigned _sp = 0; while (cond) { __builtin_amdgcn_s_sleep(1); \
    if ((++_sp & 255u) == 0u) { if (xb_ld(&(bar)[XB_TMO])) break; if (_sp > XB_SPIN_CAP) { atomicAdd(&(bar)[XB_TMO], 1u); break; } } } } while (0)
struct XcdBarrier { unsigned* bar; unsigned x; volatile LAS unsigned* st; };
__device__ __forceinline__ XcdBarrier xcd_barrier_post(unsigned* bar, volatile LAS unsigned* st) {
    XcdBarrier b; b.bar = bar; b.x = xb_xcc_id(); b.st = st;
    if (threadIdx.x == 0) (void)xb_add(&bar[XB_XCNT(b.x)], 1u);
    return b;
}
__device__ __forceinline__ void xcd_barrier_complete(unsigned* bar, unsigned x, unsigned& nloc, unsigned& nx) {
    const unsigned G = gridDim.x * gridDim.y * gridDim.z;
    unsigned sum, cnt, mine, sp = 0u;
    for (;;) {
        sum = 0u; cnt = 0u; mine = 0u;
#pragma unroll
        for (unsigned j = 0; j < 16; ++j) { const unsigned c = xb_ld(&bar[XB_XCNT(j)]); sum += c; cnt += (c > 0u) ? 1u : 0u; mine = (j == x) ? c : mine; }
        if (sum == G) break;
        __builtin_amdgcn_s_sleep(1);
        if ((++sp & 255u) == 0u) { if (xb_ld(&bar[XB_TMO])) break; if (sp > XB_SPIN_CAP) { atomicAdd(&bar[XB_TMO], 1u); break; } }
    }
    nloc = mine > 0u ? mine : 1u; nx = cnt > 0u ? cnt : 1u;
}
__device__ __forceinline__ void xcd_barrier(const XcdBarrier& b) {
    asm volatile("s_waitcnt vmcnt(0)" ::: "memory");
    __syncthreads();
    if (threadIdx.x == 0) {
        unsigned* bar = b.bar;
        __builtin_amdgcn_s_waitcnt(0);
        unsigned nloc = b.st[0], nx = b.st[1];
        if (nloc == 0u) { xcd_barrier_complete(bar, b.x, nloc, nx); b.st[0] = nloc; b.st[1] = nx; }
        const unsigned old = xb_add(&bar[XB_XSUB(b.x)], 1u);
        const unsigned gen = old / nloc;
        if (old + 1u == (gen + 1u) * nloc) {
            __builtin_amdgcn_fence(__ATOMIC_RELEASE, "agent");
            asm volatile("s_waitcnt vmcnt(0)" ::: "memory");
            const unsigned og = xb_add(&bar[XB_TOP], 1u);
            const unsigned tg = og / nx;
            if (og + 1u == (tg + 1u) * nx) xb_add(&bar[XB_TOPGEN], 1u);
            else XB_SPIN(xb_ld(&bar[XB_TOPGEN]) == tg, bar);
            __builtin_amdgcn_fence(__ATOMIC_ACQUIRE, "agent");
            xb_add(&bar[XB_XGEN(b.x)], 1u);
            asm volatile("s_waitcnt vmcnt(0)" ::: "memory");
        } else {
            XB_SPIN(xb_ld(&bar[XB_XGEN(b.x)]) == gen, bar);
            __builtin_amdgcn_fence(__ATOMIC_ACQUIRE, "agent");
            asm volatile("s_waitcnt vmcnt(0)" ::: "memory");
        }
    }
    __syncthreads();
}

__device__ __forceinline__ void p0_transpose(const float* __restrict__ W, int K, int N, hf* __restrict__ WT, int item, float* lds) {
    const int nb = N / 64;
    const int kb = item / nb, nbk = item % nb, k0 = kb * 64, n0 = nbk * 64;
    const int tid = tid_();
#pragma unroll
    for (int i = 0; i < 8; ++i) {
        int kk = (tid >> 6) + 8 * i, c = tid & 63;
        lds[kk * 65 + c] = W[(size_t)(k0 + kk) * N + n0 + c];
    }
    __syncthreads();
    const int n = tid >> 3, kc = (tid & 7) * 8;
    hf8 o;
#pragma unroll
    for (int j = 0; j < 8; ++j) o[j] = (hf)lds[(kc + j) * 65 + n];
    *(hf8*)(WT + (size_t)(n0 + n) * K + k0 + kc) = o;
    __syncthreads();
}

__device__ __forceinline__ void p0_adaln(const Params& p, int item, unsigned char* smem) {
    hf* SC = (hf*)smem;
    hf* Wt = SC + 144 * 72;
    float* MOD = (float*)(p.ws + WS_MOD);
    const int gc0 = item * 32;
    const int l = gc0 / 3072, lc0 = gc0 % 3072;
    const float* W = p.w_ada + (size_t)l * 1024 * 3072;
    const int tid = tid_(), lane = tid & 63, wave = tid >> 6;
    const int nt = wave & 1, mg = wave >> 1;
    const int mt0 = (mg == 0) ? 0 : (2 * mg + 1);
    const int nmt = (mg == 0) ? 3 : 2;
    f32x4 acc[3];
#pragma unroll
    for (int i = 0; i < 3; ++i) acc[i] = (f32x4){0.f, 0.f, 0.f, 0.f};
    float cv[17], wv[4];
    auto gload = [&](int kt) {
        const int k0 = kt * 64;
#pragma unroll
        for (int i = 0; i < 17; ++i) {
            const int e = tid + 512 * i, row = e >> 6, k = e & 63;
            const float* cr = row < 8 ? p.c_prompt + row * 1024 : p.c_sample + (row - 8) * 1024;
            cv[i] = cr[k0 + k];
        }
#pragma unroll
        for (int i = 0; i < 4; ++i) {
            const int e = tid + 512 * i, kk = e >> 5, n = e & 31;
            wv[i] = W[(size_t)(k0 + kk) * 3072 + lc0 + n];
        }
    };
    gload(0);
    { int row = 136 + (tid >> 6), k = tid & 63; SC[row * 72 + k] = (hf)0.f; }
    for (int kt = 0; kt < 16; ++kt) {
#pragma unroll
        for (int i = 0; i < 17; ++i) {
            const int e = tid + 512 * i, row = e >> 6, k = e & 63;
            SC[row * 72 + k] = (hf)silu(cv[i]);
        }
#pragma unroll
        for (int i = 0; i < 4; ++i) {
            const int e = tid + 512 * i, kk = e >> 5, n = e & 31;
            Wt[n * 72 + kk] = (hf)wv[i];
        }
        __syncthreads();
        if (kt + 1 < 16) gload(kt + 1);
#pragma unroll
        for (int ks = 0; ks < 2; ++ks) {
            hf8 bfrag = *(const hf8*)(Wt + (nt * 16 + (lane & 15)) * 72 + ks * 32 + (lane >> 4) * 8);
#pragma unroll
            for (int i = 0; i < 3; ++i) {
                if (i < nmt) {
                    hf8 afrag = *(const hf8*)(SC + ((mt0 + i) * 16 + (lane & 15)) * 72 + ks * 32 + (lane >> 4) * 8);
                    acc[i] = __builtin_amdgcn_mfma_f32_16x16x32_f16(bfrag, afrag, acc[i], 0, 0, 0);
                }
            }
        }
        __syncthreads();
    }
#pragma unroll
    for (int i = 0; i < 3; ++i) {
        if (i < nmt) {
            int row = (mt0 + i) * 16 + (lane & 15);
            if (row < NSEQ) {
#pragma unroll
                for (int j = 0; j < 4; ++j) {
                    int gc = gc0 + nt * 16 + (lane >> 4) * 4 + j;
                    MOD[(size_t)row * 6144 + gc] = acc[i][j] + p.b_ada[gc];
                }
            }
        }
    }
}

__device__ __forceinline__ void phase0(const Params& p, unsigned char* smem) {
    constexpr int I_ADA = 192;
    constexpr int I_WIN = 16 * 58;
    constexpr int I_WOUT = 16 * 16;
    constexpr int I_LORA = 8;
    constexpr int NITEMS = I_ADA + 2 * (I_WIN + I_WOUT + 2 * I_LORA);
    constexpr int NTR = NITEMS - I_ADA;
    constexpr int EXTRA = 6;
    auto transpose_item = [&](int r) {
        const int l = r / (I_WIN + I_WOUT + 2 * I_LORA);
        r = r % (I_WIN + I_WOUT + 2 * I_LORA);
        float* lds = (float*)smem;
        if (r < I_WIN) { p0_transpose(p.w_in + (size_t)l * D * PIN, D, PIN, (hf*)(p.ws + WS_WTIN) + (size_t)l * PINP * D, r, lds); return; }
        r -= I_WIN;
        if (r < I_WOUT) { p0_transpose(p.w_out + (size_t)l * D * D, D, D, (hf*)(p.ws + WS_WTOUT) + (size_t)l * D * D, r, lds); return; }
        r -= I_WOUT;
        if (r < I_LORA) { p0_transpose(p.w_up + (size_t)l * 64 * 512, 64, 512, (hf*)(p.ws + WS_WUPT) + (size_t)l * 512 * 64, r, lds); return; }
        r -= I_LORA;
        p0_transpose(p.a_up + (size_t)l * 64 * 512, 64, 512, (hf*)(p.ws + WS_AUPT) + (size_t)l * 512 * 64, r, lds);
    };
    const int nb = gridDim.x, b = blockIdx.x;
    const int nfree = nb > I_ADA ? nb - I_ADA : 0;
    const int nextra = min(nfree * EXTRA, NTR);
    for (int it = b; it < I_ADA; it += nb) p0_adaln(p, it, smem);
    if (b >= I_ADA) for (int i = 0; i < EXTRA; ++i) { const int r = (b - I_ADA) + nfree * i; if (r < nextra) transpose_item(r); }
    for (int r = nextra + b; r < NTR; r += nb) transpose_item(r);
}

__device__ __forceinline__ void phase1(const Params& p, int l) {
    const int tid = tid_(); const int lane = tid & 63, wave = tid >> 6;
    hf* H = (hf*)(p.ws + WS_H);
    const float* MOD = (const float*)(p.ws + WS_MOD);
    auto coff = [&](int q) { return 512 * (q >> 1) + 8 * lane + 4 * (q & 1); };
    for (int tk = blockIdx.x * 8 + wave; tk < MROWS; tk += gridDim.x * 8) {
        if (tk >= NTOK) {
            const int bs = tk - NTOK;
            const float* s = p.state_shift + ((size_t)l * 128 + bs) * D;
#pragma unroll
            for (int j = 0; j < 2; ++j) {
                const f32x4 v0 = *(const f32x4*)(s + coff(2 * j)), v1 = *(const f32x4*)(s + coff(2 * j + 1));
                const hf8 o = {(hf)v0.x, (hf)v0.y, (hf)v0.z, (hf)v0.w, (hf)v1.x, (hf)v1.y, (hf)v1.z, (hf)v1.w};
                st16_wt(H + (size_t)tk * D + coff(2 * j), __builtin_bit_cast(u32x4, o));
            }
            continue;
        }
        const int sq = seq_of(tk);
        const float* xr = x0_row(p, tk);
        f32x4 x[4];
#pragma unroll
        for (int q = 0; q < 4; ++q) x[q] = *(const f32x4*)(xr + coff(q));
        if (l == 1) {
            const hf* mo = (const hf*)(p.out + O_Y + (size_t)tk * D);
            f32x4 m[4];
            float ss = 0.f;
#pragma unroll
            for (int q = 0; q < 4; ++q) {
                hf4 t = *(const hf4*)(mo + coff(q));
                m[q] = (f32x4){(float)t.x, (float)t.y, (float)t.z, (float)t.w};
                ss += m[q].x * m[q].x + m[q].y * m[q].y + m[q].z * m[q].z + m[q].w * m[q].w;
            }
            const float rs = rsqrtf(wave_sum_all(ss) * (1.f / D) + 1e-6f);
#pragma unroll
            for (int q = 0; q < 4; ++q) {
                f32x4 gp = *(const f32x4*)(p.g_post + coff(q));
                f32x4 gt = *(const f32x4*)(MOD + (size_t)sq * 6144 + 2048 + coff(q));
                x[q] = x[q] + gt * (m[q] * rs * gp);
            }
        }
        float ss = 0.f;
#pragma unroll
        for (int q = 0; q < 4; ++q) ss += x[q].x * x[q].x + x[q].y * x[q].y + x[q].z * x[q].z + x[q].w * x[q].w;
        const float rs = rsqrtf(wave_sum_all(ss) * (1.f / D) + 1e-6f);
        const bool last = is_last_tok(tk);
        float* so = nullptr;
        if (last) so = (sq < 8) ? p.out + O_SHIFT_P + ((size_t)l * 8 + sq) * D : p.out + O_SHIFT_S + ((size_t)l * 128 + (sq - 8)) * D;
        f32x4 h[4];
#pragma unroll
        for (int q = 0; q < 4; ++q) {
            f32x4 g = *(const f32x4*)(p.g_pre + (size_t)l * D + coff(q));
            f32x4 sh = *(const f32x4*)(MOD + (size_t)sq * 6144 + l * 3072 + coff(q));
            f32x4 sc = *(const f32x4*)(MOD + (size_t)sq * 6144 + l * 3072 + 1024 + coff(q));
            h[q] = (x[q] * rs * g) * (1.f + sc) + sh;
            if (last) *(f32x4*)(so + coff(q)) = h[q];
        }
#pragma unroll
        for (int j = 0; j < 2; ++j) {
            const f32x4 v0 = h[2 * j], v1 = h[2 * j + 1];
            const hf8 o = {(hf)v0.x, (hf)v0.y, (hf)v0.z, (hf)v0.w, (hf)v1.x, (hf)v1.y, (hf)v1.z, (hf)v1.w};
            st16_wt(H + (size_t)tk * D + coff(2 * j), __builtin_bit_cast(u32x4, o));
        }
    }
}

constexpr int G_BM = 256, G_BN = 128, G_BK = 64, G_LD = 72;
constexpr int G_ASZ = G_BM * G_LD, G_BSZ = G_BN * G_LD;
template <int EPI>
__device__ __forceinline__ void gemm_tile(const hf* __restrict__ A, const hf* __restrict__ Bt, hf* __restrict__ C, int m0, int n0, int mlimit, int ldc, unsigned char* smem) {
    hf* As = (hf*)smem;
    hf* Bs = As + 2 * G_ASZ;
    const int tid = tid_(), lane = tid & 63, wave = tid >> 6;
    const int wm = wave >> 1, wn = wave & 1;
    const int fr = lane & 15, fq = lane >> 4;
    f32x4 acc[4][4];
#pragma unroll
    for (int i = 0; i < 4; ++i)
#pragma unroll
        for (int j = 0; j < 4; ++j) acc[i][j] = (f32x4){0.f, 0.f, 0.f, 0.f};
    hf8 ra[4], rb[2];
    const int lrow = tid >> 3, lkc = (tid & 7) * 8;
    auto gload = [&](int kt) {
#pragma unroll
        for (int i = 0; i < 4; ++i) ra[i] = *(const hf8*)(A + (size_t)(m0 + lrow + 64 * i) * D + kt * G_BK + lkc);
#pragma unroll
        for (int i = 0; i < 2; ++i) rb[i] = *(const hf8*)(Bt + (size_t)(n0 + lrow + 64 * i) * D + kt * G_BK + lkc);
    };
    auto lstore = [&](int buf) {
#pragma unroll
        for (int i = 0; i < 4; ++i) *(hf8*)(As + buf * G_ASZ + (lrow + 64 * i) * G_LD + lkc) = ra[i];
#pragma unroll
        for (int i = 0; i < 2; ++i) *(hf8*)(Bs + buf * G_BSZ + (lrow + 64 * i) * G_LD + lkc) = rb[i];
    };
    gload(0);
    lstore(0);
    __syncthreads();
    constexpr int NKT = D / G_BK;
    for (int kt = 0; kt < NKT; ++kt) {
        const int buf = kt & 1;
        if (kt + 1 < NKT) gload(kt + 1);
        const hf* as = As + buf * G_ASZ + (wm * 64 + fr) * G_LD + fq * 8;
        const hf* bs = Bs + buf * G_BSZ + (wn * 64 + fr) * G_LD + fq * 8;
#pragma unroll
        for (int ks = 0; ks < 2; ++ks) {
            hf8 af[4], bf[4];
#pragma unroll
            for (int i = 0; i < 4; ++i) af[i] = *(const hf8*)(as + i * 16 * G_LD + ks * 32);
#pragma unroll
            for (int i = 0; i < 4; ++i) bf[i] = *(const hf8*)(bs + i * 16 * G_LD + ks * 32);
#pragma unroll
            for (int i = 0; i < 4; ++i)
#pragma unroll
                for (int j = 0; j < 4; ++j)
                    acc[i][j] = __builtin_amdgcn_mfma_f32_16x16x32_f16(bf[j], af[i], acc[i][j], 0, 0, 0);
        }
        if (kt + 1 < NKT) lstore(buf ^ 1);
        __syncthreads();
    }
#pragma unroll
    for (int i = 0; i < 4; ++i) {
        const int row = m0 + wm * 64 + i * 16 + fr;
        if (row < mlimit) {
#pragma unroll
            for (int j = 0; j < 4; ++j) {
                const int col = n0 + wn * 64 + j * 16 + fq * 4;
                hf4 o = {(hf)acc[i][j][0], (hf)acc[i][j][1], (hf)acc[i][j][2], (hf)acc[i][j][3]};
                *(hf4*)(C + (size_t)row * ldc + col) = o;
            }
        }
    }
}

constexpr int Q_BM = 256, Q_BK = 64, Q_HALF = 128, Q_NXCD = 8, Q_WGM = 8, Q_HT = Q_HALF * Q_BK;
__device__ __forceinline__ int q_lds_byte(int r, int c) {
    int st = (r >> 4) * 2 + (c >> 5), rr = r & 15, cc = c & 31, ob = rr * 64 + cc * 2;
    return st * 1024 + (ob ^ (((ob >> 9) & 1) << 5));
}
__device__ __forceinline__ void q_stage_rc(int b, int& R, int& C) {
    int st = b / 1024, sb = b % 1024, swz = sb ^ (((sb >> 9) & 1) << 5);
    R = (st >> 1) * 16 + swz / 64; C = (st & 1) * 32 + (swz % 64) / 2;
}
__device__ __forceinline__ void q_tile_of(int wgid, int nM, int nN, int& pm, int& pn) {
    const int nwg = nM * nN;
    { const int q = nwg / Q_NXCD, r = nwg % Q_NXCD, xcd = wgid % Q_NXCD, off = wgid / Q_NXCD; wgid = (xcd < r ? xcd * (q + 1) : r * (q + 1) + (xcd - r) * q) + off; }
    const int nig = Q_WGM * nN, gid = wgid / nig, fm = gid * Q_WGM, gsz = min(nM - fm, Q_WGM);
    pm = fm + ((wgid % nig) % gsz); pn = (wgid % nig) / gsz;
}
__device__ __forceinline__ void gemm256(const hf* __restrict__ A, const hf* __restrict__ Bt, hf* __restrict__ C, int brow, int bcol, int mlimit, int nlimit, int ldc, unsigned char* smem) {
    constexpr int K = D;
    hf* shm = (hf*)smem;
    const int qtid = tid_();
#define SA(b,h) (shm+((b)*2+(h))*Q_HT)
#define SB(b,h) (shm+(4+(b)*2+(h))*Q_HT)
#define STAGE(P,BASE,br,kt) do{const char* _gb=(const char*)((BASE)+(long)(br)*K+(long)(kt)*Q_BK); \
    __builtin_amdgcn_global_load_lds((const unsigned*)(_gb+so0),(unsigned*)((char*)(P)+qtid*16),16,0,0); \
    __builtin_amdgcn_global_load_lds((const unsigned*)(_gb+so1),(unsigned*)((char*)(P)+qtid*16+8192),16,0,0);}while(0)
#define LDA(dst,b,h) _Pragma("unroll") for(int m=0;m<4;++m) _Pragma("unroll") for(int k=0;k<2;++k) \
    dst[m][k]=*reinterpret_cast<const hf8*>((char*)SA(b,h)+q_lds_byte(wr*64+m*16+fr,k*32+fq*8))
#define LDB(dst,b,h) _Pragma("unroll") for(int n=0;n<2;++n) _Pragma("unroll") for(int k=0;k<2;++k) \
    dst[n][k]=*reinterpret_cast<const hf8*>((char*)SB(b,h)+q_lds_byte(wc*32+n*16+fr,k*32+fq*8))
#define MMA(ai,bj,At,Bt_) do{__builtin_amdgcn_s_setprio(1); \
    _Pragma("unroll") for(int m=0;m<4;++m) _Pragma("unroll") for(int n=0;n<2;++n) _Pragma("unroll") for(int k=0;k<2;++k) \
      acc[ai][bj][m][n]=__builtin_amdgcn_mfma_f32_16x16x32_f16(Bt_[n][k],At[m][k],acc[ai][bj][m][n],0,0,0); \
    __builtin_amdgcn_s_setprio(0);}while(0)
#define WAIT_V(n) asm volatile("s_waitcnt vmcnt(" #n ")":::"memory")
#define WAIT_L(n) asm volatile("s_waitcnt lgkmcnt(" #n ")":::"memory")
#define BAR __builtin_amdgcn_s_barrier()
#define SCHED __builtin_amdgcn_sched_barrier(0)
    const int wid = qtid >> 6, lane = qtid & 63, wr = wid >> 2, wc = wid & 3, fr = lane & 15, fq = lane >> 4;
    unsigned so0, so1;
    { int r_, c_; q_stage_rc(qtid * 16, r_, c_); so0 = (unsigned)(r_ * K + c_) * 2u; q_stage_rc(qtid * 16 + 8192, r_, c_); so1 = (unsigned)(r_ * K + c_) * 2u; }
    f32x4 acc[2][2][4][2] = {};
    hf8 At[4][2], B0[2][2], B1[2][2];
    constexpr int nt = K / Q_BK;
    STAGE(SB(0,0),Bt,bcol,0); STAGE(SA(0,0),A,brow,0);
    STAGE(SB(0,1),Bt,bcol+Q_HALF,0); STAGE(SA(0,1),A,brow+Q_HALF,0);
    if(wr==1)BAR;
    WAIT_V(4); BAR;
    STAGE(SB(1,0),Bt,bcol,1); STAGE(SA(1,0),A,brow,1); STAGE(SB(1,1),Bt,bcol+Q_HALF,1);
    WAIT_V(6); BAR;
    for(int t=0;t<nt-2;t+=2){
        LDB(B0,0,0); SCHED; LDA(At,0,0); STAGE(SA(1,1),A,brow+Q_HALF,t+1);
        WAIT_L(8); BAR; WAIT_L(0); MMA(0,0,At,B0); BAR; SCHED;
        LDB(B1,0,1); STAGE(SB(0,0),Bt,bcol,t+2);
        BAR; WAIT_L(0); MMA(0,1,At,B1); BAR;
        LDA(At,0,1); STAGE(SA(0,0),A,brow,t+2);
        BAR; WAIT_L(0); MMA(1,0,At,B0); BAR; SCHED;
        STAGE(SB(0,1),Bt,bcol+Q_HALF,t+2);
        WAIT_V(6); BAR; MMA(1,1,At,B1); BAR;
        LDB(B0,1,0); SCHED; LDA(At,1,0); STAGE(SA(0,1),A,brow+Q_HALF,t+2);
        WAIT_L(8); BAR; WAIT_L(0); MMA(0,0,At,B0); BAR; SCHED;
        LDB(B1,1,1); STAGE(SB(1,0),Bt,bcol,t+3);
        BAR; WAIT_L(0); MMA(0,1,At,B1); BAR;
        LDA(At,1,1); STAGE(SA(1,0),A,brow,t+3);
        BAR; WAIT_L(0); MMA(1,0,At,B0); BAR; SCHED;
        STAGE(SB(1,1),Bt,bcol+Q_HALF,t+3);
        WAIT_V(6); BAR; MMA(1,1,At,B1); BAR;
    }
    { LDB(B0,0,0); LDA(At,0,0); STAGE(SA(1,1),A,brow+Q_HALF,nt-1);
      BAR; WAIT_L(0); MMA(0,0,At,B0); BAR;
      LDB(B1,0,1); BAR; WAIT_L(0); MMA(0,1,At,B1); BAR;
      LDA(At,0,1); WAIT_V(4); BAR; WAIT_L(0); MMA(1,0,At,B0); MMA(1,1,At,B1); BAR; }
    { LDB(B0,1,0); LDA(At,1,0); WAIT_V(2); BAR; WAIT_L(0); MMA(0,0,At,B0); BAR;
      LDB(B1,1,1); WAIT_V(0); BAR; WAIT_L(0); MMA(0,1,At,B1); BAR;
      LDA(At,1,1); BAR; WAIT_L(0); MMA(1,0,At,B0); MMA(1,1,At,B1); BAR; }
    if(wr==0)BAR;
#pragma unroll
    for(int ai=0;ai<2;++ai)
#pragma unroll
    for(int bj=0;bj<2;++bj)
#pragma unroll
    for(int m=0;m<4;++m){
        const int row = brow+ai*Q_HALF+wr*64+m*16+fr;
        const f32x4 a = acc[ai][bj][m][0], b = acc[ai][bj][m][1];
        const hf4 ha = {(hf)a[0], (hf)a[1], (hf)a[2], (hf)a[3]}, hb = {(hf)b[0], (hf)b[1], (hf)b[2], (hf)b[3]};
        const u32x2 ua = __builtin_bit_cast(u32x2, ha), ub = __builtin_bit_cast(u32x2, hb);
        const auto r0 = __builtin_amdgcn_permlane16_swap(ua.x, ub.x, false, false);
        const auto r1 = __builtin_amdgcn_permlane16_swap(ua.y, ub.y, false, false);
        const u32x4 o = {r0[0], r1[0], r0[1], r1[1]};
        const int col = bcol+bj*Q_HALF+wc*32 + ((fq & 1) ? 16 + (fq - 1) * 4 : fq * 4);
        if (row < mlimit && col < nlimit) {
            st16_wt(C + (size_t)row * ldc + col, o);
        }
    }
    __syncthreads();
#undef SA
#undef SB
#undef STAGE
#undef LDA
#undef LDB
#undef MMA
#undef WAIT_V
#undef WAIT_L
#undef BAR
#undef SCHED
}

__device__ __forceinline__ void phase2(const Params& p, int l, unsigned char* smem) {
    const hf* A = (const hf*)(p.ws + WS_H);
    const hf* Bt = (const hf*)(p.ws + WS_WTIN) + (size_t)l * PINP * D;
    hf* U = (hf*)(p.ws + WS_U);
    constexpr int NMT = MPAD / 256, NNT = PINP / 256;
    for (int t = blockIdx.x; t < NMT * NNT; t += gridDim.x) {
        int pm, pn;
        q_tile_of(t, NMT, NNT, pm, pn);
        gemm256(A, Bt, U, pm * 256, pn * 256, MROWS, PIN, PIN, smem);
    }
}
__device__ __forceinline__ void phase5b(const Params& p, int l, unsigned char* smem) {
    const hf* A = (const hf*)(p.ws + WS_MIX);
    const hf* Bt = (const hf*)(p.ws + WS_WTOUT) + (size_t)l * D * D;
    hf* C = (hf*)(p.out + O_Y) + l * 1024;
    for (int t = blockIdx.x; t < 64 * 4; t += gridDim.x) {
        int pm, pn;
        q_tile_of(t, 64, 4, pm, pn);
        gemm256(A, Bt, C, pm * 256, pn * 256, NTOK, D, 2048, smem);
    }
    for (int t = blockIdx.x; t < 256; t += gridDim.x) {
        const int tid = tid_(), lane = tid & 63, wave = tid >> 6;
        const int fr = lane & 15, fq = lane >> 4;
        const int m0 = 16384 + (t >> 5) * 64 + (wave >> 1) * 16, n0 = (t & 31) * 32 + (wave & 1) * 16;
        const hf* ap = A + (size_t)(m0 + fr) * D + fq * 8;
        const hf* bp = Bt + (size_t)(n0 + fr) * D + fq * 8;
        f32x4 acc0 = {0.f, 0.f, 0.f, 0.f}, acc1 = {0.f, 0.f, 0.f, 0.f};
#pragma unroll 4
        for (int k = 0; k < D; k += 64) {
            const hf8 a0 = *(const hf8*)(ap + k), b0 = *(const hf8*)(bp + k);
            const hf8 a1 = *(const hf8*)(ap + k + 32), b1 = *(const hf8*)(bp + k + 32);
            acc0 = __builtin_amdgcn_mfma_f32_16x16x32_f16(b0, a0, acc0, 0, 0, 0);
            acc1 = __builtin_amdgcn_mfma_f32_16x16x32_f16(b1, a1, acc1, 0, 0, 0);
        }
        const f32x4 a = acc0 + acc1;
        hf4 o = {(hf)a[0], (hf)a[1], (hf)a[2], (hf)a[3]};
        *(hf4*)(C + (size_t)(m0 + fr) * 2048 + n0 + fq * 4) = o;
    }
}

__device__ __forceinline__ void p3_lora(const Params& p, int l, int witem, int h0, int h1) {
    const int lane = tid_() & 63;
    const int fr = lane & 15, fq = lane >> 4;
    const hf* U = (const hf*)(p.ws + WS_U);
    hf* EA = (hf*)(p.ws + WS_EA);
    hf* KKB = (hf*)(p.ws + WS_H);
    const hf* WupT = (const hf*)(p.ws + WS_WUPT) + (size_t)l * 512 * 64;
    const hf* AupT = (const hf*)(p.ws + WS_AUPT) + (size_t)l * 512 * 64;
    const float* mu = p.mu + (size_t)l * PRW;
    const int tk = witem * 16 + fr;
    const int pr = prev_row(tk);
    const float pm = pr >= 0 ? 1.f : 0.f;
    const hf* ut = U + (size_t)tk * PIN;
    const hf* up = U + (size_t)(pr >= 0 ? pr : 0) * PIN;
    hf8 aw[2], aa[2];
#pragma unroll
    for (int ks = 0; ks < 2; ++ks) {
        const int kb = ks * 32 + fq * 8;
        const hf8 cw = *(const hf8*)(ut + 2048 + kb), ca = *(const hf8*)(ut + 2112 + kb);
        const hf8 pw = *(const hf8*)(up + 2048 + kb), pa = *(const hf8*)(up + 2112 + kb);
#pragma unroll
        for (int j = 0; j < 8; ++j) {
            float c = (float)cw[j], q = (float)pw[j] * pm;
            aw[ks][j] = (hf)tanh_fast(c + (q - c) * mu[2048 + kb + j]);
            c = (float)ca[j]; q = (float)pa[j] * pm;
            aa[ks][j] = (hf)(c + (q - c) * mu[2112 + kb + j]);
        }
    }
    auto store_pair = [&](hf* base, int n0, hf4 t0, hf4 t1) {
        const u32x2 ua = __builtin_bit_cast(u32x2, t0), ub = __builtin_bit_cast(u32x2, t1);
        const auto r0 = __builtin_amdgcn_permlane16_swap(ua.x, ub.x, false, false);
        const auto r1 = __builtin_amdgcn_permlane16_swap(ua.y, ub.y, false, false);
        const u32x4 o = {r0[0], r1[0], r0[1], r1[1]};
        const int col = n0 + ((fq & 1) ? 16 + (fq - 1) * 4 : fq * 4);
        st16_wt(base + (size_t)tk * D + col, o);
    };
    for (int h = h0; h < h1; ++h) {
        f32x4 av[4], kv[4];
        hf4 eo[4], ao[4];
        float ss = 0.f;
#pragma unroll
        for (int nt = 0; nt < 4; ++nt) {
            const int n0 = h * 64 + nt * 16;
            f32x4 cw = {0.f, 0.f, 0.f, 0.f}, ca = {0.f, 0.f, 0.f, 0.f};
#pragma unroll
            for (int ks = 0; ks < 2; ++ks) {
                const hf8 bw = *(const hf8*)(WupT + (size_t)(n0 + fr) * 64 + ks * 32 + fq * 8);
                const hf8 ba = *(const hf8*)(AupT + (size_t)(n0 + fr) * 64 + ks * 32 + fq * 8);
                cw = __builtin_amdgcn_mfma_f32_16x16x32_f16(bw, aw[ks], cw, 0, 0, 0);
                ca = __builtin_amdgcn_mfma_f32_16x16x32_f16(ba, aa[ks], ca, 0, 0, 0);
            }
            const int col = n0 + fq * 4;
            const f32x4 w0c = *(const f32x4*)(p.w0 + l * 512 + col), a0c = *(const f32x4*)(p.a0 + l * 512 + col);
            const f32x4 kkc = *(const f32x4*)(p.k_k + l * 512 + col), muk = *(const f32x4*)(mu + 512 + col), kac = *(const f32x4*)(p.k_a + l * 512 + col);
            const hf4 kc4 = *(const hf4*)(ut + 512 + col), kp4 = *(const hf4*)(up + 512 + col);
            const f32x4 kcf = {(float)kc4.x, (float)kc4.y, (float)kc4.z, (float)kc4.w};
            const f32x4 kpf = (f32x4){(float)kp4.x, (float)kp4.y, (float)kp4.z, (float)kp4.w} * pm;
            const f32x4 kl = kcf + (kpf - kcf) * muk;
            const f32x4 xe = w0c + cw, xa = a0c + ca;
            f32x4 e4, a4;
            e4.x = sigm(xe.x); e4.y = sigm(xe.y); e4.z = sigm(xe.z); e4.w = sigm(xe.w);
            a4.x = sigm(xa.x); a4.y = sigm(xa.y); a4.z = sigm(xa.z); a4.w = sigm(xa.w);
            e4 = e4 * 0.60653066f;
            const f32x4 km = kl * (1.f + (a4 - 1.f) * kac);
            const f32x4 kkr = kl * kkc;
            eo[nt] = (hf4){(hf)e4.x, (hf)e4.y, (hf)e4.z, (hf)e4.w};
            ao[nt] = (hf4){(hf)km.x, (hf)km.y, (hf)km.z, (hf)km.w};
            av[nt] = a4; kv[nt] = kkr;
            const f32x4 k2 = kkr * kkr;
            ss += (k2.x + k2.y) + (k2.z + k2.w);
        }
        store_pair(EA, h * 64, eo[0], eo[1]);
        store_pair(EA, h * 64 + 32, eo[2], eo[3]);
        store_pair(EA + 512, h * 64, ao[0], ao[1]);
        store_pair(EA + 512, h * 64 + 32, ao[2], ao[3]);
        ss += __shfl_xor(ss, 16);
        ss += __shfl_xor(ss, 32);
        const float inv = 1.f / fmaxf(sqrtf(ss), 1e-12f);
        hf4 ko[4], bo[4];
#pragma unroll
        for (int nt = 0; nt < 4; ++nt) {
#pragma unroll
            for (int j = 0; j < 4; ++j) { const float kk = kv[nt][j] * inv; ko[nt][j] = (hf)kk; bo[nt][j] = (hf)(kk * av[nt][j]); }
        }
        store_pair(KKB, h * 64, ko[0], ko[1]);
        store_pair(KKB, h * 64 + 32, ko[2], ko[3]);
        store_pair(KKB + 512, h * 64, bo[0], bo[1]);
        store_pair(KKB + 512, h * 64 + 32, bo[2], bo[3]);
    }
}

template <int NT>
__device__ __forceinline__ void conv_taps(const float* G, const float* w, float bias, float* acc) {
    typedef float cf2 __attribute__((ext_vector_type(2)));
    cf2 W2[32];
#pragma unroll
    for (int j = 0; j < 32; ++j) W2[j] = (cf2){j < 31 ? w[j] : 0.f, j > 0 ? w[j - 1] : 0.f};
    cf2 ap[NT / 2];
#pragma unroll
    for (int pi = 0; pi < NT / 2; ++pi) ap[pi] = (cf2){bias, bias};
#pragma unroll
    for (int r = 0; r < NT + 30; ++r) {
        const float g = G[r * 64];
        const cf2 gg = {g, g};
#pragma unroll
        for (int pi = 0; pi < NT / 2; ++pi) {
            const int j = r - 2 * pi;
            if (j >= 0 && j <= 31) ap[pi] = gg * W2[j] + ap[pi];
        }
    }
#pragma unroll
    for (int pi = 0; pi < NT / 2; ++pi) { acc[2 * pi] = ap[pi].x; acc[2 * pi + 1] = ap[pi].y; }
}

__device__ __forceinline__ void p3_conv_prompt(const Params& p, int l, int item, unsigned char* smem) {
    float* G = (float*)smem;
    hf* T = (hf*)(smem + 286 * 64 * 4) + (tid_() >> 6) * 512;
    const int g = item & 7, tt = (item >> 3) & 7, b = item >> 6;
    const int c0 = g * 64, t0 = tt * 256;
    const hf* U = (const hf*)(p.ws + WS_U);
    hf* MIX = (hf*)(p.ws + WS_MIX);
    const int tid = tid_();
    const int c = tid & 63, tq = tid >> 6;
    const int ch = c0 + c;
    float w[31];
#pragma unroll
    for (int j = 0; j < 31; ++j) w[j] = p.w_dw[((size_t)l * 31 + j) * 512 + ch];
    const float bias = p.b_dw[l * 512 + ch], gg = p.gn_c_g[l * 512 + ch], gb = p.gn_c_b[l * 512 + ch];
    hf gcv[32];
#pragma unroll
    for (int i = 0; i < 32; ++i) gcv[i] = U[(size_t)(b * 2048 + t0 + tq * 32 + i) * PIN + PRW + 1024 + ch];
    {
        hf2 ua[18], ub[18];
#pragma unroll
        for (int i = 0; i < 18; ++i) {
            const int e = min(tid + NTHR * i, 286 * 32 - 1);
            const int r = e >> 5, cp = (e & 31) * 2;
            const int t = max(t0 - 30 + r, 0);
            const hf* u = U + (size_t)(b * 2048 + t) * PIN + PRW + c0 + cp;
            ua[i] = *(const hf2*)u; ub[i] = *(const hf2*)(u + 512);
        }
#pragma unroll
        for (int i = 0; i < 18; ++i) {
            const int e = tid + NTHR * i;
            if (e < 286 * 32) {
                const int r = e >> 5, cp = (e & 31) * 2;
                const float m = (t0 - 30 + r) >= 0 ? 1.f : 0.f;
                G[r * 64 + cp] = m * (float)ua[i].x * sigm((float)ub[i].x);
                G[r * 64 + cp + 1] = m * (float)ua[i].y * sigm((float)ub[i].y);
            }
        }
    }
    __syncthreads();
#pragma unroll
    for (int sub = 0; sub < 4; ++sub) {
        const int tl = tq * 32 + sub * 8;
        float acc[8];
        conv_taps<8>(G + tl * 64 + c, w, bias, acc);
#pragma unroll
        for (int i = 0; i < 8; ++i) {
            const int tk = b * 2048 + t0 + tl + i;
            const float mean = wave_sum_all(acc[i]) * (1.f / 64.f);
            const float var = fmaxf(wave_sum_all(acc[i] * acc[i]) * (1.f / 64.f) - mean * mean, 0.f);
            const float yn = (acc[i] - mean) * rsqrtf(var + 1e-5f) * gg + gb;
            (void)tk;
            T[i * 64 + c] = (hf)silu2(yn, (float)gcv[sub * 8 + i]);
        }
        asm volatile("s_waitcnt lgkmcnt(0)" ::: "memory");
        {
            const int lane = tid & 63, tok = lane >> 3, ch8 = (lane & 7) * 8;
            const u32x4 v = *(const u32x4*)(T + tok * 64 + ch8);
            st16_wt(MIX + (size_t)(b * 2048 + t0 + tl + tok) * D + 512 + c0 + ch8, v);
        }
        asm volatile("s_waitcnt lgkmcnt(0)" ::: "memory");
    }
    if (tt == 7) {
        float* oc = p.out + O_CONV_P + ((size_t)l * 8 + b) * 30 * 512;
        for (int e = tid; e < 30 * 64; e += NTHR) {
            const int r = e >> 6, cc = e & 63;
            oc[(size_t)r * 512 + c0 + cc] = G[(256 + r) * 64 + cc];
        }
    }
    __syncthreads();
}

__device__ __forceinline__ void p3_conv_sample(const Params& p, int l, int item, unsigned char* smem) {
    float* G = (float*)smem;
    const int g = item & 7, s0 = (item >> 3) * 4;
    const int c0 = g * 64;
    const hf* U = (const hf*)(p.ws + WS_U);
    hf* MIX = (hf*)(p.ws + WS_MIX);
    const int tid = tid_();
    {
        float hv[15];
        hf ga[2], gbv[2];
#pragma unroll
        for (int i = 0; i < 15; ++i) {
            const int e = tid + NTHR * i, cc = e & 63, rr = (e >> 6) % 30, sl = (e >> 6) / 30;
            hv[i] = p.state_conv[(((size_t)l * 128 + s0 + sl) * 30 + rr) * 512 + c0 + cc];
        }
#pragma unroll
        for (int i = 0; i < 2; ++i) {
            const int e = tid + NTHR * i, cc = e & 63, tt = (e >> 6) & 3, sl = e >> 8;
            const hf* u = U + (size_t)(NTOKP + (s0 + sl) * 4 + tt) * PIN + PRW + c0 + cc;
            ga[i] = u[0]; gbv[i] = u[512];
        }
#pragma unroll
        for (int i = 0; i < 15; ++i) {
            const int e = tid + NTHR * i, cc = e & 63, rr = (e >> 6) % 30, sl = (e >> 6) / 30;
            G[(sl * 34 + rr) * 64 + cc] = hv[i];
        }
#pragma unroll
        for (int i = 0; i < 2; ++i) {
            const int e = tid + NTHR * i, cc = e & 63, tt = (e >> 6) & 3, sl = e >> 8;
            G[(sl * 34 + 30 + tt) * 64 + cc] = (float)ga[i] * sigm((float)gbv[i]);
        }
    }
    const int c = tid & 63, wv = tid >> 6;
    const int sl = wv >> 1, tp = (wv & 1) * 2;
    const int ch = c0 + c, bs = s0 + sl;
    float w[31];
#pragma unroll
    for (int j = 0; j < 31; ++j) w[j] = p.w_dw[((size_t)l * 31 + j) * 512 + ch];
    hf gcs[2];
#pragma unroll
    for (int i = 0; i < 2; ++i) gcs[i] = U[(size_t)(NTOKP + bs * 4 + tp + i) * PIN + PRW + 1024 + ch];
    __syncthreads();
    float acc[2];
    conv_taps<2>(G + (sl * 34 + tp) * 64 + c, w, p.b_dw[l * 512 + ch], acc);
    const float gg = p.gn_c_g[l * 512 + ch], gb = p.gn_c_b[l * 512 + ch];
#pragma unroll
    for (int i = 0; i < 2; ++i) {
        const int tk = NTOKP + bs * 4 + tp + i;
        const float mean = wave_sum(acc[i]) * (1.f / 64.f);
        const float d = acc[i] - mean;
        const float var = wave_sum(d * d) * (1.f / 64.f);
        const float yn = d * rsqrtf(var + 1e-5f) * gg + gb;
        MIX[(size_t)tk * D + 512 + ch] = (hf)silu2(yn, (float)gcs[i]);
    }
#pragma unroll
    for (int e = tid; e < 4 * 30 * 64; e += NTHR) {
        const int cc = e & 63, r = (e >> 6) % 30, s2 = (e >> 6) / 30;
        p.out[O_CONV_S + (((size_t)l * 128 + s0 + s2) * 30 + r) * 512 + c0 + cc] = G[(s2 * 34 + 4 + r) * 64 + cc];
    }
    __syncthreads();
}

__device__ __forceinline__ void phase3(const Params& p, int l, unsigned char* smem) {
    constexpr int W_LORA = NTOK / 16;
    constexpr int I_CP = 8 * 8 * 8;
    constexpr int I_CS = 32 * 8;
    {
        const int wave = tid_() >> 6;
        if (wave < 4) {
            const int wi = blockIdx.x + gridDim.x * wave;
            if (wi < W_LORA) p3_lora(p, l, wi, 0, 8);
        } else if (wave == 4) {
            const int piece = blockIdx.x;
            const int wi = 4 * (int)gridDim.x + (piece >> 3), hh = piece & 7;
            if (wi < W_LORA) p3_lora(p, l, wi, hh, hh + 1);
        }
    }
    for (int it = blockIdx.x; it < I_CP + I_CS; it += gridDim.x) {
        if (it < I_CP) p3_conv_prompt(p, l, it, smem);
        else p3_conv_sample(p, l, it - I_CP, smem);
    }
}

typedef float f32x2 __attribute__((ext_vector_type(2)));
struct WkvS { f32x2 lo, hi; };
__device__ __forceinline__ void wkv_step(WkvS& S, const float* op, float v, float& y) {
    const f32x4 r4 = *(const f32x4*)(op + 0 * 64);
    const f32x4 w4 = *(const f32x4*)(op + 1 * 64);
    const f32x4 m4 = *(const f32x4*)(op + 2 * 64);
    const f32x4 k4 = *(const f32x4*)(op + 3 * 64);
    const f32x4 b4 = *(const f32x4*)(op + 4 * 64);
    f32x2 d = S.lo * k4.lo + S.hi * k4.hi;
    const float sk = row_allreduce16(d.x + d.y);
    const f32x2 nsk = {-sk, -sk}, vv = {v, v};
    S.lo = vv * m4.lo + (nsk * b4.lo + S.lo * w4.lo);
    S.hi = vv * m4.hi + (nsk * b4.hi + S.hi * w4.hi);
    f32x2 e = S.lo * r4.lo + S.hi * r4.hi;
    y = row_allreduce16(e.x + e.y);
}

struct WkvOps { f32x4 r4, w4, m4, k4, b4; float v; };
__device__ __forceinline__ WkvOps wkv_load(const float* op, const float* vb) {
    WkvOps o;
    o.r4 = *(const f32x4*)(op + 0 * 64);
    o.w4 = *(const f32x4*)(op + 1 * 64);
    o.m4 = *(const f32x4*)(op + 2 * 64);
    o.k4 = *(const f32x4*)(op + 3 * 64);
    o.b4 = *(const f32x4*)(op + 4 * 64);
    o.v = *vb;
    return o;
}
struct WkvOpsS { f32x4 r4, m4, k4, b4; float v; };
__device__ __forceinline__ WkvOpsS wkv_load_s(const float* op, const float* vb) {
    WkvOpsS o;
    o.r4 = *(const f32x4*)(op + 0 * 64);
    o.m4 = *(const f32x4*)(op + 2 * 64);
    o.k4 = *(const f32x4*)(op + 3 * 64);
    o.b4 = *(const f32x4*)(op + 4 * 64);
    o.v = *vb;
    return o;
}
__device__ __forceinline__ float wkv_step_part(WkvS& S, const WkvOpsS& o, const f32x4& rprev) {
    f32x2 d = S.lo * o.k4.lo + S.hi * o.k4.hi;
    float s = d.x + d.y;
    const f32x2 vv = {o.v, o.v};
    f32x2 q = S.lo * rprev.lo + S.hi * rprev.hi;
    const f32x2 tl = vv * o.m4.lo + S.lo;
    const f32x2 th = vv * o.m4.hi + S.hi;
    s = row_allreduce16(s);
    const f32x2 nsk = {-s, -s};
    S.lo = nsk * o.b4.lo + tl;
    S.hi = nsk * o.b4.hi + th;
    return q.x + q.y;
}

__device__ __forceinline__ void wkv_step_pipe(WkvS& S, const WkvOps& o, float& eprev, float& enew) {
    f32x2 d = S.lo * o.k4.lo + S.hi * o.k4.hi;
    float s = d.x + d.y, e = eprev;
    s += dpp_mov<0x128>(s); e += dpp_mov<0x128>(e);
    s += dpp_mov<0x124>(s); e += dpp_mov<0x124>(e);
    s += dpp_mov<0x122>(s); e += dpp_mov<0x122>(e);
    s += dpp_mov<0x121>(s); e += dpp_mov<0x121>(e);
    eprev = e;
    const f32x2 nsk = {-s, -s}, vv = {o.v, o.v};
    S.lo = vv * o.m4.lo + (nsk * o.b4.lo + S.lo * o.w4.lo);
    S.hi = vv * o.m4.hi + (nsk * o.b4.hi + S.hi * o.w4.hi);
    f32x2 q = S.lo * o.r4.lo + S.hi * o.r4.hi;
    enew = q.x + q.y;
}

__device__ __forceinline__ void phase4(const Params& p, int l, unsigned char* smem) {
    constexpr int OPS = 324;
    float* OP = (float*)smem;
    float* VB = OP + 2 * 16 * OPS;
    float* YB = VB + 2 * 16 * 16;
    float* VS = YB + 2 * 16 * 16 * 17;
    float* GE = VS + 16 * 64;
    const int tid = tid_(), lane = tid & 63, wave = tid >> 6;
    const hf* U = (const hf*)(p.ws + WS_U);
    const hf* EA = (const hf*)(p.ws + WS_EA);
    const hf* KKB = (const hf*)(p.ws + WS_H);
    hf* MIX = (hf*)(p.ws + WS_MIX);
    const float* mu = p.mu + (size_t)l * PRW;
    const int blk = blockIdx.x;
    const int xcd = blk & 7, idx = blk >> 3;
    const int rg = idx & 3;
    const int pbh = xcd * 8 + (idx >> 2);
    const int pb = pbh >> 3, ph = pbh & 7;
    const bool producer = wave >= 4;
    const int pw = wave & 3;
    const int rl = lane >> 4, ks = lane & 15;
    constexpr int NCHP = 2048 / 16;

    const int cl = lane >> 4, pt = lane & 15;
    const int c4 = pw * 16 + cl * 4;
    const int pcol = ph * 64 + c4;
    const f32x4 mur4 = *(const f32x4*)(mu + pcol), muv4 = *(const f32x4*)(mu + 1024 + pcol);
    const int tkp = pb * 2048 + pt;
    const hf* uc = U + (size_t)tkp * PIN + pcol;
    const hf* eac = EA + (size_t)tkp * D + pcol;
    const hf* kbc = KKB + (size_t)tkp * D + pcol;
    struct PQ { hf4 r, v, rp, vp, e, a, kk, bb; };
    PQ qA, qB;
    auto load_prompt = [&](int ci, PQ& q) {
        const hf* u = uc + (size_t)ci * (16 * PIN);
        q.r = *(const hf4*)u; q.v = *(const hf4*)(u + 1024);
        q.rp = *(const hf4*)(u - PIN); q.vp = *(const hf4*)(u - PIN + 1024);
        const hf* e_ = eac + (size_t)ci * (16 * D);
        q.e = *(const hf4*)e_; q.a = *(const hf4*)(e_ + 512);
        const hf* k_ = kbc + (size_t)ci * (16 * D);
        q.kk = *(const hf4*)k_; q.bb = *(const hf4*)(k_ + 512);
    };
    auto cvt4 = [](hf4 x) { return (f32x4){(float)x.x, (float)x.y, (float)x.z, (float)x.w}; };
    auto scan16 = [](float x) {
        x += dpp_mov<0x111>(x);
        x += dpp_mov<0x112>(x);
        x += dpp_mov<0x114>(x);
        x += dpp_mov<0x118>(x);
        return x;
    };
    auto store_prompt = [&](int ci, int buf, const PQ& q) {
        const float pmask = (ci == 0 && pt == 0) ? 0.f : 1.f;
        const f32x4 rc = cvt4(q.r), vc = cvt4(q.v);
        const f32x4 rp = cvt4(q.rp) * pmask, vp = cvt4(q.vp) * pmask;
        const f32x4 e = cvt4(q.e);
        const f32x4 r = rc + (rp - rc) * mur4, v = vc + (vp - vc) * muv4;
        f32x4 cum;
        cum.x = scan16(e.x); cum.y = scan16(e.y); cum.z = scan16(e.z); cum.w = scan16(e.w);
        const f32x4 cpv = cum - e;
        f32x4 gin, gout, gprev;
        gin.x = __expf(-cum.x); gin.y = __expf(-cum.y); gin.z = __expf(-cum.z); gin.w = __expf(-cum.w);
        gout.x = __expf(cum.x); gout.y = __expf(cum.y); gout.z = __expf(cum.z); gout.w = __expf(cum.w);
        gprev.x = __expf(-cpv.x); gprev.y = __expf(-cpv.y); gprev.z = __expf(-cpv.z); gprev.w = __expf(-cpv.w);
        float* op = OP + buf * (16 * OPS) + pt * OPS + c4;
        *(f32x4*)(op + 0 * 64) = r * gin;
        *(f32x4*)(op + 2 * 64) = cvt4(q.a) * gout;
        *(f32x4*)(op + 3 * 64) = cvt4(q.kk) * gprev;
        *(f32x4*)(op + 4 * 64) = cvt4(q.bb) * gout;
        if (pt == 15) *(f32x4*)(GE + buf * 64 + c4) = gin;
        if (pw == rg) *(f32x4*)(VB + buf * 256 + pt * 16 + cl * 4) = v;
    };
    auto flush_y = [&](int ci, int buf) {
        const int tok = pw * 4 + (lane >> 4), row = lane & 15;
        const float* yb = YB + buf * (16 * 16 * 17) + (tok * 16 + row) * 17;
        float y0 = 0.f, y1 = 0.f, y2 = 0.f, y3 = 0.f;
#pragma unroll
        for (int j = 0; j < 16; j += 4) { y0 += yb[j]; y1 += yb[j + 1]; y2 += yb[j + 2]; y3 += yb[j + 3]; }
        MIX[(size_t)(pb * 2048 + ci * 16 + tok) * D + ph * 64 + rg * 16 + row] = (hf)((y0 + y1) + (y2 + y3));
    };

    WkvS S; S.lo = (f32x2){0.f, 0.f}; S.hi = (f32x2){0.f, 0.f};
    if (producer) { load_prompt(0, qB); store_prompt(0, 0, qB); load_prompt(1, qA); load_prompt(2, qB); }
    __syncthreads();
    auto consume = [&](int buf) {
        const float* op = OP + buf * (16 * OPS) + ks * 4;
        const float* vb = VB + buf * 256 + pw * 4 + rl;
        float* yb = YB + buf * (16 * 16 * 17) + (pw * 4 + rl) * 17 + ks;
        WkvOpsS ring[4];
        ring[0] = wkv_load_s(op, vb);
        ring[1] = wkv_load_s(op + OPS, vb + 16);
        ring[2] = wkv_load_s(op + 2 * OPS, vb + 32);
        f32x4 rprev = {0.f, 0.f, 0.f, 0.f};
#pragma unroll
        for (int t = 0; t < 16; ++t) {
            if (t + 3 < 16) ring[(t + 3) & 3] = wkv_load_s(op + (t + 3) * OPS, vb + (t + 3) * 16);
            __builtin_amdgcn_sched_barrier(0);
            const float e = wkv_step_part(S, ring[t & 3], rprev);
            if (t > 0) yb[(t - 1) * (16 * 17)] = e;
            rprev = ring[t & 3].r4;
            __builtin_amdgcn_sched_barrier(0);
        }
        {
            f32x2 q = S.lo * rprev.lo + S.hi * rprev.hi;
            yb[15 * (16 * 17)] = q.x + q.y;
            const f32x4 ge = *(const f32x4*)(GE + buf * 64 + ks * 4);
            S.lo = S.lo * ge.lo;
            S.hi = S.hi * ge.hi;
        }
    };
#pragma unroll 1
    for (int ci = 0; ci < NCHP; ci += 2) {
        if (producer) {
            store_prompt(ci + 1, 1, qA);
            if (ci + 3 < NCHP) load_prompt(ci + 3, qA);
            if (ci >= 1) flush_y(ci - 1, 1);
        } else consume(0);
        __syncthreads();
        if (producer) {
            if (ci + 2 < NCHP) store_prompt(ci + 2, 0, qB);
            if (ci + 4 < NCHP) load_prompt(ci + 4, qB);
            flush_y(ci, 0);
        } else consume(1);
        __syncthreads();
    }

    f32x4 St[4][4];
    if (producer) {
        flush_y(NCHP - 1, (NCHP - 1) & 1);
        const int id = blk * 4 + pw, bs = id >> 3, h = id & 7;
        const int col = h * 64 + lane;
        const float smur = mu[col], smuk = mu[512 + col], smuv = mu[1024 + col], ska = p.k_a[l * 512 + col];
        const int tk0 = NTOKP + bs * 4;
        const hf* up = U + (size_t)(NTOK + bs) * PIN + col;
        float rp = (float)up[0], kp = (float)up[512], vp = (float)up[1024];
#pragma unroll
        for (int i = 0; i < 4; ++i) {
            const int tk = tk0 + i, t = pw * 4 + i;
            const hf* ut = U + (size_t)tk * PIN + col;
            const float rc = (float)ut[0], kc = (float)ut[512], vc = (float)ut[1024];
            const float e = (float)EA[(size_t)tk * D + col], a = (float)EA[(size_t)tk * D + 512 + col];
            const float kk = (float)KKB[(size_t)tk * D + col], bb = (float)KKB[(size_t)tk * D + 512 + col];
            OP[(t * 5 + 0) * 64 + lane] = rc + (rp - rc) * smur;
            OP[(t * 5 + 1) * 64 + lane] = __expf(-e);
            OP[(t * 5 + 2) * 64 + lane] = a;
            OP[(t * 5 + 3) * 64 + lane] = kk;
            OP[(t * 5 + 4) * 64 + lane] = bb;
            VS[t * 64 + lane] = vc + (vp - vc) * smuv;
            rp = rc; kp = kc; vp = vc;
        }
    } else {
        *(f32x4*)(p.out + O_WKV_P + ((((size_t)l * 8 + pb) * 8 + ph) * 64 + rg * 16 + pw * 4 + rl) * 64 + ks * 4) = (f32x4){S.lo.x, S.lo.y, S.hi.x, S.hi.y};
#pragma unroll
        for (int q = 0; q < 4; ++q) {
            const int id = blk * 4 + q, bs = id >> 3, h = id & 7;
#pragma unroll
            for (int g = 0; g < 4; ++g) {
                const int row = pw * 16 + g * 4 + rl;
                St[q][g] = *(const f32x4*)(p.state_wkv + ((((size_t)l * 128 + bs) * 8 + h) * 64 + row) * 64 + ks * 4);
            }
        }
    }
    __syncthreads();
    if (!producer) {
#pragma unroll
        for (int q = 0; q < 4; ++q) {
            const int id = blk * 4 + q, bs = id >> 3, h = id & 7;
#pragma unroll
            for (int g = 0; g < 4; ++g) {
                const int row = pw * 16 + g * 4 + rl;
                WkvS Sq; Sq.lo = St[q][g].lo; Sq.hi = St[q][g].hi;
                float ykeep = 0.f;
#pragma unroll
                for (int t = 0; t < 4; ++t) {
                    float y;
                    wkv_step(Sq, OP + ((q * 4 + t) * 5) * 64 + ks * 4, VS[(q * 4 + t) * 64 + row], y);
                    ykeep = (ks == t) ? y : ykeep;
                }
                *(f32x4*)(p.out + O_WKV_S + ((((size_t)l * 128 + bs) * 8 + h) * 64 + row) * 64 + ks * 4) = (f32x4){Sq.lo.x, Sq.lo.y, Sq.hi.x, Sq.hi.y};
                if (ks < 4) MIX[(size_t)(NTOKP + bs * 4 + ks) * D + h * 64 + row] = (hf)ykeep;
            }
        }
    }
    __syncthreads();
}

__device__ __forceinline__ void phase5a(const Params& p, int l, hf* DST = nullptr) {
    const int tid = tid_(); const int lane = tid & 63, wave = tid >> 6;
    const hf* U = (const hf*)(p.ws + WS_U);
    const hf* EA = (const hf*)(p.ws + WS_EA);
    hf* MIX = (hf*)(p.ws + WS_MIX);
    hf* OUT = DST ? DST : MIX;
    const float* mu = p.mu + (size_t)l * PRW;
    const int ti = lane >> 4, c4 = (lane & 15) * 4;
    struct It { hf4 uc[4], up[4], a, y; };
    constexpr int NIT = (NTOK / 4) * 8;
    const int stride = gridDim.x * 8;
    auto load = [&](int it, It& q) {
        const int tk = (it >> 3) * 4 + ti, col = (it & 7) * 64 + c4;
        const int pr = prev_row(tk);
        const hf* ut = U + (size_t)tk * PIN + col;
        const hf* up = U + (size_t)(pr >= 0 ? pr : 0) * PIN + col;
#pragma unroll
        for (int c = 0; c < 4; ++c) { if (c == 1) continue; q.uc[c] = *(const hf4*)(ut + 512 * c); q.up[c] = *(const hf4*)(up + 512 * c); }
        q.a = *(const hf4*)(EA + (size_t)tk * D + 512 + col);
        q.y = *(const hf4*)(MIX + (size_t)tk * D + col);
    };
    auto cvt4 = [](hf4 x) { return (f32x4){(float)x.x, (float)x.y, (float)x.z, (float)x.w}; };
    auto compute = [&](int it, const It& q) {
        const int tk = (it >> 3) * 4 + ti, col = (it & 7) * 64 + c4;
        const float pm = prev_row(tk) >= 0 ? 1.f : 0.f;
        const f32x4 mr = *(const f32x4*)(mu + col), mk = *(const f32x4*)(mu + 512 + col), mv = *(const f32x4*)(mu + 1024 + col), mg = *(const f32x4*)(mu + 1536 + col);
        const f32x4 ka = *(const f32x4*)(p.k_a + l * 512 + col), rk = *(const f32x4*)(p.r_k + l * 512 + col);
        const f32x4 gg = *(const f32x4*)(p.gn_r_g + l * 512 + col), gb = *(const f32x4*)(p.gn_r_b + l * 512 + col);
        const f32x4 rc = cvt4(q.uc[0]), vc = cvt4(q.uc[2]), gc = cvt4(q.uc[3]);
        const f32x4 r = rc + (cvt4(q.up[0]) * pm - rc) * mr;
        const f32x4 v = vc + (cvt4(q.up[2]) * pm - vc) * mv, g = gc + (cvt4(q.up[3]) * pm - gc) * mg;
        const f32x4 km = cvt4(q.a);
        const f32x4 y = cvt4(q.y);
        const f32x4 y2 = y * y, bo = r * km * rk;
        float s1 = (y.x + y.y) + (y.z + y.w), s2 = (y2.x + y2.y) + (y2.z + y2.w), s3 = (bo.x + bo.y) + (bo.z + bo.w);
        s1 = row_allreduce16(s1); s2 = row_allreduce16(s2); s3 = row_allreduce16(s3);
        const float mean = s1 * (1.f / 64.f);
        const float var = fmaxf(s2 * (1.f / 64.f) - mean * mean, 0.f);
        const float rs = rsqrtf(var + 64e-5f);
        const f32x4 yn = (y - mean) * rs * gg + gb;
        const f32x4 t = yn + s3 * v;
        hf4 o = {(hf)(t.x * silu(g.x)), (hf)(t.y * silu(g.y)), (hf)(t.z * silu(g.z)), (hf)(t.w * silu(g.w))};
        const u32x2 uo = __builtin_bit_cast(u32x2, o);
        const unsigned n0 = (unsigned)__builtin_amdgcn_update_dpp(0, (int)uo.x, 0x101, 0xf, 0xf, false);
        const unsigned n1 = (unsigned)__builtin_amdgcn_update_dpp(0, (int)uo.y, 0x101, 0xf, 0xf, false);
        if ((lane & 1) == 0) st16_wt(OUT + (size_t)tk * D + col, (u32x4){uo.x, uo.y, n0, n1});
    };
    It qa, qb;
    int it = blockIdx.x * 8 + wave;
    if (it < NIT) load(it, qa);
    while (it < NIT) {
        const int nx = it + stride;
        if (nx < NIT) load(nx, qb);
        compute(it, qa);
        qa = qb;
        it = nx;
    }
}

__device__ __forceinline__ void phase6(const Params& p) {
    const int tid = tid_(); const int lane = tid & 63, wave = tid >> 6;
    const float* MOD = (const float*)(p.ws + WS_MOD);
    struct Row { f32x4 x[4]; hf4 m0[4], m1[4]; };
    const int stride = gridDim.x * 8;
    auto load = [&](int tk, Row& q) {
        const float* xr = x0_row(p, tk);
        const hf* mo = (const hf*)(p.out + O_Y + (size_t)tk * D);
#pragma unroll
        for (int j = 0; j < 4; ++j) {
            q.x[j] = *(const f32x4*)(xr + 256 * j + 4 * lane);
            q.m0[j] = *(const hf4*)(mo + 256 * j + 4 * lane);
            q.m1[j] = *(const hf4*)(mo + 1024 + 256 * j + 4 * lane);
        }
    };
    Row qa, qb;
    int tk = blockIdx.x * 8 + wave;
    if (tk < NTOK) load(tk, qa);
    while (tk < NTOK) {
        const int nx = tk + stride;
        if (nx < NTOK) load(nx, qb);
        const int sq = seq_of(tk);
        float* yr = p.out + O_Y + (size_t)tk * D;
        f32x4 m0[4], m1[4];
        float s0 = 0.f, s1 = 0.f;
#pragma unroll
        for (int j = 0; j < 4; ++j) {
            m0[j] = (f32x4){(float)qa.m0[j].x, (float)qa.m0[j].y, (float)qa.m0[j].z, (float)qa.m0[j].w};
            m1[j] = (f32x4){(float)qa.m1[j].x, (float)qa.m1[j].y, (float)qa.m1[j].z, (float)qa.m1[j].w};
            s0 += m0[j].x * m0[j].x + m0[j].y * m0[j].y + m0[j].z * m0[j].z + m0[j].w * m0[j].w;
            s1 += m1[j].x * m1[j].x + m1[j].y * m1[j].y + m1[j].z * m1[j].z + m1[j].w * m1[j].w;
        }
        const float r0 = rsqrtf(wave_sum_all(s0) * (1.f / D) + 1e-6f);
        const float r1 = rsqrtf(wave_sum_all(s1) * (1.f / D) + 1e-6f);
#pragma unroll
        for (int j = 0; j < 4; ++j) {
            f32x4 gp0 = *(const f32x4*)(p.g_post + 256 * j + 4 * lane);
            f32x4 gp1 = *(const f32x4*)(p.g_post + D + 256 * j + 4 * lane);
            f32x4 gt0 = *(const f32x4*)(MOD + (size_t)sq * 6144 + 2048 + 256 * j + 4 * lane);
            f32x4 gt1 = *(const f32x4*)(MOD + (size_t)sq * 6144 + 3072 + 2048 + 256 * j + 4 * lane);
            f32x4 y = qa.x[j] + gt0 * (m0[j] * r0 * gp0);
            y = y + gt1 * (m1[j] * r1 * gp1);
            *(f32x4*)(yr + 256 * j + 4 * lane) = y;
        }
        qa = qb;
        tk = nx;
    }
}

constexpr int NPHASES = 14;
__device__ __forceinline__ void run_phase(const Params& p, int ph, unsigned char* smem) {
    if (ph == 0) { phase0(p, smem); return; }
    if (ph == 13) { phase6(p); return; }
    const int l = (ph - 1) / 6, s = (ph - 1) % 6;
    switch (s) {
        case 0: phase1(p, l); break;
        case 1: phase2(p, l, smem); break;
        case 2: phase3(p, l, smem); break;
        case 3: phase4(p, l, smem); break;
        case 4: phase5a(p, l); break;
        default: phase5b(p, l, smem); break;
    }
}

#define GSYNC() xcd_barrier(xb)
__global__ void __launch_bounds__(NTHR) fwd_mega(Params p) {
    extern __shared__ __attribute__((aligned(16))) unsigned char smem[];
    volatile LAS unsigned* st = (volatile LAS unsigned*)(smem + LDS_BYTES - 16);
    if (threadIdx.x == 0) { st[0] = 0u; st[1] = 0u; }
    __syncthreads();
    XcdBarrier xb = xcd_barrier_post((unsigned*)(p.ws + WS_BAR), st);
    if (p.ws == nullptr) cg::this_grid().sync();
    phase0(p, smem); GSYNC();
    phase1(p, 0); GSYNC();
    phase2(p, 0, smem); GSYNC();
    phase3(p, 0, smem); GSYNC();
    phase4(p, 0, smem); GSYNC();
    phase5a(p, 0); GSYNC();
    phase5b(p, 0, smem); GSYNC();
    phase1(p, 1); GSYNC();
    phase2(p, 1, smem); GSYNC();
    phase3(p, 1, smem); GSYNC();
    phase4(p, 1, smem); GSYNC();
    phase5a(p, 1); GSYNC();
    phase5b(p, 1, smem); GSYNC();
    phase6(p);
}
__global__ void __launch_bounds__(NTHR) fwd_phase(Params p, int ph) {
    extern __shared__ __attribute__((aligned(16))) unsigned char smem[];
    run_phase(p, ph, smem);
}

extern "C" void kernel_launch(void* const* d_in, const int* in_sizes, int n_in, void* d_out, int out_size, void* d_ws, size_t ws_size,
                              hipStream_t stream) {
    static int ok = 0;
    if (ok == 0) {
        ok = 1;
        if (n_in != 27 || (size_t)out_size != O_END || ws_size < WS_END) {
            fprintf(stderr, "kernel_launch: unexpected sizes n_in %d out %d ws %zu (need %zu)\n", n_in, out_size, ws_size, (size_t)WS_END);
            ok = -1;
        }
        int dev = 0, cus = 0, per_cu = 0;
        (void)hipGetDevice(&dev);
        (void)hipDeviceGetAttribute(&cus, hipDeviceAttributeMultiprocessorCount, dev);
        (void)hipFuncSetAttribute((const void*)fwd_mega, hipFuncAttributeMaxDynamicSharedMemorySize, LDS_BYTES);
        (void)hipFuncSetAttribute((const void*)fwd_phase, hipFuncAttributeMaxDynamicSharedMemorySize, LDS_BYTES);
        (void)hipOccupancyMaxActiveBlocksPerMultiprocessor(&per_cu, (const void*)fwd_mega, NTHR, LDS_BYTES);
        if (cus * per_cu < GRID) {
            fprintf(stderr, "kernel_launch: resident capacity %d x %d < grid %d\n", cus, per_cu, GRID);
            ok = -1;
        }
    }
    if (ok < 0) return;
    Params p{};
    const float** pp = (const float**)&p;
    for (int i = 0; i < 27; ++i) pp[i] = (const float*)d_in[i];
    p.out = (float*)d_out;
    p.ws = (unsigned char*)d_ws;
#if MULTI_LAUNCH
    for (int ph = 0; ph < NPHASES; ++ph) hipLaunchKernelGGL(fwd_phase, dim3(GRID), dim3(NTHR), LDS_BYTES, stream, p, ph);
#else
    (void)hipMemsetAsync((unsigned char*)d_ws + WS_BAR, 0, 16384, stream);
    void* args[] = {&p};
    hipError_t e = hipLaunchCooperativeKernel((const void*)fwd_mega, dim3(GRID), dim3(NTHR), args, LDS_BYTES, stream);
    if (e != hipSuccess) fprintf(stderr, "cooperative launch failed: %s\n", hipGetErrorString(e));
#endif
}
```

```cpp
#include <hip/hip_runtime.h>
#include <hip/hip_cooperative_groups.h>
#include <cstdio>
namespace cg = cooperative_groups;

#ifndef MULTI_LAUNCH
#define MULTI_LAUNCH 0
#endif

typedef _Float16 hf;
typedef hf hf8 __attribute__((ext_vector_type(8)));
typedef hf hf4 __attribute__((ext_vector_type(4)));
typedef hf hf2 __attribute__((ext_vector_type(2)));
typedef float f32x4 __attribute__((ext_vector_type(4)));

constexpr int D = 1024;
constexpr int NTOKP = 16384, NTOKS = 512, NTOK = 16896, NSEQ = 136;
constexpr int PIN = 3712, PRW = 2176;
constexpr int MROWS = NTOK + 128;
constexpr int MPAD = 17152;
constexpr int NTHR = 512;
constexpr int GRID = 256;

constexpr int PINP = 3840;
constexpr size_t WS_WTIN = 0;
constexpr size_t WS_WTOUT = WS_WTIN + (size_t)2 * PINP * D * 2;
constexpr size_t WS_WUPT = WS_WTOUT + (size_t)2 * D * D * 2;
constexpr size_t WS_AUPT = WS_WUPT + (size_t)2 * 512 * 64 * 2;
constexpr size_t WS_MOD = WS_AUPT + (size_t)2 * 512 * 64 * 2;
constexpr size_t WS_H = WS_MOD + (size_t)NSEQ * 6144 * 4;
constexpr size_t WS_U = WS_H + (size_t)MPAD * D * 2;
constexpr size_t WS_EA = WS_U + (size_t)MROWS * PIN * 2;
constexpr size_t WS_MIX = WS_EA + (size_t)NTOK * D * 2;
constexpr size_t WS_BAR = WS_MIX + (size_t)NTOK * D * 2;
constexpr size_t WS_END = WS_BAR + 16384;

constexpr size_t O_Y = 0;
constexpr size_t O_SHIFT_P = (size_t)NTOK * D;
constexpr size_t O_WKV_P = O_SHIFT_P + 2 * 8 * 1024;
constexpr size_t O_CONV_P = O_WKV_P + (size_t)2 * 8 * 8 * 4096;
constexpr size_t O_SHIFT_S = O_CONV_P + (size_t)2 * 8 * 30 * 512;
constexpr size_t O_WKV_S = O_SHIFT_S + (size_t)2 * 128 * 1024;
constexpr size_t O_CONV_S = O_WKV_S + (size_t)2 * 128 * 8 * 4096;
constexpr size_t O_END = O_CONV_S + (size_t)2 * 128 * 30 * 512;

constexpr int LDS_BYTES = 132 * 1024;

struct Params {
    const float *x_prompt, *x_sample, *c_prompt, *c_sample, *state_shift, *state_wkv, *state_conv;
    const float *w_ada, *b_ada, *g_pre, *g_post, *w_in, *mu, *w0, *w_up, *a0, *a_up, *k_k, *k_a, *r_k;
    const float *gn_r_g, *gn_r_b, *w_dw, *b_dw, *gn_c_g, *gn_c_b, *w_out;
    float* out;
    unsigned char* ws;
};

typedef unsigned u32x2 __attribute__((ext_vector_type(2)));
typedef unsigned u32x4 __attribute__((ext_vector_type(4)));
__device__ __forceinline__ void st16_wt(void* p, u32x4 v) { asm volatile("global_store_dwordx4 %0, %1, off sc1\n\ts_nop 1" :: "v"(p), "v"(v) : "memory"); }
__device__ __forceinline__ int tid_() { int t = threadIdx.x; asm volatile("" : "+v"(t)); return t; }
template <int CTRL>
__device__ __forceinline__ float dpp_mov(float v) {
    return __builtin_bit_cast(float, __builtin_amdgcn_update_dpp(0, __builtin_bit_cast(int, v), CTRL, 0xf, 0xf, false));
}
__device__ __forceinline__ float row_allreduce16(float v) {
    v += dpp_mov<0x128>(v);
    v += dpp_mov<0x124>(v);
    v += dpp_mov<0x122>(v);
    v += dpp_mov<0x121>(v);
    return v;
}
__device__ __forceinline__ float wave_sum(float v) {
    v = row_allreduce16(v);
    v += __shfl_xor(v, 16);
    v += __shfl_xor(v, 32);
    return v;
}
__device__ __forceinline__ float wave_sum_all(float v) {
    v = row_allreduce16(v);
    v += __builtin_bit_cast(float, __builtin_amdgcn_update_dpp(0, __builtin_bit_cast(int, v), 0x142, 0xa, 0xf, false));
    v += __builtin_bit_cast(float, __builtin_amdgcn_update_dpp(0, __builtin_bit_cast(int, v), 0x143, 0xc, 0xf, false));
    return __builtin_bit_cast(float, __builtin_amdgcn_readlane(__builtin_bit_cast(int, v), 63));
}
__device__ __forceinline__ float sigm(float x) { return __builtin_amdgcn_rcpf(1.f + __expf(-x)); }
__device__ __forceinline__ float silu(float x) { return x * __builtin_amdgcn_rcpf(1.f + __expf(-x)); }
__device__ __forceinline__ float silu2(float a, float b) { return (a * b) * __builtin_amdgcn_rcpf((1.f + __expf(-a)) * (1.f + __expf(-b))); }
__device__ __forceinline__ float tanh_fast(float x) { float t = __expf(2.f * x); return 1.f - 2.f * __builtin_amdgcn_rcpf(t + 1.f); }

__device__ __forceinline__ int seq_of(int tk) { return tk < NTOKP ? (tk >> 11) : 8 + ((tk - NTOKP) >> 2); }
__device__ __forceinline__ bool is_last_tok(int tk) { return tk < NTOKP ? ((tk & 2047) == 2047) : (((tk - NTOKP) & 3) == 3); }
__device__ __forceinline__ int prev_row(int tk) {
    if (tk < NTOKP) return (tk & 2047) ? tk - 1 : -1;
    int s = tk - NTOKP;
    return (s & 3) ? tk - 1 : NTOK + (s >> 2);
}
__device__ __forceinline__ const float* x0_row(const Params& p, int tk) {
    return tk < NTOKP ? p.x_prompt + (size_t)tk * D : p.x_sample + (size_t)(tk - NTOKP) * D;
}


#define XB_TMO      128
#define XB_XCNT(j)  (256  + 64 * (j))
#define XB_XSUB(j)  (1280 + 64 * (j))
#define XB_XGEN(j)  (2304 + 64 * (j))
#define XB_TOP      3328
#define XB_TOPGEN   3392
#define XCD_BAR_WORDS 3456
#define XB_SPIN_CAP (1u << 22)
#define LAS __attribute__((address_space(3)))
__device__ __forceinline__ unsigned xb_ld(unsigned* p)              { return __hip_atomic_load(p, __ATOMIC_RELAXED, __HIP_MEMORY_SCOPE_AGENT); }
__device__ __forceinline__ unsigned xb_add(unsigned* p, unsigned v) { return __hip_atomic_fetch_add(p, v, __ATOMIC_RELAXED, __HIP_MEMORY_SCOPE_AGENT); }
__device__ __forceinline__ unsigned xb_xcc_id() { return (unsigned)__builtin_amdgcn_s_getreg((3 << 11) | 20) & 0xFu; }
#define XB_SPIN(cond, bar) do { unsigned _sp = 0; while (cond) { __builtin_amdgcn_s_sleep(1); \
    if ((++_sp & 255u) == 0u) { if (xb_ld(&(bar)[XB_TMO])) break; if (_sp > XB_SPIN_CAP) { atomicAdd(&(bar)[XB_TMO], 1u); break; } } } } while (0)
struct XcdBarrier { unsigned* bar; unsigned x; volatile LAS unsigned* st; };
__device__ __forceinline__ XcdBarrier xcd_barrier_post(unsigned* bar, volatile LAS unsigned* st) {
    XcdBarrier b; b.bar = bar; b.x = xb_xcc_id(); b.st = st;
    if (threadIdx.x == 0) (void)xb_add(&bar[XB_XCNT(b.x)], 1u);
    return b;
}
__device__ __forceinline__ void xcd_barrier_complete(unsigned* bar, unsigned x, unsigned& nloc, unsigned& nx) {
    const unsigned G = gridDim.x * gridDim.y * gridDim.z;
    unsigned sum, cnt, mine, sp = 0u;
    for (;;) {
        sum = 0u; cnt = 0u; mine = 0u;
#pragma unroll
        for (unsigned j = 0; j < 16; ++j) { const unsigned c = xb_ld(&bar[XB_XCNT(j)]); sum += c; cnt += (c > 0u) ? 1u : 0u; mine = (j == x) ? c : mine; }
        if (sum == G) break;
        __builtin_amdgcn_s_sleep(1);
        if ((++sp & 255u) == 0u) { if (xb_ld(&bar[XB_TMO])) break; if (sp > XB_SPIN_CAP) { atomicAdd(&bar[XB_TMO], 1u); break; } }
    }
    nloc = mine > 0u ? mine : 1u; nx = cnt > 0u ? cnt : 1u;
}
__device__ __forceinline__ void xcd_barrier(const XcdBarrier& b) {
    asm volatile("s_waitcnt vmcnt(0)" ::: "memory");
    __syncthreads();
    if (threadIdx.x == 0) {
        unsigned* bar = b.bar;
        __builtin_amdgcn_s_waitcnt(0);
        unsigned nloc = b.st[0], nx = b.st[1];
        if (nloc == 0u) { xcd_barrier_complete(bar, b.x, nloc, nx); b.st[0] = nloc; b.st[1] = nx; }
        const unsigned old = xb_add(&bar[XB_XSUB(b.x)], 1u);
        const unsigned gen = old / nloc;
        if (old + 1u == (gen + 1u) * nloc) {
            __builtin_amdgcn_fence(__ATOMIC_RELEASE, "agent");
            asm volatile("s_waitcnt vmcnt(0)" ::: "memory");
            const unsigned og = xb_add(&bar[XB_TOP], 1u);
            const unsigned tg = og / nx;
            if (og + 1u == (tg + 1u) * nx) xb_add(&bar[XB_TOPGEN], 1u);
            else XB_SPIN(xb_ld(&bar[XB_TOPGEN]) == tg, bar);
            __builtin_amdgcn_fence(__ATOMIC_ACQUIRE, "agent");
            xb_add(&bar[XB_XGEN(b.x)], 1u);
            asm volatile("s_waitcnt vmcnt(0)" ::: "memory");
        } else {
            XB_SPIN(xb_ld(&bar[XB_XGEN(b.x)]) == gen, bar);
            __builtin_amdgcn_fence(__ATOMIC_ACQUIRE, "agent");
            asm volatile("s_waitcnt vmcnt(0)" ::: "memory");
        }
    }
    __syncthreads();
}

__device__ __forceinline__ void p0_transpose(const float* __restrict__ W, int K, int N, hf* __restrict__ WT, int item, float* lds) {
    const int nb = N / 64;
    const int kb = item / nb, nbk = item % nb, k0 = kb * 64, n0 = nbk * 64;
    const int tid = tid_();
#pragma unroll
    for (int i = 0; i < 8; ++i) {
        int kk = (tid >> 6) + 8 * i, c = tid & 63;
        lds[kk * 65 + c] = W[(size_t)(k0 + kk) * N + n0 + c];
    }
    __syncthreads();
    const int n = tid >> 3, kc = (tid & 7) * 8;
    hf8 o;
#pragma unroll
    for (int j = 0; j < 8; ++j) o[j] = (hf)lds[(kc + j) * 65 + n];
    *(hf8*)(WT + (size_t)(n0 + n) * K + k0 + kc) = o;
    __syncthreads();
}

__device__ __forceinline__ void p0_adaln(const Params& p, int item, unsigned char* smem) {
    hf* SC = (hf*)smem;
    hf* Wt = SC + 144 * 72;
    float* MOD = (float*)(p.ws + WS_MOD);
    const int gc0 = item * 32;
    const int l = gc0 / 3072, lc0 = gc0 % 3072;
    const float* W = p.w_ada + (size_t)l * 1024 * 3072;
    const int tid = tid_(), lane = tid & 63, wave = tid >> 6;
    const int nt = wave & 1, mg = wave >> 1;
    const int mt0 = (mg == 0) ? 0 : (2 * mg + 1);
    const int nmt = (mg == 0) ? 3 : 2;
    f32x4 acc[3];
#pragma unroll
    for (int i = 0; i < 3; ++i) acc[i] = (f32x4){0.f, 0.f, 0.f, 0.f};
    float cv[17], wv[4];
    auto gload = [&](int kt) {
        const int k0 = kt * 64;
#pragma unroll
        for (int i = 0; i < 17; ++i) {
            const int e = tid + 512 * i, row = e >> 6, k = e & 63;
            const float* cr = row < 8 ? p.c_prompt + row * 1024 : p.c_sample + (row - 8) * 1024;
            cv[i] = cr[k0 + k];
        }
#pragma unroll
        for (int i = 0; i < 4; ++i) {
            const int e = tid + 512 * i, kk = e >> 5, n = e & 31;
            wv[i] = W[(size_t)(k0 + kk) * 3072 + lc0 + n];
        }
    };
    gload(0);
    { int row = 136 + (tid >> 6), k = tid & 63; SC[row * 72 + k] = (hf)0.f; }
    for (int kt = 0; kt < 16; ++kt) {
#pragma unroll
        for (int i = 0; i < 17; ++i) {
            const int e = tid + 512 * i, row = e >> 6, k = e & 63;
            SC[row * 72 + k] = (hf)silu(cv[i]);
        }
#pragma unroll
        for (int i = 0; i < 4; ++i) {
            const int e = tid + 512 * i, kk = e >> 5, n = e & 31;
            Wt[n * 72 + kk] = (hf)wv[i];
        }
        __syncthreads();
        if (kt + 1 < 16) gload(kt + 1);
#pragma unroll
        for (int ks = 0; ks < 2; ++ks) {
            hf8 bfrag = *(const hf8*)(Wt + (nt * 16 + (lane & 15)) * 72 + ks * 32 + (lane >> 4) * 8);
#pragma unroll
            for (int i = 0; i < 3; ++i) {
                if (i < nmt) {
                    hf8 afrag = *(const hf8*)(SC + ((mt0 + i) * 16 + (lane & 15)) * 72 + ks * 32 + (lane >> 4) * 8);
                    acc[i] = __builtin_amdgcn_mfma_f32_16x16x32_f16(bfrag, afrag, acc[i], 0, 0, 0);
                }
            }
        }
        __syncthreads();
    }
#pragma unroll
    for (int i = 0; i < 3; ++i) {
        if (i < nmt) {
            int row = (mt0 + i) * 16 + (lane & 15);
            if (row < NSEQ) {
#pragma unroll
                for (int j = 0; j < 4; ++j) {
                    int gc = gc0 + nt * 16 + (lane >> 4) * 4 + j;
                    MOD[(size_t)row * 6144 + gc] = acc[i][j] + p.b_ada[gc];
                }
            }
        }
    }
}

__device__ __forceinline__ void phase0(const Params& p, unsigned char* smem) {
    constexpr int I_ADA = 192;
    constexpr int I_WIN = 16 * 58;
    constexpr int I_WOUT = 16 * 16;
    constexpr int I_LORA = 8;
    constexpr int NITEMS = I_ADA + 2 * (I_WIN + I_WOUT + 2 * I_LORA);
    constexpr int NTR = NITEMS - I_ADA;
    constexpr int EXTRA = 6;
    auto transpose_item = [&](int r) {
        const int l = r / (I_WIN + I_WOUT + 2 * I_LORA);
        r = r % (I_WIN + I_WOUT + 2 * I_LORA);
        float* lds = (float*)smem;
        if (r < I_WIN) { p0_transpose(p.w_in + (size_t)l * D * PIN, D, PIN, (hf*)(p.ws + WS_WTIN) + (size_t)l * PINP * D, r, lds); return; }
        r -= I_WIN;
        if (r < I_WOUT) { p0_transpose(p.w_out + (size_t)l * D * D, D, D, (hf*)(p.ws + WS_WTOUT) + (size_t)l * D * D, r, lds); return; }
        r -= I_WOUT;
        if (r < I_LORA) { p0_transpose(p.w_up + (size_t)l * 64 * 512, 64, 512, (hf*)(p.ws + WS_WUPT) + (size_t)l * 512 * 64, r, lds); return; }
        r -= I_LORA;
        p0_transpose(p.a_up + (size_t)l * 64 * 512, 64, 512, (hf*)(p.ws + WS_AUPT) + (size_t)l * 512 * 64, r, lds);
    };
    const int nb = gridDim.x, b = blockIdx.x;
    const int nfree = nb > I_ADA ? nb - I_ADA : 0;
    const int nextra = min(nfree * EXTRA, NTR);
    for (int it = b; it < I_ADA; it += nb) p0_adaln(p, it, smem);
    if (b >= I_ADA) for (int i = 0; i < EXTRA; ++i) { const int r = (b - I_ADA) + nfree * i; if (r < nextra) transpose_item(r); }
    for (int r = nextra + b; r < NTR; r += nb) transpose_item(r);
}

__device__ __forceinline__ void phase1(const Params& p, int l) {
    const int tid = tid_(); const int lane = tid & 63, wave = tid >> 6;
    hf* H = (hf*)(p.ws + WS_H);
    const float* MOD = (const float*)(p.ws + WS_MOD);
    auto coff = [&](int q) { return 512 * (q >> 1) + 8 * lane + 4 * (q & 1); };
    const int nfull = (NTOKP / ((int)gridDim.x * 8)) * ((int)gridDim.x * 8);
    const int nrounds = nfull / ((int)gridDim.x * 8);
    for (int it = 0; it <= nrounds; ++it) {
        int tk;
        if (it < nrounds) tk = blockIdx.x * 8 + wave + it * (int)gridDim.x * 8;
        else {
            const int e = wave * (int)gridDim.x + blockIdx.x;
            if (e >= MROWS - nfull) break;
            tk = nfull + e;
        }
        if (tk >= NTOK) {
            const int bs = tk - NTOK;
            const float* s = p.state_shift + ((size_t)l * 128 + bs) * D;
#pragma unroll
            for (int j = 0; j < 2; ++j) {
                const f32x4 v0 = *(const f32x4*)(s + coff(2 * j)), v1 = *(const f32x4*)(s + coff(2 * j + 1));
                const hf8 o = {(hf)v0.x, (hf)v0.y, (hf)v0.z, (hf)v0.w, (hf)v1.x, (hf)v1.y, (hf)v1.z, (hf)v1.w};
                st16_wt(H + (size_t)tk * D + coff(2 * j), __builtin_bit_cast(u32x4, o));
            }
            continue;
        }
        const int sq = seq_of(tk);
        const float* xr = x0_row(p, tk);
        f32x4 x[4];
#pragma unroll
        for (int q = 0; q < 4; ++q) x[q] = *(const f32x4*)(xr + coff(q));
        if (l == 1) {
            const hf* mo = (const hf*)(p.out + O_Y + (size_t)tk * D);
            f32x4 m[4];
            float ss = 0.f;
#pragma unroll
            for (int q = 0; q < 4; ++q) {
                hf4 t = *(const hf4*)(mo + coff(q));
                m[q] = (f32x4){(float)t.x, (float)t.y, (float)t.z, (float)t.w};
                ss += m[q].x * m[q].x + m[q].y * m[q].y + m[q].z * m[q].z + m[q].w * m[q].w;
            }
            const float rs = rsqrtf(wave_sum_all(ss) * (1.f / D) + 1e-6f);
#pragma unroll
            for (int q = 0; q < 4; ++q) {
                f32x4 gp = *(const f32x4*)(p.g_post + coff(q));
                f32x4 gt = *(const f32x4*)(MOD + (size_t)sq * 6144 + 2048 + coff(q));
                x[q] = x[q] + gt * (m[q] * rs * gp);
            }
        }
        float ss = 0.f;
#pragma unroll
        for (int q = 0; q < 4; ++q) ss += x[q].x * x[q].x + x[q].y * x[q].y + x[q].z * x[q].z + x[q].w * x[q].w;
        const float rs = rsqrtf(wave_sum_all(ss) * (1.f / D) + 1e-6f);
        const bool last = is_last_tok(tk);
        float* so = nullptr;
        if (last) so = (sq < 8) ? p.out + O_SHIFT_P + ((size_t)l * 8 + sq) * D : p.out + O_SHIFT_S + ((size_t)l * 128 + (sq - 8)) * D;
        f32x4 h[4];
#pragma unroll
        for (int q = 0; q < 4; ++q) {
            f32x4 g = *(const f32x4*)(p.g_pre + (size_t)l * D + coff(q));
            f32x4 sh = *(const f32x4*)(MOD + (size_t)sq * 6144 + l * 3072 + coff(q));
            f32x4 sc = *(const f32x4*)(MOD + (size_t)sq * 6144 + l * 3072 + 1024 + coff(q));
            h[q] = (x[q] * rs * g) * (1.f + sc) + sh;
            if (last) *(f32x4*)(so + coff(q)) = h[q];
        }
#pragma unroll
        for (int j = 0; j < 2; ++j) {
            const f32x4 v0 = h[2 * j], v1 = h[2 * j + 1];
            const hf8 o = {(hf)v0.x, (hf)v0.y, (hf)v0.z, (hf)v0.w, (hf)v1.x, (hf)v1.y, (hf)v1.z, (hf)v1.w};
            st16_wt(H + (size_t)tk * D + coff(2 * j), __builtin_bit_cast(u32x4, o));
        }
    }
}

constexpr int G_BM = 256, G_BN = 128, G_BK = 64, G_LD = 72;
constexpr int G_ASZ = G_BM * G_LD, G_BSZ = G_BN * G_LD;
template <int EPI>
__device__ __forceinline__ void gemm_tile(const hf* __restrict__ A, const hf* __restrict__ Bt, hf* __restrict__ C, int m0, int n0, int mlimit, int ldc, unsigned char* smem) {
    hf* As = (hf*)smem;
    hf* Bs = As + 2 * G_ASZ;
    const int tid = tid_(), lane = tid & 63, wave = tid >> 6;
    const int wm = wave >> 1, wn = wave & 1;
    const int fr = lane & 15, fq = lane >> 4;
    f32x4 acc[4][4];
#pragma unroll
    for (int i = 0; i < 4; ++i)
#pragma unroll
        for (int j = 0; j < 4; ++j) acc[i][j] = (f32x4){0.f, 0.f, 0.f, 0.f};
    hf8 ra[4], rb[2];
    const int lrow = tid >> 3, lkc = (tid & 7) * 8;
    auto gload = [&](int kt) {
#pragma unroll
        for (int i = 0; i < 4; ++i) ra[i] = *(const hf8*)(A + (size_t)(m0 + lrow + 64 * i) * D + kt * G_BK + lkc);
#pragma unroll
        for (int i = 0; i < 2; ++i) rb[i] = *(const hf8*)(Bt + (size_t)(n0 + lrow + 64 * i) * D + kt * G_BK + lkc);
    };
    auto lstore = [&](int buf) {
#pragma unroll
        for (int i = 0; i < 4; ++i) *(hf8*)(As + buf * G_ASZ + (lrow + 64 * i) * G_LD + lkc) = ra[i];
#pragma unroll
        for (int i = 0; i < 2; ++i) *(hf8*)(Bs + buf * G_BSZ + (lrow + 64 * i) * G_LD + lkc) = rb[i];
    };
    gload(0);
    lstore(0);
    __syncthreads();
    constexpr int NKT = D / G_BK;
    for (int kt = 0; kt < NKT; ++kt) {
        const int buf = kt & 1;
        if (kt + 1 < NKT) gload(kt + 1);
        const hf* as = As + buf * G_ASZ + (wm * 64 + fr) * G_LD + fq * 8;
        const hf* bs = Bs + buf * G_BSZ + (wn * 64 + fr) * G_LD + fq * 8;
#pragma unroll
        for (int ks = 0; ks < 2; ++ks) {
            hf8 af[4], bf[4];
#pragma unroll
            for (int i = 0; i < 4; ++i) af[i] = *(const hf8*)(as + i * 16 * G_LD + ks * 32);
#pragma unroll
            for (int i = 0; i < 4; ++i) bf[i] = *(const hf8*)(bs + i * 16 * G_LD + ks * 32);
#pragma unroll
            for (int i = 0; i < 4; ++i)
#pragma unroll
                for (int j = 0; j < 4; ++j)
                    acc[i][j] = __builtin_amdgcn_mfma_f32_16x16x32_f16(bf[j], af[i], acc[i][j], 0, 0, 0);
        }
        if (kt + 1 < NKT) lstore(buf ^ 1);
        __syncthreads();
    }
#pragma unroll
    for (int i = 0; i < 4; ++i) {
        const int row = m0 + wm * 64 + i * 16 + fr;
        if (row < mlimit) {
#pragma unroll
            for (int j = 0; j < 4; ++j) {
                const int col = n0 + wn * 64 + j * 16 + fq * 4;
                hf4 o = {(hf)acc[i][j][0], (hf)acc[i][j][1], (hf)acc[i][j][2], (hf)acc[i][j][3]};
                *(hf4*)(C + (size_t)row * ldc + col) = o;
            }
        }
    }
}

constexpr int Q_BM = 256, Q_BK = 64, Q_HALF = 128, Q_NXCD = 8, Q_WGM = 8, Q_HT = Q_HALF * Q_BK;
__device__ __forceinline__ int q_lds_byte(int r, int c) {
    int st = (r >> 4) * 2 + (c >> 5), rr = r & 15, cc = c & 31, ob = rr * 64 + cc * 2;
    return st * 1024 + (ob ^ (((ob >> 9) & 1) << 5));
}
__device__ __forceinline__ void q_stage_rc(int b, int& R, int& C) {
    int st = b / 1024, sb = b % 1024, swz = sb ^ (((sb >> 9) & 1) << 5);
    R = (st >> 1) * 16 + swz / 64; C = (st & 1) * 32 + (swz % 64) / 2;
}
__device__ __forceinline__ void q_tile_of(int wgid, int nM, int nN, int& pm, int& pn) {
    const int nwg = nM * nN;
    { const int q = nwg / Q_NXCD, r = nwg % Q_NXCD, xcd = wgid % Q_NXCD, off = wgid / Q_NXCD; wgid = (xcd < r ? xcd * (q + 1) : r * (q + 1) + (xcd - r) * q) + off; }
    const int nig = Q_WGM * nN, gid = wgid / nig, fm = gid * Q_WGM, gsz = min(nM - fm, Q_WGM);
    pm = fm + ((wgid % nig) % gsz); pn = (wgid % nig) / gsz;
}
__device__ __forceinline__ void gemm256(const hf* __restrict__ A, const hf* __restrict__ Bt, hf* __restrict__ C, int brow, int bcol, int mlimit, int nlimit, int ldc, unsigned char* smem) {
    constexpr int K = D;
    hf* shm = (hf*)smem;
    const int qtid = tid_();
#define SA(b,h) (shm+((b)*2+(h))*Q_HT)
#define SB(b,h) (shm+(4+(b)*2+(h))*Q_HT)
#define STAGE(P,BASE,br,kt) do{const char* _gb=(const char*)((BASE)+(long)(br)*K+(long)(kt)*Q_BK); \
    __builtin_amdgcn_global_load_lds((const unsigned*)(_gb+so0),(unsigned*)((char*)(P)+qtid*16),16,0,0); \
    __builtin_amdgcn_global_load_lds((const unsigned*)(_gb+so1),(unsigned*)((char*)(P)+qtid*16+8192),16,0,0);}while(0)
#define LDA(dst,b,h) _Pragma("unroll") for(int m=0;m<4;++m) _Pragma("unroll") for(int k=0;k<2;++k) \
    dst[m][k]=*reinterpret_cast<const hf8*>((char*)SA(b,h)+q_lds_byte(wr*64+m*16+fr,k*32+fq*8))
#define LDB(dst,b,h) _Pragma("unroll") for(int n=0;n<2;++n) _Pragma("unroll") for(int k=0;k<2;++k) \
    dst[n][k]=*reinterpret_cast<const hf8*>((char*)SB(b,h)+q_lds_byte(wc*32+n*16+fr,k*32+fq*8))
#define MMA(ai,bj,At,Bt_) do{__builtin_amdgcn_s_setprio(1); \
    _Pragma("unroll") for(int m=0;m<4;++m) _Pragma("unroll") for(int n=0;n<2;++n) _Pragma("unroll") for(int k=0;k<2;++k) \
      acc[ai][bj][m][n]=__builtin_amdgcn_mfma_f32_16x16x32_f16(Bt_[n][k],At[m][k],acc[ai][bj][m][n],0,0,0); \
    __builtin_amdgcn_s_setprio(0);}while(0)
#define WAIT_V(n) asm volatile("s_waitcnt vmcnt(" #n ")":::"memory")
#define WAIT_L(n) asm volatile("s_waitcnt lgkmcnt(" #n ")":::"memory")
#define BAR __builtin_amdgcn_s_barrier()
#define SCHED __builtin_amdgcn_sched_barrier(0)
    const int wid = qtid >> 6, lane = qtid & 63, wr = wid >> 2, wc = wid & 3, fr = lane & 15, fq = lane >> 4;
    unsigned so0, so1;
    { int r_, c_; q_stage_rc(qtid * 16, r_, c_); so0 = (unsigned)(r_ * K + c_) * 2u; q_stage_rc(qtid * 16 + 8192, r_, c_); so1 = (unsigned)(r_ * K + c_) * 2u; }
    f32x4 acc[2][2][4][2] = {};
    hf8 At[4][2], B0[2][2], B1[2][2];
    constexpr int nt = K / Q_BK;
    STAGE(SB(0,0),Bt,bcol,0); STAGE(SA(0,0),A,brow,0);
    STAGE(SB(0,1),Bt,bcol+Q_HALF,0); STAGE(SA(0,1),A,brow+Q_HALF,0);
    if(wr==1)BAR;
    WAIT_V(4); BAR;
    STAGE(SB(1,0),Bt,bcol,1); STAGE(SA(1,0),A,brow,1); STAGE(SB(1,1),Bt,bcol+Q_HALF,1);
    WAIT_V(6); BAR;
    for(int t=0;t<nt-2;t+=2){
        LDB(B0,0,0); SCHED; LDA(At,0,0); STAGE(SA(1,1),A,brow+Q_HALF,t+1);
        WAIT_L(8); BAR; WAIT_L(0); MMA(0,0,At,B0); BAR; SCHED;
        LDB(B1,0,1); STAGE(SB(0,0),Bt,bcol,t+2);
        BAR; WAIT_L(0); MMA(0,1,At,B1); BAR;
        LDA(At,0,1); STAGE(SA(0,0),A,brow,t+2);
        BAR; WAIT_L(0); MMA(1,0,At,B0); BAR; SCHED;
        STAGE(SB(0,1),Bt,bcol+Q_HALF,t+2);
        WAIT_V(6); BAR; MMA(1,1,At,B1); BAR;
        LDB(B0,1,0); SCHED; LDA(At,1,0); STAGE(SA(0,1),A,brow+Q_HALF,t+2);
        WAIT_L(8); BAR; WAIT_L(0); MMA(0,0,At,B0); BAR; SCHED;
        LDB(B1,1,1); STAGE(SB(1,0),Bt,bcol,t+3);
        BAR; WAIT_L(0); MMA(0,1,At,B1); BAR;
        LDA(At,1,1); STAGE(SA(1,0),A,brow,t+3);
        BAR; WAIT_L(0); MMA(1,0,At,B0); BAR; SCHED;
        STAGE(SB(1,1),Bt,bcol+Q_HALF,t+3);
        WAIT_V(6); BAR; MMA(1,1,At,B1); BAR;
    }
    { LDB(B0,0,0); LDA(At,0,0); STAGE(SA(1,1),A,brow+Q_HALF,nt-1);
      BAR; WAIT_L(0); MMA(0,0,At,B0); BAR;
      LDB(B1,0,1); BAR; WAIT_L(0); MMA(0,1,At,B1); BAR;
      LDA(At,0,1); WAIT_V(4); BAR; WAIT_L(0); MMA(1,0,At,B0); MMA(1,1,At,B1); BAR; }
    { LDB(B0,1,0); LDA(At,1,0); WAIT_V(2); BAR; WAIT_L(0); MMA(0,0,At,B0); BAR;
      LDB(B1,1,1); WAIT_V(0); BAR; WAIT_L(0); MMA(0,1,At,B1); BAR;
      LDA(At,1,1); BAR; WAIT_L(0); MMA(1,0,At,B0); MMA(1,1,At,B1); BAR; }
    if(wr==0)BAR;
#pragma unroll
    for(int ai=0;ai<2;++ai)
#pragma unroll
    for(int bj=0;bj<2;++bj)
#pragma unroll
    for(int m=0;m<4;++m){
        const int row = brow+ai*Q_HALF+wr*64+m*16+fr;
        const f32x4 a = acc[ai][bj][m][0], b = acc[ai][bj][m][1];
        const hf4 ha = {(hf)a[0], (hf)a[1], (hf)a[2], (hf)a[3]}, hb = {(hf)b[0], (hf)b[1], (hf)b[2], (hf)b[3]};
        const u32x2 ua = __builtin_bit_cast(u32x2, ha), ub = __builtin_bit_cast(u32x2, hb);
        const auto r0 = __builtin_amdgcn_permlane16_swap(ua.x, ub.x, false, false);
        const auto r1 = __builtin_amdgcn_permlane16_swap(ua.y, ub.y, false, false);
        const u32x4 o = {r0[0], r1[0], r0[1], r1[1]};
        const int col = bcol+bj*Q_HALF+wc*32 + ((fq & 1) ? 16 + (fq - 1) * 4 : fq * 4);
        if (row < mlimit && col < nlimit) {
            st16_wt(C + (size_t)row * ldc + col, o);
        }
    }
    __syncthreads();
#undef SA
#undef SB
#undef STAGE
#undef LDA
#undef LDB
#undef MMA
#undef WAIT_V
#undef WAIT_L
#undef BAR
#undef SCHED
}

__device__ __forceinline__ void phase2(const Params& p, int l, unsigned char* smem) {
    const hf* A = (const hf*)(p.ws + WS_H);
    const hf* Bt = (const hf*)(p.ws + WS_WTIN) + (size_t)l * PINP * D;
    hf* U = (hf*)(p.ws + WS_U);
    constexpr int NMT = MPAD / 256, NNT = PINP / 256;
    for (int t = blockIdx.x; t < NMT * NNT; t += gridDim.x) {
        int pm, pn;
        q_tile_of(t, NMT, NNT, pm, pn);
        gemm256(A, Bt, U, pm * 256, pn * 256, MROWS, PIN, PIN, smem);
    }
}
__device__ __forceinline__ void phase5b(const Params& p, int l, unsigned char* smem) {
    const hf* A = (const hf*)(p.ws + WS_MIX);
    const hf* Bt = (const hf*)(p.ws + WS_WTOUT) + (size_t)l * D * D;
    hf* C = (hf*)(p.out + O_Y) + l * 1024;
    for (int t = blockIdx.x; t < 64 * 4; t += gridDim.x) {
        int pm, pn;
        q_tile_of(t, 64, 4, pm, pn);
        gemm256(A, Bt, C, pm * 256, pn * 256, NTOK, D, 2048, smem);
    }
    for (int t = blockIdx.x; t < 256; t += gridDim.x) {
        const int tid = tid_(), lane = tid & 63, wave = tid >> 6;
        const int fr = lane & 15, fq = lane >> 4;
        const int m0 = 16384 + (t >> 5) * 64 + (wave >> 1) * 16, n0 = (t & 31) * 32 + (wave & 1) * 16;
        const hf* ap = A + (size_t)(m0 + fr) * D + fq * 8;
        const hf* bp = Bt + (size_t)(n0 + fr) * D + fq * 8;
        f32x4 acc0 = {0.f, 0.f, 0.f, 0.f}, acc1 = {0.f, 0.f, 0.f, 0.f};
#pragma unroll 4
        for (int k = 0; k < D; k += 64) {
            const hf8 a0 = *(const hf8*)(ap + k), b0 = *(const hf8*)(bp + k);
            const hf8 a1 = *(const hf8*)(ap + k + 32), b1 = *(const hf8*)(bp + k + 32);
            acc0 = __builtin_amdgcn_mfma_f32_16x16x32_f16(b0, a0, acc0, 0, 0, 0);
            acc1 = __builtin_amdgcn_mfma_f32_16x16x32_f16(b1, a1, acc1, 0, 0, 0);
        }
        const f32x4 a = acc0 + acc1;
        hf4 o = {(hf)a[0], (hf)a[1], (hf)a[2], (hf)a[3]};
        *(hf4*)(C + (size_t)(m0 + fr) * 2048 + n0 + fq * 4) = o;
    }
}

__device__ __forceinline__ void p3_lora(const Params& p, int l, int witem, int h0, int h1) {
    const int lane = tid_() & 63;
    const int fr = lane & 15, fq = lane >> 4;
    const hf* U = (const hf*)(p.ws + WS_U);
    hf* EA = (hf*)(p.ws + WS_EA);
    hf* KKB = (hf*)(p.ws + WS_H);
    const hf* WupT = (const hf*)(p.ws + WS_WUPT) + (size_t)l * 512 * 64;
    const hf* AupT = (const hf*)(p.ws + WS_AUPT) + (size_t)l * 512 * 64;
    const float* mu = p.mu + (size_t)l * PRW;
    const int tk = witem * 16 + fr;
    const int pr = prev_row(tk);
    const float pm = pr >= 0 ? 1.f : 0.f;
    const hf* ut = U + (size_t)tk * PIN;
    const hf* up = U + (size_t)(pr >= 0 ? pr : 0) * PIN;
    hf8 aw[2], aa[2];
#pragma unroll
    for (int ks = 0; ks < 2; ++ks) {
        const int kb = ks * 32 + fq * 8;
        const hf8 cw = *(const hf8*)(ut + 2048 + kb), ca = *(const hf8*)(ut + 2112 + kb);
        const hf8 pw = *(const hf8*)(up + 2048 + kb), pa = *(const hf8*)(up + 2112 + kb);
#pragma unroll
        for (int j = 0; j < 8; ++j) {
            float c = (float)cw[j], q = (float)pw[j] * pm;
            aw[ks][j] = (hf)tanh_fast(c + (q - c) * mu[2048 + kb + j]);
            c = (float)ca[j]; q = (float)pa[j] * pm;
            aa[ks][j] = (hf)(c + (q - c) * mu[2112 + kb + j]);
        }
    }
    auto store_pair = [&](hf* base, int n0, hf4 t0, hf4 t1) {
        const u32x2 ua = __builtin_bit_cast(u32x2, t0), ub = __builtin_bit_cast(u32x2, t1);
        const auto r0 = __builtin_amdgcn_permlane16_swap(ua.x, ub.x, false, false);
        const auto r1 = __builtin_amdgcn_permlane16_swap(ua.y, ub.y, false, false);
        const u32x4 o = {r0[0], r1[0], r0[1], r1[1]};
        const int col = n0 + ((fq & 1) ? 16 + (fq - 1) * 4 : fq * 4);
        st16_wt(base + (size_t)tk * D + col, o);
    };
    for (int h = h0; h < h1; ++h) {
        f32x4 av[4], kv[4];
        hf4 eo[4], ao[4];
        float ss = 0.f;
#pragma unroll
        for (int nt = 0; nt < 4; ++nt) {
            const int n0 = h * 64 + nt * 16;
            f32x4 cw = {0.f, 0.f, 0.f, 0.f}, ca = {0.f, 0.f, 0.f, 0.f};
#pragma unroll
            for (int ks = 0; ks < 2; ++ks) {
                const hf8 bw = *(const hf8*)(WupT + (size_t)(n0 + fr) * 64 + ks * 32 + fq * 8);
                const hf8 ba = *(const hf8*)(AupT + (size_t)(n0 + fr) * 64 + ks * 32 + fq * 8);
                cw = __builtin_amdgcn_mfma_f32_16x16x32_f16(bw, aw[ks], cw, 0, 0, 0);
                ca = __builtin_amdgcn_mfma_f32_16x16x32_f16(ba, aa[ks], ca, 0, 0, 0);
            }
            const int col = n0 + fq * 4;
            const f32x4 w0c = *(const f32x4*)(p.w0 + l * 512 + col), a0c = *(const f32x4*)(p.a0 + l * 512 + col);
            const f32x4 kkc = *(const f32x4*)(p.k_k + l * 512 + col), muk = *(const f32x4*)(mu + 512 + col), kac = *(const f32x4*)(p.k_a + l * 512 + col);
            const hf4 kc4 = *(const hf4*)(ut + 512 + col), kp4 = *(const hf4*)(up + 512 + col);
            const f32x4 kcf = {(float)kc4.x, (float)kc4.y, (float)kc4.z, (float)kc4.w};
            const f32x4 kpf = (f32x4){(float)kp4.x, (float)kp4.y, (float)kp4.z, (float)kp4.w} * pm;
            const f32x4 kl = kcf + (kpf - kcf) * muk;
            const f32x4 xe = w0c + cw, xa = a0c + ca;
            f32x4 e4, a4;
            e4.x = sigm(xe.x); e4.y = sigm(xe.y); e4.z = sigm(xe.z); e4.w = sigm(xe.w);
            a4.x = sigm(xa.x); a4.y = sigm(xa.y); a4.z = sigm(xa.z); a4.w = sigm(xa.w);
            e4 = e4 * 0.60653066f;
            const f32x4 km = kl * (1.f + (a4 - 1.f) * kac);
            const f32x4 kkr = kl * kkc;
            eo[nt] = (hf4){(hf)e4.x, (hf)e4.y, (hf)e4.z, (hf)e4.w};
            ao[nt] = (hf4){(hf)km.x, (hf)km.y, (hf)km.z, (hf)km.w};
            av[nt] = a4; kv[nt] = kkr;
            const f32x4 k2 = kkr * kkr;
            ss += (k2.x + k2.y) + (k2.z + k2.w);
        }
        store_pair(EA, h * 64, eo[0], eo[1]);
        store_pair(EA, h * 64 + 32, eo[2], eo[3]);
        store_pair(EA + 512, h * 64, ao[0], ao[1]);
        store_pair(EA + 512, h * 64 + 32, ao[2], ao[3]);
        ss += __shfl_xor(ss, 16);
        ss += __shfl_xor(ss, 32);
        const float inv = 1.f / fmaxf(sqrtf(ss), 1e-12f);
        hf4 ko[4], bo[4];
#pragma unroll
        for (int nt = 0; nt < 4; ++nt) {
#pragma unroll
            for (int j = 0; j < 4; ++j) { const float kk = kv[nt][j] * inv; ko[nt][j] = (hf)kk; bo[nt][j] = (hf)(kk * av[nt][j]); }
        }
        store_pair(KKB, h * 64, ko[0], ko[1]);
        store_pair(KKB, h * 64 + 32, ko[2], ko[3]);
        store_pair(KKB + 512, h * 64, bo[0], bo[1]);
        store_pair(KKB + 512, h * 64 + 32, bo[2], bo[3]);
    }
}

template <int NT>
__device__ __forceinline__ void conv_taps(const float* G, const float* w, float bias, float* acc) {
    typedef float cf2 __attribute__((ext_vector_type(2)));
    cf2 W2[32];
#pragma unroll
    for (int j = 0; j < 32; ++j) W2[j] = (cf2){j < 31 ? w[j] : 0.f, j > 0 ? w[j - 1] : 0.f};
    cf2 ap[NT / 2];
#pragma unroll
    for (int pi = 0; pi < NT / 2; ++pi) ap[pi] = (cf2){bias, bias};
#pragma unroll
    for (int r = 0; r < NT + 30; ++r) {
        const float g = G[r * 64];
        const cf2 gg = {g, g};
#pragma unroll
        for (int pi = 0; pi < NT / 2; ++pi) {
            const int j = r - 2 * pi;
            if (j >= 0 && j <= 31) ap[pi] = gg * W2[j] + ap[pi];
        }
    }
#pragma unroll
    for (int pi = 0; pi < NT / 2; ++pi) { acc[2 * pi] = ap[pi].x; acc[2 * pi + 1] = ap[pi].y; }
}

__device__ __forceinline__ void p3_conv_prompt(const Params& p, int l, int item, unsigned char* smem) {
    float* G = (float*)smem;
    hf* T = (hf*)(smem + 286 * 64 * 4) + (tid_() >> 6) * 512;
    const int g = item & 7, tt = (item >> 3) & 7, b = item >> 6;
    const int c0 = g * 64, t0 = tt * 256;
    const hf* U = (const hf*)(p.ws + WS_U);
    hf* MIX = (hf*)(p.ws + WS_MIX);
    const int tid = tid_();
    const int c = tid & 63, tq = tid >> 6;
    const int ch = c0 + c;
    float w[31];
#pragma unroll
    for (int j = 0; j < 31; ++j) w[j] = p.w_dw[((size_t)l * 31 + j) * 512 + ch];
    const float bias = p.b_dw[l * 512 + ch], gg = p.gn_c_g[l * 512 + ch], gb = p.gn_c_b[l * 512 + ch];
    hf gcv[32];
#pragma unroll
    for (int i = 0; i < 32; ++i) gcv[i] = U[(size_t)(b * 2048 + t0 + tq * 32 + i) * PIN + PRW + 1024 + ch];
    {
        hf2 ua[18], ub[18];
#pragma unroll
        for (int i = 0; i < 18; ++i) {
            const int e = min(tid + NTHR * i, 286 * 32 - 1);
            const int r = e >> 5, cp = (e & 31) * 2;
            const int t = max(t0 - 30 + r, 0);
            const hf* u = U + (size_t)(b * 2048 + t) * PIN + PRW + c0 + cp;
            ua[i] = *(const hf2*)u; ub[i] = *(const hf2*)(u + 512);
        }
#pragma unroll
        for (int i = 0; i < 18; ++i) {
            const int e = tid + NTHR * i;
            if (e < 286 * 32) {
                const int r = e >> 5, cp = (e & 31) * 2;
                const float m = (t0 - 30 + r) >= 0 ? 1.f : 0.f;
                G[r * 64 + cp] = m * (float)ua[i].x * sigm((float)ub[i].x);
                G[r * 64 + cp + 1] = m * (float)ua[i].y * sigm((float)ub[i].y);
            }
        }
    }
    __syncthreads();
#pragma unroll
    for (int sub = 0; sub < 4; ++sub) {
        const int tl = tq * 32 + sub * 8;
        float acc[8];
        conv_taps<8>(G + tl * 64 + c, w, bias, acc);
#pragma unroll
        for (int i = 0; i < 8; ++i) {
            const int tk = b * 2048 + t0 + tl + i;
            const float mean = wave_sum_all(acc[i]) * (1.f / 64.f);
            const float var = fmaxf(wave_sum_all(acc[i] * acc[i]) * (1.f / 64.f) - mean * mean, 0.f);
            const float yn = (acc[i] - mean) * rsqrtf(var + 1e-5f) * gg + gb;
            (void)tk;
            T[i * 64 + c] = (hf)silu2(yn, (float)gcv[sub * 8 + i]);
        }
        asm volatile("s_waitcnt lgkmcnt(0)" ::: "memory");
        {
            const int lane = tid & 63, tok = lane >> 3, ch8 = (lane & 7) * 8;
            const u32x4 v = *(const u32x4*)(T + tok * 64 + ch8);
            st16_wt(MIX + (size_t)(b * 2048 + t0 + tl + tok) * D + 512 + c0 + ch8, v);
        }
        asm volatile("s_waitcnt lgkmcnt(0)" ::: "memory");
    }
    if (tt == 7) {
        float* oc = p.out + O_CONV_P + ((size_t)l * 8 + b) * 30 * 512;
        for (int e = tid; e < 30 * 64; e += NTHR) {
            const int r = e >> 6, cc = e & 63;
            oc[(size_t)r * 512 + c0 + cc] = G[(256 + r) * 64 + cc];
        }
    }
    __syncthreads();
}

__device__ __forceinline__ void p3_conv_sample(const Params& p, int l, int item, unsigned char* smem) {
    float* G = (float*)smem;
    const int g = item & 7, s0 = (item >> 3) * 4;
    const int c0 = g * 64;
    const hf* U = (const hf*)(p.ws + WS_U);
    hf* MIX = (hf*)(p.ws + WS_MIX);
    const int tid = tid_();
    {
        float hv[15];
        hf ga[2], gbv[2];
#pragma unroll
        for (int i = 0; i < 15; ++i) {
            const int e = tid + NTHR * i, cc = e & 63, rr = (e >> 6) % 30, sl = (e >> 6) / 30;
            hv[i] = p.state_conv[(((size_t)l * 128 + s0 + sl) * 30 + rr) * 512 + c0 + cc];
        }
#pragma unroll
        for (int i = 0; i < 2; ++i) {
            const int e = tid + NTHR * i, cc = e & 63, tt = (e >> 6) & 3, sl = e >> 8;
            const hf* u = U + (size_t)(NTOKP + (s0 + sl) * 4 + tt) * PIN + PRW + c0 + cc;
            ga[i] = u[0]; gbv[i] = u[512];
        }
#pragma unroll
        for (int i = 0; i < 15; ++i) {
            const int e = tid + NTHR * i, cc = e & 63, rr = (e >> 6) % 30, sl = (e >> 6) / 30;
            G[(sl * 34 + rr) * 64 + cc] = hv[i];
        }
#pragma unroll
        for (int i = 0; i < 2; ++i) {
            const int e = tid + NTHR * i, cc = e & 63, tt = (e >> 6) & 3, sl = e >> 8;
            G[(sl * 34 + 30 + tt) * 64 + cc] = (float)ga[i] * sigm((float)gbv[i]);
        }
    }
    const int c = tid & 63, wv = tid >> 6;
    const int sl = wv >> 1, tp = (wv & 1) * 2;
    const int ch = c0 + c, bs = s0 + sl;
    float w[31];
#pragma unroll
    for (int j = 0; j < 31; ++j) w[j] = p.w_dw[((size_t)l * 31 + j) * 512 + ch];
    hf gcs[2];
#pragma unroll
    for (int i = 0; i < 2; ++i) gcs[i] = U[(size_t)(NTOKP + bs * 4 + tp + i) * PIN + PRW + 1024 + ch];
    __syncthreads();
    float acc[2];
    conv_taps<2>(G + (sl * 34 + tp) * 64 + c, w, p.b_dw[l * 512 + ch], acc);
    const float gg = p.gn_c_g[l * 512 + ch], gb = p.gn_c_b[l * 512 + ch];
#pragma unroll
    for (int i = 0; i < 2; ++i) {
        const int tk = NTOKP + bs * 4 + tp + i;
        const float mean = wave_sum(acc[i]) * (1.f / 64.f);
        const float d = acc[i] - mean;
        const float var = wave_sum(d * d) * (1.f / 64.f);
        const float yn = d * rsqrtf(var + 1e-5f) * gg + gb;
        MIX[(size_t)tk * D + 512 + ch] = (hf)silu2(yn, (float)gcs[i]);
    }
#pragma unroll
    for (int e = tid; e < 4 * 30 * 64; e += NTHR) {
        const int cc = e & 63, r = (e >> 6) % 30, s2 = (e >> 6) / 30;
        p.out[O_CONV_S + (((size_t)l * 128 + s0 + s2) * 30 + r) * 512 + c0 + cc] = G[(s2 * 34 + 4 + r) * 64 + cc];
    }
    __syncthreads();
}

__device__ __forceinline__ void phase3(const Params& p, int l, unsigned char* smem) {
    constexpr int W_LORA = NTOK / 16;
    constexpr int I_CP = 8 * 8 * 8;
    constexpr int I_CS = 32 * 8;
    {
        const int wave = tid_() >> 6;
        if (wave < 4) {
            const int wi = blockIdx.x + gridDim.x * wave;
            if (wi < W_LORA) p3_lora(p, l, wi, 0, 8);
        } else if (wave == 4) {
            const int piece = blockIdx.x;
            const int wi = 4 * (int)gridDim.x + (piece >> 3), hh = piece & 7;
            if (wi < W_LORA) p3_lora(p, l, wi, hh, hh + 1);
        }
    }
    for (int it = blockIdx.x; it < I_CP + I_CS; it += gridDim.x) {
        if (it < I_CP) p3_conv_prompt(p, l, it, smem);
        else p3_conv_sample(p, l, it - I_CP, smem);
    }
}

typedef float f32x2 __attribute__((ext_vector_type(2)));
struct WkvS { f32x2 lo, hi; };
__device__ __forceinline__ void wkv_step(WkvS& S, const float* op, float v, float& y) {
    const f32x4 r4 = *(const f32x4*)(op + 0 * 64);
    const f32x4 w4 = *(const f32x4*)(op + 1 * 64);
    const f32x4 m4 = *(const f32x4*)(op + 2 * 64);
    const f32x4 k4 = *(const f32x4*)(op + 3 * 64);
    const f32x4 b4 = *(const f32x4*)(op + 4 * 64);
    f32x2 d = S.lo * k4.lo + S.hi * k4.hi;
    const float sk = row_allreduce16(d.x + d.y);
    const f32x2 nsk = {-sk, -sk}, vv = {v, v};
    S.lo = vv * m4.lo + (nsk * b4.lo + S.lo * w4.lo);
    S.hi = vv * m4.hi + (nsk * b4.hi + S.hi * w4.hi);
    f32x2 e = S.lo * r4.lo + S.hi * r4.hi;
    y = row_allreduce16(e.x + e.y);
}

struct WkvOps { f32x4 r4, w4, m4, k4, b4; float v; };
__device__ __forceinline__ WkvOps wkv_load(const float* op, const float* vb) {
    WkvOps o;
    o.r4 = *(const f32x4*)(op + 0 * 64);
    o.w4 = *(const f32x4*)(op + 1 * 64);
    o.m4 = *(const f32x4*)(op + 2 * 64);
    o.k4 = *(const f32x4*)(op + 3 * 64);
    o.b4 = *(const f32x4*)(op + 4 * 64);
    o.v = *vb;
    return o;
}
struct WkvOpsS { f32x4 r4, m4, k4, b4; float v; };
__device__ __forceinline__ WkvOpsS wkv_load_s(const float* op, const float* vb) {
    WkvOpsS o;
    o.r4 = *(const f32x4*)(op + 0 * 64);
    o.m4 = *(const f32x4*)(op + 2 * 64);
    o.k4 = *(const f32x4*)(op + 3 * 64);
    o.b4 = *(const f32x4*)(op + 4 * 64);
    o.v = *vb;
    return o;
}
__device__ __forceinline__ float wkv_step_part(WkvS& S, const WkvOpsS& o, const f32x4& rprev) {
    f32x2 d = S.lo * o.k4.lo + S.hi * o.k4.hi;
    float s = d.x + d.y;
    const f32x2 vv = {o.v, o.v};
    f32x2 q = S.lo * rprev.lo + S.hi * rprev.hi;
    const f32x2 tl = vv * o.m4.lo + S.lo;
    const f32x2 th = vv * o.m4.hi + S.hi;
    s = row_allreduce16(s);
    const f32x2 nsk = {-s, -s};
    S.lo = nsk * o.b4.lo + tl;
    S.hi = nsk * o.b4.hi + th;
    return q.x + q.y;
}

__device__ __forceinline__ void wkv_step_pipe(WkvS& S, const WkvOps& o, float& eprev, float& enew) {
    f32x2 d = S.lo * o.k4.lo + S.hi * o.k4.hi;
    float s = d.x + d.y, e = eprev;
    s += dpp_mov<0x128>(s); e += dpp_mov<0x128>(e);
    s += dpp_mov<0x124>(s); e += dpp_mov<0x124>(e);
    s += dpp_mov<0x122>(s); e += dpp_mov<0x122>(e);
    s += dpp_mov<0x121>(s); e += dpp_mov<0x121>(e);
    eprev = e;
    const f32x2 nsk = {-s, -s}, vv = {o.v, o.v};
    S.lo = vv * o.m4.lo + (nsk * o.b4.lo + S.lo * o.w4.lo);
    S.hi = vv * o.m4.hi + (nsk * o.b4.hi + S.hi * o.w4.hi);
    f32x2 q = S.lo * o.r4.lo + S.hi * o.r4.hi;
    enew = q.x + q.y;
}

__device__ __forceinline__ void phase4(const Params& p, int l, unsigned char* smem) {
    constexpr int OPS = 324;
    float* OP = (float*)smem;
    float* VB = OP + 2 * 16 * OPS;
    float* YB = VB + 2 * 16 * 16;
    float* VS = YB + 2 * 16 * 16 * 17;
    float* GE = VS + 16 * 64;
    const int tid = tid_(), lane = tid & 63, wave = tid >> 6;
    const hf* U = (const hf*)(p.ws + WS_U);
    const hf* EA = (const hf*)(p.ws + WS_EA);
    const hf* KKB = (const hf*)(p.ws + WS_H);
    hf* MIX = (hf*)(p.ws + WS_MIX);
    const float* mu = p.mu + (size_t)l * PRW;
    const int blk = blockIdx.x;
    const int xcd = blk & 7, idx = blk >> 3;
    const int rg = idx & 3;
    const int pbh = xcd * 8 + (idx >> 2);
    const int pb = pbh >> 3, ph = pbh & 7;
    const bool producer = wave >= 4;
    const int pw = wave & 3;
    const int rl = lane >> 4, ks = lane & 15;
    constexpr int NCHP = 2048 / 16;

    const int cl = lane >> 4, pt = lane & 15;
    const int c4 = pw * 16 + cl * 4;
    const int pcol = ph * 64 + c4;
    const f32x4 mur4 = *(const f32x4*)(mu + pcol), muv4 = *(const f32x4*)(mu + 1024 + pcol);
    const int tkp = pb * 2048 + pt;
    const hf* uc = U + (size_t)tkp * PIN + pcol;
    const hf* eac = EA + (size_t)tkp * D + pcol;
    const hf* kbc = KKB + (size_t)tkp * D + pcol;
    struct PQ { hf4 r, v, rp, vp, e, a, kk, bb; };
    PQ qA, qB;
    auto load_prompt = [&](int ci, PQ& q) {
        const hf* u = uc + (size_t)ci * (16 * PIN);
        q.r = *(const hf4*)u; q.v = *(const hf4*)(u + 1024);
        q.rp = *(const hf4*)(u - PIN); q.vp = *(const hf4*)(u - PIN + 1024);
        const hf* e_ = eac + (size_t)ci * (16 * D);
        q.e = *(const hf4*)e_; q.a = *(const hf4*)(e_ + 512);
        const hf* k_ = kbc + (size_t)ci * (16 * D);
        q.kk = *(const hf4*)k_; q.bb = *(const hf4*)(k_ + 512);
    };
    auto cvt4 = [](hf4 x) { return (f32x4){(float)x.x, (float)x.y, (float)x.z, (float)x.w}; };
    auto scan16 = [](float x) {
        x += dpp_mov<0x111>(x);
        x += dpp_mov<0x112>(x);
        x += dpp_mov<0x114>(x);
        x += dpp_mov<0x118>(x);
        return x;
    };
    auto store_prompt = [&](int ci, int buf, const PQ& q) {
        const float pmask = (ci == 0 && pt == 0) ? 0.f : 1.f;
        const f32x4 rc = cvt4(q.r), vc = cvt4(q.v);
        const f32x4 rp = cvt4(q.rp) * pmask, vp = cvt4(q.vp) * pmask;
        const f32x4 e = cvt4(q.e);
        const f32x4 r = rc + (rp - rc) * mur4, v = vc + (vp - vc) * muv4;
        f32x4 cum;
        cum.x = scan16(e.x); cum.y = scan16(e.y); cum.z = scan16(e.z); cum.w = scan16(e.w);
        const f32x4 cpv = cum - e;
        f32x4 gin, gout, gprev;
        gin.x = __expf(-cum.x); gin.y = __expf(-cum.y); gin.z = __expf(-cum.z); gin.w = __expf(-cum.w);
        gout.x = __expf(cum.x); gout.y = __expf(cum.y); gout.z = __expf(cum.z); gout.w = __expf(cum.w);
        gprev.x = __expf(-cpv.x); gprev.y = __expf(-cpv.y); gprev.z = __expf(-cpv.z); gprev.w = __expf(-cpv.w);
        float* op = OP + buf * (16 * OPS) + pt * OPS + c4;
        *(f32x4*)(op + 0 * 64) = r * gin;
        *(f32x4*)(op + 2 * 64) = cvt4(q.a) * gout;
        *(f32x4*)(op + 3 * 64) = cvt4(q.kk) * gprev;
        *(f32x4*)(op + 4 * 64) = cvt4(q.bb) * gout;
        if (pt == 15) *(f32x4*)(GE + buf * 64 + c4) = gin;
        if (pw == rg) *(f32x4*)(VB + buf * 256 + pt * 16 + cl * 4) = v;
    };
    auto flush_y = [&](int ci, int buf) {
        const int tok = pw * 4 + (lane >> 4), row = lane & 15;
        const float* yb = YB + buf * (16 * 16 * 17) + (tok * 16 + row) * 17;
        float y0 = 0.f, y1 = 0.f, y2 = 0.f, y3 = 0.f;
#pragma unroll
        for (int j = 0; j < 16; j += 4) { y0 += yb[j]; y1 += yb[j + 1]; y2 += yb[j + 2]; y3 += yb[j + 3]; }
        MIX[(size_t)(pb * 2048 + ci * 16 + tok) * D + ph * 64 + rg * 16 + row] = (hf)((y0 + y1) + (y2 + y3));
    };

    WkvS S; S.lo = (f32x2){0.f, 0.f}; S.hi = (f32x2){0.f, 0.f};
    if (producer) { load_prompt(0, qB); store_prompt(0, 0, qB); load_prompt(1, qA); load_prompt(2, qB); }
    __syncthreads();
    auto consume = [&](int buf) {
        const float* op = OP + buf * (16 * OPS) + ks * 4;
        const float* vb = VB + buf * 256 + pw * 4 + rl;
        float* yb = YB + buf * (16 * 16 * 17) + (pw * 4 + rl) * 17 + ks;
        WkvOpsS ring[4];
        ring[0] = wkv_load_s(op, vb);
        ring[1] = wkv_load_s(op + OPS, vb + 16);
        ring[2] = wkv_load_s(op + 2 * OPS, vb + 32);
        f32x4 rprev = {0.f, 0.f, 0.f, 0.f};
#pragma unroll
        for (int t = 0; t < 16; ++t) {
            if (t + 3 < 16) ring[(t + 3) & 3] = wkv_load_s(op + (t + 3) * OPS, vb + (t + 3) * 16);
            __builtin_amdgcn_sched_barrier(0);
            const float e = wkv_step_part(S, ring[t & 3], rprev);
            if (t > 0) yb[(t - 1) * (16 * 17)] = e;
            rprev = ring[t & 3].r4;
            __builtin_amdgcn_sched_barrier(0);
        }
        {
            f32x2 q = S.lo * rprev.lo + S.hi * rprev.hi;
            yb[15 * (16 * 17)] = q.x + q.y;
            const f32x4 ge = *(const f32x4*)(GE + buf * 64 + ks * 4);
            S.lo = S.lo * ge.lo;
            S.hi = S.hi * ge.hi;
        }
    };
#pragma unroll 1
    for (int ci = 0; ci < NCHP; ci += 2) {
        if (producer) {
            store_prompt(ci + 1, 1, qA);
            if (ci + 3 < NCHP) load_prompt(ci + 3, qA);
            if (ci >= 1) flush_y(ci - 1, 1);
        } else consume(0);
        __syncthreads();
        if (producer) {
            if (ci + 2 < NCHP) store_prompt(ci + 2, 0, qB);
            if (ci + 4 < NCHP) load_prompt(ci + 4, qB);
            flush_y(ci, 0);
        } else consume(1);
        __syncthreads();
    }

    f32x4 St[4][4];
    if (producer) {
        flush_y(NCHP - 1, (NCHP - 1) & 1);
        const int id = blk * 4 + pw, bs = id >> 3, h = id & 7;
        const int col = h * 64 + lane;
        const float smur = mu[col], smuk = mu[512 + col], smuv = mu[1024 + col], ska = p.k_a[l * 512 + col];
        const int tk0 = NTOKP + bs * 4;
        const hf* up = U + (size_t)(NTOK + bs) * PIN + col;
        float rp = (float)up[0], kp = (float)up[512], vp = (float)up[1024];
#pragma unroll
        for (int i = 0; i < 4; ++i) {
            const int tk = tk0 + i, t = pw * 4 + i;
            const hf* ut = U + (size_t)tk * PIN + col;
            const float rc = (float)ut[0], kc = (float)ut[512], vc = (float)ut[1024];
            const float e = (float)EA[(size_t)tk * D + col], a = (float)EA[(size_t)tk * D + 512 + col];
            const float kk = (float)KKB[(size_t)tk * D + col], bb = (float)KKB[(size_t)tk * D + 512 + col];
            OP[(t * 5 + 0) * 64 + lane] = rc + (rp - rc) * smur;
            OP[(t * 5 + 1) * 64 + lane] = __expf(-e);
            OP[(t * 5 + 2) * 64 + lane] = a;
            OP[(t * 5 + 3) * 64 + lane] = kk;
            OP[(t * 5 + 4) * 64 + lane] = bb;
            VS[t * 64 + lane] = vc + (vp - vc) * smuv;
            rp = rc; kp = kc; vp = vc;
        }
    } else {
        *(f32x4*)(p.out + O_WKV_P + ((((size_t)l * 8 + pb) * 8 + ph) * 64 + rg * 16 + pw * 4 + rl) * 64 + ks * 4) = (f32x4){S.lo.x, S.lo.y, S.hi.x, S.hi.y};
#pragma unroll
        for (int q = 0; q < 4; ++q) {
            const int id = blk * 4 + q, bs = id >> 3, h = id & 7;
#pragma unroll
            for (int g = 0; g < 4; ++g) {
                const int row = pw * 16 + g * 4 + rl;
                St[q][g] = *(const f32x4*)(p.state_wkv + ((((size_t)l * 128 + bs) * 8 + h) * 64 + row) * 64 + ks * 4);
            }
        }
    }
    __syncthreads();
    if (!producer) {
#pragma unroll
        for (int q = 0; q < 4; ++q) {
            const int id = blk * 4 + q, bs = id >> 3, h = id & 7;
#pragma unroll
            for (int g = 0; g < 4; ++g) {
                const int row = pw * 16 + g * 4 + rl;
                WkvS Sq; Sq.lo = St[q][g].lo; Sq.hi = St[q][g].hi;
                float ykeep = 0.f;
#pragma unroll
                for (int t = 0; t < 4; ++t) {
                    float y;
                    wkv_step(Sq, OP + ((q * 4 + t) * 5) * 64 + ks * 4, VS[(q * 4 + t) * 64 + row], y);
                    ykeep = (ks == t) ? y : ykeep;
                }
                *(f32x4*)(p.out + O_WKV_S + ((((size_t)l * 128 + bs) * 8 + h) * 64 + row) * 64 + ks * 4) = (f32x4){Sq.lo.x, Sq.lo.y, Sq.hi.x, Sq.hi.y};
                if (ks < 4) MIX[(size_t)(NTOKP + bs * 4 + ks) * D + h * 64 + row] = (hf)ykeep;
            }
        }
    }
    __syncthreads();
}

__device__ __forceinline__ void phase5a(const Params& p, int l, hf* DST = nullptr) {
    const int tid = tid_(); const int lane = tid & 63, wave = tid >> 6;
    const hf* U = (const hf*)(p.ws + WS_U);
    const hf* EA = (const hf*)(p.ws + WS_EA);
    hf* MIX = (hf*)(p.ws + WS_MIX);
    hf* OUT = DST ? DST : MIX;
    const float* mu = p.mu + (size_t)l * PRW;
    const int ti = lane >> 4, c4 = (lane & 15) * 4;
    struct It { hf4 uc[4], up[4], a, y; };
    constexpr int NIT = (NTOK / 4) * 8;
    const int stride = gridDim.x * 8;
    auto load = [&](int it, It& q) {
        const int tk = (it >> 3) * 4 + ti, col = (it & 7) * 64 + c4;
        const int pr = prev_row(tk);
        const hf* ut = U + (size_t)tk * PIN + col;
        const hf* up = U + (size_t)(pr >= 0 ? pr : 0) * PIN + col;
#pragma unroll
        for (int c = 0; c < 4; ++c) { if (c == 1) continue; q.uc[c] = *(const hf4*)(ut + 512 * c); q.up[c] = *(const hf4*)(up + 512 * c); }
        q.a = *(const hf4*)(EA + (size_t)tk * D + 512 + col);
        q.y = *(const hf4*)(MIX + (size_t)tk * D + col);
    };
    auto cvt4 = [](hf4 x) { return (f32x4){(float)x.x, (float)x.y, (float)x.z, (float)x.w}; };
    auto compute = [&](int it, const It& q) {
        const int tk = (it >> 3) * 4 + ti, col = (it & 7) * 64 + c4;
        const float pm = prev_row(tk) >= 0 ? 1.f : 0.f;
        const f32x4 mr = *(const f32x4*)(mu + col), mk = *(const f32x4*)(mu + 512 + col), mv = *(const f32x4*)(mu + 1024 + col), mg = *(const f32x4*)(mu + 1536 + col);
        const f32x4 ka = *(const f32x4*)(p.k_a + l * 512 + col), rk = *(const f32x4*)(p.r_k + l * 512 + col);
        const f32x4 gg = *(const f32x4*)(p.gn_r_g + l * 512 + col), gb = *(const f32x4*)(p.gn_r_b + l * 512 + col);
        const f32x4 rc = cvt4(q.uc[0]), vc = cvt4(q.uc[2]), gc = cvt4(q.uc[3]);
        const f32x4 r = rc + (cvt4(q.up[0]) * pm - rc) * mr;
        const f32x4 v = vc + (cvt4(q.up[2]) * pm - vc) * mv, g = gc + (cvt4(q.up[3]) * pm - gc) * mg;
        const f32x4 km = cvt4(q.a);
        const f32x4 y = cvt4(q.y);
        const f32x4 y2 = y * y, bo = r * km * rk;
        float s1 = (y.x + y.y) + (y.z + y.w), s2 = (y2.x + y2.y) + (y2.z + y2.w), s3 = (bo.x + bo.y) + (bo.z + bo.w);
        s1 = row_allreduce16(s1); s2 = row_allreduce16(s2); s3 = row_allreduce16(s3);
        const float mean = s1 * (1.f / 64.f);
        const float var = fmaxf(s2 * (1.f / 64.f) - mean * mean, 0.f);
        const float rs = rsqrtf(var + 64e-5f);
        const f32x4 yn = (y - mean) * rs * gg + gb;
        const f32x4 t = yn + s3 * v;
        hf4 o = {(hf)(t.x * silu(g.x)), (hf)(t.y * silu(g.y)), (hf)(t.z * silu(g.z)), (hf)(t.w * silu(g.w))};
        const u32x2 uo = __builtin_bit_cast(u32x2, o);
        const unsigned n0 = (unsigned)__builtin_amdgcn_update_dpp(0, (int)uo.x, 0x101, 0xf, 0xf, false);
        const unsigned n1 = (unsigned)__builtin_amdgcn_update_dpp(0, (int)uo.y, 0x101, 0xf, 0xf, false);
        if ((lane & 1) == 0) st16_wt(OUT + (size_t)tk * D + col, (u32x4){uo.x, uo.y, n0, n1});
    };
    It qa, qb;
    int it = blockIdx.x * 8 + wave;
    if (it < NIT) load(it, qa);
    while (it < NIT) {
        const int nx = it + stride;
        if (nx < NIT) load(nx, qb);
        compute(it, qa);
        qa = qb;
        it = nx;
    }
}

__device__ __forceinline__ void phase6(const Params& p) {
    const int tid = tid_(); const int lane = tid & 63, wave = tid >> 6;
    const float* MOD = (const float*)(p.ws + WS_MOD);
    struct Row { f32x4 x[4]; hf4 m0[4], m1[4]; };
    const int stride = gridDim.x * 8;
    auto load = [&](int tk, Row& q) {
        const float* xr = x0_row(p, tk);
        const hf* mo = (const hf*)(p.out + O_Y + (size_t)tk * D);
#pragma unroll
        for (int j = 0; j < 4; ++j) {
            q.x[j] = *(const f32x4*)(xr + 256 * j + 4 * lane);
            q.m0[j] = *(const hf4*)(mo + 256 * j + 4 * lane);
            q.m1[j] = *(const hf4*)(mo + 1024 + 256 * j + 4 * lane);
        }
    };
    Row qa, qb;
    auto tok_of = [&](int it) {
        if (it < NTOKP / stride) return (int)(blockIdx.x * 8 + wave) + it * stride;
        const int e = (wave + (it - NTOKP / stride) * 8) * (int)gridDim.x + (int)blockIdx.x;
        return e < NTOK - NTOKP ? NTOKP + e : NTOK;
    };
    int itn = 0;
    int tk = tok_of(0);
    if (tk < NTOK) load(tk, qa);
    while (tk < NTOK) {
        const int nx = tok_of(++itn);
        if (nx < NTOK) load(nx, qb);
        const int sq = seq_of(tk);
        float* yr = p.out + O_Y + (size_t)tk * D;
        f32x4 m0[4], m1[4];
        float s0 = 0.f, s1 = 0.f;
#pragma unroll
        for (int j = 0; j < 4; ++j) {
            m0[j] = (f32x4){(float)qa.m0[j].x, (float)qa.m0[j].y, (float)qa.m0[j].z, (float)qa.m0[j].w};
            m1[j] = (f32x4){(float)qa.m1[j].x, (float)qa.m1[j].y, (float)qa.m1[j].z, (float)qa.m1[j].w};
            s0 += m0[j].x * m0[j].x + m0[j].y * m0[j].y + m0[j].z * m0[j].z + m0[j].w * m0[j].w;
            s1 += m1[j].x * m1[j].x + m1[j].y * m1[j].y + m1[j].z * m1[j].z + m1[j].w * m1[j].w;
        }
        const float r0 = rsqrtf(wave_sum_all(s0) * (1.f / D) + 1e-6f);
        const float r1 = rsqrtf(wave_sum_all(s1) * (1.f / D) + 1e-6f);
#pragma unroll
        for (int j = 0; j < 4; ++j) {
            f32x4 gp0 = *(const f32x4*)(p.g_post + 256 * j + 4 * lane);
            f32x4 gp1 = *(const f32x4*)(p.g_post + D + 256 * j + 4 * lane);
            f32x4 gt0 = *(const f32x4*)(MOD + (size_t)sq * 6144 + 2048 + 256 * j + 4 * lane);
            f32x4 gt1 = *(const f32x4*)(MOD + (size_t)sq * 6144 + 3072 + 2048 + 256 * j + 4 * lane);
            f32x4 y = qa.x[j] + gt0 * (m0[j] * r0 * gp0);
            y = y + gt1 * (m1[j] * r1 * gp1);
            *(f32x4*)(yr + 256 * j + 4 * lane) = y;
        }
        qa = qb;
        tk = nx;
    }
}

constexpr int NPHASES = 14;
__device__ __forceinline__ void run_phase(const Params& p, int ph, unsigned char* smem) {
    if (ph == 0) { phase0(p, smem); return; }
    if (ph == 13) { phase6(p); return; }
    const int l = (ph - 1) / 6, s = (ph - 1) % 6;
    switch (s) {
        case 0: phase1(p, l); break;
        case 1: phase2(p, l, smem); break;
        case 2: phase3(p, l, smem); break;
        case 3: phase4(p, l, smem); break;
        case 4: phase5a(p, l); break;
        default: phase5b(p, l, smem); break;
    }
}

#define GSYNC() xcd_barrier(xb)
__global__ void __launch_bounds__(NTHR) fwd_mega(Params p) {
    extern __shared__ __attribute__((aligned(16))) unsigned char smem[];
    volatile LAS unsigned* st = (volatile LAS unsigned*)(smem + LDS_BYTES - 16);
    if (threadIdx.x == 0) { st[0] = 0u; st[1] = 0u; }
    __syncthreads();
    XcdBarrier xb = xcd_barrier_post((unsigned*)(p.ws + WS_BAR), st);
    if (p.ws == nullptr) cg::this_grid().sync();
    phase0(p, smem); GSYNC();
    phase1(p, 0); GSYNC();
    phase2(p, 0, smem); GSYNC();
    phase3(p, 0, smem); GSYNC();
    phase4(p, 0, smem); GSYNC();
    phase5a(p, 0); GSYNC();
    phase5b(p, 0, smem); GSYNC();
    phase1(p, 1); GSYNC();
    phase2(p, 1, smem); GSYNC();
    phase3(p, 1, smem); GSYNC();
    phase4(p, 1, smem); GSYNC();
    phase5a(p, 1); GSYNC();
    phase5b(p, 1, smem); GSYNC();
    phase6(p);
}
__global__ void __launch_bounds__(NTHR) fwd_phase(Params p, int ph) {
    extern __shared__ __attribute__((aligned(16))) unsigned char smem[];
    run_phase(p, ph, smem);
}

extern "C" void kernel_launch(void* const* d_in, const int* in_sizes, int n_in, void* d_out, int out_size, void* d_ws, size_t ws_size,
                              hipStream_t stream) {
    static int ok = 0;
    if (ok == 0) {
        ok = 1;
        if (n_in != 27 || (size_t)out_size != O_END || ws_size < WS_END) {
            fprintf(stderr, "kernel_launch: unexpected sizes n_in %d out %d ws %zu (need %zu)\n", n_in, out_size, ws_size, (size_t)WS_END);
            ok = -1;
        }
        int dev = 0, cus = 0, per_cu = 0;
        (void)hipGetDevice(&dev);
        (void)hipDeviceGetAttribute(&cus, hipDeviceAttributeMultiprocessorCount, dev);
        (void)hipFuncSetAttribute((const void*)fwd_mega, hipFuncAttributeMaxDynamicSharedMemorySize, LDS_BYTES);
        (void)hipFuncSetAttribute((const void*)fwd_phase, hipFuncAttributeMaxDynamicSharedMemorySize, LDS_BYTES);
        (void)hipOccupancyMaxActiveBlocksPerMultiprocessor(&per_cu, (const void*)fwd_mega, NTHR, LDS_BYTES);
        if (cus * per_cu < GRID) {
            fprintf(stderr, "kernel_launch: resident capacity %d x %d < grid %d\n", cus, per_cu, GRID);
            ok = -1;
        }
    }
    if (ok < 0) return;
    Params p{};
    const float** pp = (const float**)&p;
    for (int i = 0; i < 27; ++i) pp[i] = (const float*)d_in[i];
    p.out = (float*)d_out;
    p.ws = (unsigned char*)d_ws;
#if MULTI_LAUNCH
    for (int ph = 0; ph < NPHASES; ++ph) hipLaunchKernelGGL(fwd_phase, dim3(GRID), dim3(NTHR), LDS_BYTES, stream, p, ph);
#else
    (void)hipMemsetAsync((unsigned char*)d_ws + WS_BAR, 0, 16384, stream);
    void* args[] = {&p};
    hipError_t e = hipLaunchCooperativeKernel((const void*)fwd_mega, dim3(GRID), dim3(NTHR), args, LDS_BYTES, stream);
    if (e != hipSuccess) fprintf(stderr, "cooperative launch failed: %s\n", hipGetErrorString(e));
#endif
}
```

```cpp
#include <hip/hip_runtime.h>
#include <hip/hip_cooperative_groups.h>
#include <cstdio>
namespace cg = cooperative_groups;

#ifndef MULTI_LAUNCH
#define MULTI_LAUNCH 0
#endif

typedef _Float16 hf;
typedef hf hf8 __attribute__((ext_vector_type(8)));
typedef hf hf4 __attribute__((ext_vector_type(4)));
typedef hf hf2 __attribute__((ext_vector_type(2)));
typedef float f32x4 __attribute__((ext_vector_type(4)));

constexpr int D = 1024;
constexpr int NTOKP = 16384, NTOKS = 512, NTOK = 16896, NSEQ = 136;
constexpr int PIN = 3712, PRW = 2176;
constexpr int MROWS = NTOK + 128;
constexpr int MPAD = 17152;
constexpr int NTHR = 512;
constexpr int GRID = 256;

constexpr int PINP = 3840;
constexpr size_t WS_WTIN = 0;
constexpr size_t WS_WTOUT = WS_WTIN + (size_t)2 * PINP * D * 2;
constexpr size_t WS_WUPT = WS_WTOUT + (size_t)2 * D * D * 2;
constexpr size_t WS_AUPT = WS_WUPT + (size_t)2 * 512 * 64 * 2;
constexpr size_t WS_MOD = WS_AUPT + (size_t)2 * 512 * 64 * 2;
constexpr size_t WS_H = WS_MOD + (size_t)NSEQ * 6144 * 4;
constexpr size_t WS_U = WS_H + (size_t)MPAD * D * 2;
constexpr size_t WS_EA = WS_U + (size_t)MROWS * PIN * 2;
constexpr size_t WS_MIX = WS_EA + (size_t)NTOK * D * 2;
constexpr size_t WS_BAR = WS_MIX + (size_t)NTOK * D * 2;
constexpr size_t WS_END = WS_BAR + 16384;

constexpr size_t O_Y = 0;
constexpr size_t O_SHIFT_P = (size_t)NTOK * D;
constexpr size_t O_WKV_P = O_SHIFT_P + 2 * 8 * 1024;
constexpr size_t O_CONV_P = O_WKV_P + (size_t)2 * 8 * 8 * 4096;
constexpr size_t O_SHIFT_S = O_CONV_P + (size_t)2 * 8 * 30 * 512;
constexpr size_t O_WKV_S = O_SHIFT_S + (size_t)2 * 128 * 1024;
constexpr size_t O_CONV_S = O_WKV_S + (size_t)2 * 128 * 8 * 4096;
constexpr size_t O_END = O_CONV_S + (size_t)2 * 128 * 30 * 512;

constexpr int LDS_BYTES = 132 * 1024;

struct Params {
    const float *x_prompt, *x_sample, *c_prompt, *c_sample, *state_shift, *state_wkv, *state_conv;
    const float *w_ada, *b_ada, *g_pre, *g_post, *w_in, *mu, *w0, *w_up, *a0, *a_up, *k_k, *k_a, *r_k;
    const float *gn_r_g, *gn_r_b, *w_dw, *b_dw, *gn_c_g, *gn_c_b, *w_out;
    float* out;
    unsigned char* ws;
};

typedef unsigned u32x2 __attribute__((ext_vector_type(2)));
typedef unsigned u32x4 __attribute__((ext_vector_type(4)));
__device__ __forceinline__ void st16_wt(void* p, u32x4 v) { asm volatile("global_store_dwordx4 %0, %1, off sc1\n\ts_nop 1" :: "v"(p), "v"(v) : "memory"); }
__device__ __forceinline__ int tid_() { int t = threadIdx.x; asm volatile("" : "+v"(t)); return t; }
template <int CTRL>
__device__ __forceinline__ float dpp_mov(float v) {
    return __builtin_bit_cast(float, __builtin_amdgcn_update_dpp(0, __builtin_bit_cast(int, v), CTRL, 0xf, 0xf, false));
}
__device__ __forceinline__ float row_allreduce16(float v) {
    v += dpp_mov<0x128>(v);
    v += dpp_mov<0x124>(v);
    v += dpp_mov<0x122>(v);
    v += dpp_mov<0x121>(v);
    return v;
}
__device__ __forceinline__ float wave_sum(float v) {
    v = row_allreduce16(v);
    v += __shfl_xor(v, 16);
    v += __shfl_xor(v, 32);
    return v;
}
__device__ __forceinline__ float wave_sum_all(float v) {
    v = row_allreduce16(v);
    v += __builtin_bit_cast(float, __builtin_amdgcn_update_dpp(0, __builtin_bit_cast(int, v), 0x142, 0xa, 0xf, false));
    v += __builtin_bit_cast(float, __builtin_amdgcn_update_dpp(0, __builtin_bit_cast(int, v), 0x143, 0xc, 0xf, false));
    return __builtin_bit_cast(float, __builtin_amdgcn_readlane(__builtin_bit_cast(int, v), 63));
}
__device__ __forceinline__ float sigm(float x) { return __builtin_amdgcn_rcpf(1.f + __expf(-x)); }
__device__ __forceinline__ float silu(float x) { return x * __builtin_amdgcn_rcpf(1.f + __expf(-x)); }
__device__ __forceinline__ float silu2(float a, float b) { return (a * b) * __builtin_amdgcn_rcpf((1.f + __expf(-a)) * (1.f + __expf(-b))); }
__device__ __forceinline__ float tanh_fast(float x) { float t = __expf(2.f * x); return 1.f - 2.f * __builtin_amdgcn_rcpf(t + 1.f); }

__device__ __forceinline__ int seq_of(int tk) { return tk < NTOKP ? (tk >> 11) : 8 + ((tk - NTOKP) >> 2); }
__device__ __forceinline__ bool is_last_tok(int tk) { return tk < NTOKP ? ((tk & 2047) == 2047) : (((tk - NTOKP) & 3) == 3); }
__device__ __forceinline__ int prev_row(int tk) {
    if (tk < NTOKP) return (tk & 2047) ? tk - 1 : -1;
    int s = tk - NTOKP;
    return (s & 3) ? tk - 1 : NTOK + (s >> 2);
}
__device__ __forceinline__ const float* x0_row(const Params& p, int tk) {
    return tk < NTOKP ? p.x_prompt + (size_t)tk * D : p.x_sample + (size_t)(tk - NTOKP) * D;
}


#define XB_TMO      128
#define XB_XCNT(j)  (256  + 64 * (j))
#define XB_XSUB(j)  (1280 + 64 * (j))
#define XB_XGEN(j)  (2304 + 64 * (j))
#define XB_TOP      3328
#define XB_TOPGEN   3392
#define XCD_BAR_WORDS 3456
#define XB_SPIN_CAP (1u << 22)
#define LAS __attribute__((address_space(3)))
__device__ __forceinline__ unsigned xb_ld(unsigned* p)              { return __hip_atomic_load(p, __ATOMIC_RELAXED, __HIP_MEMORY_SCOPE_AGENT); }
__device__ __forceinline__ unsigned xb_add(unsigned* p, unsigned v) { return __hip_atomic_fetch_add(p, v, __ATOMIC_RELAXED, __HIP_MEMORY_SCOPE_AGENT); }
__device__ __forceinline__ unsigned xb_xcc_id() { return (unsigned)__builtin_amdgcn_s_getreg((3 << 11) | 20) & 0xFu; }
#define XB_SPIN(cond, bar) do { unsigned _sp = 0; while (cond) { __builtin_amdgcn_s_sleep(1); \
    if ((++_sp & 255u) == 0u) { if (xb_ld(&(bar)[XB_TMO])) break; if (_sp > XB_SPIN_CAP) { atomicAdd(&(bar)[XB_TMO], 1u); break; } } } } while (0)
struct XcdBarrier { unsigned* bar; unsigned x; volatile LAS unsigned* st; };
__device__ __forceinline__ XcdBarrier xcd_barrier_post(unsigned* bar, volatile LAS unsigned* st) {
    XcdBarrier b; b.bar = bar; b.x = xb_xcc_id(); b.st = st;
    if (threadIdx.x == 0) (void)xb_add(&bar[XB_XCNT(b.x)], 1u);
    return b;
}
__device__ __forceinline__ void xcd_barrier_complete(unsigned* bar, unsigned x, unsigned& nloc, unsigned& nx) {
    const unsigned G = gridDim.x * gridDim.y * gridDim.z;
    unsigned sum, cnt, mine, sp = 0u;
    for (;;) {
        sum = 0u; cnt = 0u; mine = 0u;
#pragma unroll
        for (unsigned j = 0; j < 16; ++j) { const unsigned c = xb_ld(&bar[XB_XCNT(j)]); sum += c; cnt += (c > 0u) ? 1u : 0u; mine = (j == x) ? c : mine; }
        if (sum == G) break;
        __builtin_amdgcn_s_sleep(1);
        if ((++sp & 255u) == 0u) { if (xb_ld(&bar[XB_TMO])) break; if (sp > XB_SPIN_CAP) { atomicAdd(&bar[XB_TMO], 1u); break; } }
    }
    nloc = mine > 0u ? mine : 1u; nx = cnt > 0u ? cnt : 1u;
}
__device__ __forceinline__ void xcd_barrier(const XcdBarrier& b) {
    asm volatile("s_waitcnt vmcnt(0)" ::: "memory");
    __syncthreads();
    if (threadIdx.x == 0) {
        unsigned* bar = b.bar;
        __builtin_amdgcn_s_waitcnt(0);
        unsigned nloc = b.st[0], nx = b.st[1];
        if (nloc == 0u) { xcd_barrier_complete(bar, b.x, nloc, nx); b.st[0] = nloc; b.st[1] = nx; }
        const unsigned old = xb_add(&bar[XB_XSUB(b.x)], 1u);
        const unsigned gen = old / nloc;
        if (old + 1u == (gen + 1u) * nloc) {
            __builtin_amdgcn_fence(__ATOMIC_RELEASE, "agent");
            asm volatile("s_waitcnt vmcnt(0)" ::: "memory");
            const unsigned og = xb_add(&bar[XB_TOP], 1u);
            const unsigned tg = og / nx;
            if (og + 1u == (tg + 1u) * nx) xb_add(&bar[XB_TOPGEN], 1u);
            else XB_SPIN(xb_ld(&bar[XB_TOPGEN]) == tg, bar);
            __builtin_amdgcn_fence(__ATOMIC_ACQUIRE, "agent");
            xb_add(&bar[XB_XGEN(b.x)], 1u);
            asm volatile("s_waitcnt vmcnt(0)" ::: "memory");
        } else {
            XB_SPIN(xb_ld(&bar[XB_XGEN(b.x)]) == gen, bar);
            __builtin_amdgcn_fence(__ATOMIC_ACQUIRE, "agent");
            asm volatile("s_waitcnt vmcnt(0)" ::: "memory");
        }
    }
    __syncthreads();
}

__device__ __forceinline__ void p0_transpose(const float* __restrict__ W, int K, int N, hf* __restrict__ WT, int item, float* lds) {
    const int nb = N / 64;
    const int kb = item / nb, nbk = item % nb, k0 = kb * 64, n0 = nbk * 64;
    const int tid = tid_();
#pragma unroll
    for (int i = 0; i < 8; ++i) {
        int kk = (tid >> 6) + 8 * i, c = tid & 63;
        lds[kk * 65 + c] = W[(size_t)(k0 + kk) * N + n0 + c];
    }
    __syncthreads();
    const int n = tid >> 3, kc = (tid & 7) * 8;
    hf8 o;
#pragma unroll
    for (int j = 0; j < 8; ++j) o[j] = (hf)lds[(kc + j) * 65 + n];
    *(hf8*)(WT + (size_t)(n0 + n) * K + k0 + kc) = o;
    __syncthreads();
}

__device__ __forceinline__ void p0_adaln(const Params& p, int item, unsigned char* smem) {
    hf* SC = (hf*)smem;
    hf* Wt = SC + 144 * 72;
    float* MOD = (float*)(p.ws + WS_MOD);
    const int gc0 = item * 32;
    const int l = gc0 / 3072, lc0 = gc0 % 3072;
    const float* W = p.w_ada + (size_t)l * 1024 * 3072;
    const int tid = tid_(), lane = tid & 63, wave = tid >> 6;
    const int nt = wave & 1, mg = wave >> 1;
    const int mt0 = (mg == 0) ? 0 : (2 * mg + 1);
    const int nmt = (mg == 0) ? 3 : 2;
    f32x4 acc[3];
#pragma unroll
    for (int i = 0; i < 3; ++i) acc[i] = (f32x4){0.f, 0.f, 0.f, 0.f};
    float cv[17], wv[4];
    auto gload = [&](int kt) {
        const int k0 = kt * 64;
#pragma unroll
        for (int i = 0; i < 17; ++i) {
            const int e = tid + 512 * i, row = e >> 6, k = e & 63;
            const float* cr = row < 8 ? p.c_prompt + row * 1024 : p.c_sample + (row - 8) * 1024;
            cv[i] = cr[k0 + k];
        }
#pragma unroll
        for (int i = 0; i < 4; ++i) {
            const int e = tid + 512 * i, kk = e >> 5, n = e & 31;
            wv[i] = W[(size_t)(k0 + kk) * 3072 + lc0 + n];
        }
    };
    gload(0);
    { int row = 136 + (tid >> 6), k = tid & 63; SC[row * 72 + k] = (hf)0.f; }
    for (int kt = 0; kt < 16; ++kt) {
#pragma unroll
        for (int i = 0; i < 17; ++i) {
            const int e = tid + 512 * i, row = e >> 6, k = e & 63;
            SC[row * 72 + k] = (hf)silu(cv[i]);
        }
#pragma unroll
        for (int i = 0; i < 4; ++i) {
            const int e = tid + 512 * i, kk = e >> 5, n = e & 31;
            Wt[n * 72 + kk] = (hf)wv[i];
        }
        __syncthreads();
        if (kt + 1 < 16) gload(kt + 1);
#pragma unroll
        for (int ks = 0; ks < 2; ++ks) {
            hf8 bfrag = *(const hf8*)(Wt + (nt * 16 + (lane & 15)) * 72 + ks * 32 + (lane >> 4) * 8);
#pragma unroll
            for (int i = 0; i < 3; ++i) {
                if (i < nmt) {
                    hf8 afrag = *(const hf8*)(SC + ((mt0 + i) * 16 + (lane & 15)) * 72 + ks * 32 + (lane >> 4) * 8);
                    acc[i] = __builtin_amdgcn_mfma_f32_16x16x32_f16(bfrag, afrag, acc[i], 0, 0, 0);
                }
            }
        }
        __syncthreads();
    }
#pragma unroll
    for (int i = 0; i < 3; ++i) {
        if (i < nmt) {
            int row = (mt0 + i) * 16 + (lane & 15);
            if (row < NSEQ) {
#pragma unroll
                for (int j = 0; j < 4; ++j) {
                    int gc = gc0 + nt * 16 + (lane >> 4) * 4 + j;
                    MOD[(size_t)row * 6144 + gc] = acc[i][j] + p.b_ada[gc];
                }
            }
        }
    }
}

__device__ __forceinline__ void phase0(const Params& p, unsigned char* smem) {
    constexpr int I_ADA = 192;
    constexpr int I_WIN = 16 * 58;
    constexpr int I_WOUT = 16 * 16;
    constexpr int I_LORA = 8;
    constexpr int NITEMS = I_ADA + 2 * (I_WIN + I_WOUT + 2 * I_LORA);
    constexpr int NTR = NITEMS - I_ADA;
    constexpr int EXTRA = 6;
    auto transpose_item = [&](int r) {
        const int l = r / (I_WIN + I_WOUT + 2 * I_LORA);
        r = r % (I_WIN + I_WOUT + 2 * I_LORA);
        float* lds = (float*)smem;
        if (r < I_WIN) { p0_transpose(p.w_in + (size_t)l * D * PIN, D, PIN, (hf*)(p.ws + WS_WTIN) + (size_t)l * PINP * D, r, lds); return; }
        r -= I_WIN;
        if (r < I_WOUT) { p0_transpose(p.w_out + (size_t)l * D * D, D, D, (hf*)(p.ws + WS_WTOUT) + (size_t)l * D * D, r, lds); return; }
        r -= I_WOUT;
        if (r < I_LORA) { p0_transpose(p.w_up + (size_t)l * 64 * 512, 64, 512, (hf*)(p.ws + WS_WUPT) + (size_t)l * 512 * 64, r, lds); return; }
        r -= I_LORA;
        p0_transpose(p.a_up + (size_t)l * 64 * 512, 64, 512, (hf*)(p.ws + WS_AUPT) + (size_t)l * 512 * 64, r, lds);
    };
    const int nb = gridDim.x, b = blockIdx.x;
    const int nfree = nb > I_ADA ? nb - I_ADA : 0;
    const int nextra = min(nfree * EXTRA, NTR);
    for (int it = b; it < I_ADA; it += nb) p0_adaln(p, it, smem);
    if (b >= I_ADA) for (int i = 0; i < EXTRA; ++i) { const int r = (b - I_ADA) + nfree * i; if (r < nextra) transpose_item(r); }
    for (int r = nextra + b; r < NTR; r += nb) transpose_item(r);
}

__device__ __forceinline__ void phase1(const Params& p, int l) {
    const int tid = tid_(); const int lane = tid & 63, wave = tid >> 6;
    hf* H = (hf*)(p.ws + WS_H);
    const float* MOD = (const float*)(p.ws + WS_MOD);
    auto coff = [&](int q) { return 512 * (q >> 1) + 8 * lane + 4 * (q & 1); };
    const int nfull = (NTOKP / ((int)gridDim.x * 8)) * ((int)gridDim.x * 8);
    const int nrounds = nfull / ((int)gridDim.x * 8);
    for (int it = 0; it <= nrounds; ++it) {
        int tk;
        if (it < nrounds) tk = blockIdx.x * 8 + wave + it * (int)gridDim.x * 8;
        else {
            const int e = wave * (int)gridDim.x + blockIdx.x;
            if (e >= MROWS - nfull) break;
            tk = nfull + e;
        }
        if (tk >= NTOK) {
            const int bs = tk - NTOK;
            const float* s = p.state_shift + ((size_t)l * 128 + bs) * D;
#pragma unroll
            for (int j = 0; j < 2; ++j) {
                const f32x4 v0 = *(const f32x4*)(s + coff(2 * j)), v1 = *(const f32x4*)(s + coff(2 * j + 1));
                const hf8 o = {(hf)v0.x, (hf)v0.y, (hf)v0.z, (hf)v0.w, (hf)v1.x, (hf)v1.y, (hf)v1.z, (hf)v1.w};
                st16_wt(H + (size_t)tk * D + coff(2 * j), __builtin_bit_cast(u32x4, o));
            }
            continue;
        }
        const int sq = seq_of(tk);
        const float* xr = x0_row(p, tk);
        f32x4 x[4];
#pragma unroll
        for (int q = 0; q < 4; ++q) x[q] = *(const f32x4*)(xr + coff(q));
        if (l == 1) {
            const hf* mo = (const hf*)(p.out + O_Y + (size_t)tk * D);
            f32x4 m[4];
            float ss = 0.f;
#pragma unroll
            for (int q = 0; q < 4; ++q) {
                hf4 t = *(const hf4*)(mo + coff(q));
                m[q] = (f32x4){(float)t.x, (float)t.y, (float)t.z, (float)t.w};
                ss += m[q].x * m[q].x + m[q].y * m[q].y + m[q].z * m[q].z + m[q].w * m[q].w;
            }
            const float rs = rsqrtf(wave_sum_all(ss) * (1.f / D) + 1e-6f);
#pragma unroll
            for (int q = 0; q < 4; ++q) {
                f32x4 gp = *(const f32x4*)(p.g_post + coff(q));
                f32x4 gt = *(const f32x4*)(MOD + (size_t)sq * 6144 + 2048 + coff(q));
                x[q] = x[q] + gt * (m[q] * rs * gp);
            }
        }
        float ss = 0.f;
#pragma unroll
        for (int q = 0; q < 4; ++q) ss += x[q].x * x[q].x + x[q].y * x[q].y + x[q].z * x[q].z + x[q].w * x[q].w;
        const float rs = rsqrtf(wave_sum_all(ss) * (1.f / D) + 1e-6f);
        const bool last = is_last_tok(tk);
        float* so = nullptr;
        if (last) so = (sq < 8) ? p.out + O_SHIFT_P + ((size_t)l * 8 + sq) * D : p.out + O_SHIFT_S + ((size_t)l * 128 + (sq - 8)) * D;
        f32x4 h[4];
#pragma unroll
        for (int q = 0; q < 4; ++q) {
            f32x4 g = *(const f32x4*)(p.g_pre + (size_t)l * D + coff(q));
            f32x4 sh = *(const f32x4*)(MOD + (size_t)sq * 6144 + l * 3072 + coff(q));
            f32x4 sc = *(const f32x4*)(MOD + (size_t)sq * 6144 + l * 3072 + 1024 + coff(q));
            h[q] = (x[q] * rs * g) * (1.f + sc) + sh;
            if (last) *(f32x4*)(so + coff(q)) = h[q];
        }
#pragma unroll
        for (int j = 0; j < 2; ++j) {
            const f32x4 v0 = h[2 * j], v1 = h[2 * j + 1];
            const hf8 o = {(hf)v0.x, (hf)v0.y, (hf)v0.z, (hf)v0.w, (hf)v1.x, (hf)v1.y, (hf)v1.z, (hf)v1.w};
            st16_wt(H + (size_t)tk * D + coff(2 * j), __builtin_bit_cast(u32x4, o));
        }
    }
}

constexpr int G_BM = 256, G_BN = 128, G_BK = 64, G_LD = 72;
constexpr int G_ASZ = G_BM * G_LD, G_BSZ = G_BN * G_LD;
template <int EPI>
__device__ __forceinline__ void gemm_tile(const hf* __restrict__ A, const hf* __restrict__ Bt, hf* __restrict__ C, int m0, int n0, int mlimit, int ldc, unsigned char* smem) {
    hf* As = (hf*)smem;
    hf* Bs = As + 2 * G_ASZ;
    const int tid = tid_(), lane = tid & 63, wave = tid >> 6;
    const int wm = wave >> 1, wn = wave & 1;
    const int fr = lane & 15, fq = lane >> 4;
    f32x4 acc[4][4];
#pragma unroll
    for (int i = 0; i < 4; ++i)
#pragma unroll
        for (int j = 0; j < 4; ++j) acc[i][j] = (f32x4){0.f, 0.f, 0.f, 0.f};
    hf8 ra[4], rb[2];
    const int lrow = tid >> 3, lkc = (tid & 7) * 8;
    auto gload = [&](int kt) {
#pragma unroll
        for (int i = 0; i < 4; ++i) ra[i] = *(const hf8*)(A + (size_t)(m0 + lrow + 64 * i) * D + kt * G_BK + lkc);
#pragma unroll
        for (int i = 0; i < 2; ++i) rb[i] = *(const hf8*)(Bt + (size_t)(n0 + lrow + 64 * i) * D + kt * G_BK + lkc);
    };
    auto lstore = [&](int buf) {
#pragma unroll
        for (int i = 0; i < 4; ++i) *(hf8*)(As + buf * G_ASZ + (lrow + 64 * i) * G_LD + lkc) = ra[i];
#pragma unroll
        for (int i = 0; i < 2; ++i) *(hf8*)(Bs + buf * G_BSZ + (lrow + 64 * i) * G_LD + lkc) = rb[i];
    };
    gload(0);
    lstore(0);
    __syncthreads();
    constexpr int NKT = D / G_BK;
    for (int kt = 0; kt < NKT; ++kt) {
        const int buf = kt & 1;
        if (kt + 1 < NKT) gload(kt + 1);
        const hf* as = As + buf * G_ASZ + (wm * 64 + fr) * G_LD + fq * 8;
        const hf* bs = Bs + buf * G_BSZ + (wn * 64 + fr) * G_LD + fq * 8;
#pragma unroll
        for (int ks = 0; ks < 2; ++ks) {
            hf8 af[4], bf[4];
#pragma unroll
            for (int i = 0; i < 4; ++i) af[i] = *(const hf8*)(as + i * 16 * G_LD + ks * 32);
#pragma unroll
            for (int i = 0; i < 4; ++i) bf[i] = *(const hf8*)(bs + i * 16 * G_LD + ks * 32);
#pragma unroll
            for (int i = 0; i < 4; ++i)
#pragma unroll
                for (int j = 0; j < 4; ++j)
                    acc[i][j] = __builtin_amdgcn_mfma_f32_16x16x32_f16(bf[j], af[i], acc[i][j], 0, 0, 0);
        }
        if (kt + 1 < NKT) lstore(buf ^ 1);
        __syncthreads();
    }
#pragma unroll
    for (int i = 0; i < 4; ++i) {
        const int row = m0 + wm * 64 + i * 16 + fr;
        if (row < mlimit) {
#pragma unroll
            for (int j = 0; j < 4; ++j) {
                const int col = n0 + wn * 64 + j * 16 + fq * 4;
                hf4 o = {(hf)acc[i][j][0], (hf)acc[i][j][1], (hf)acc[i][j][2], (hf)acc[i][j][3]};
                *(hf4*)(C + (size_t)row * ldc + col) = o;
            }
        }
    }
}

constexpr int Q_BM = 256, Q_BK = 64, Q_HALF = 128, Q_NXCD = 8, Q_WGM = 8, Q_HT = Q_HALF * Q_BK;
__device__ __forceinline__ int q_lds_byte(int r, int c) {
    int st = (r >> 4) * 2 + (c >> 5), rr = r & 15, cc = c & 31, ob = rr * 64 + cc * 2;
    return st * 1024 + (ob ^ (((ob >> 9) & 1) << 5));
}
__device__ __forceinline__ void q_stage_rc(int b, int& R, int& C) {
    int st = b / 1024, sb = b % 1024, swz = sb ^ (((sb >> 9) & 1) << 5);
    R = (st >> 1) * 16 + swz / 64; C = (st & 1) * 32 + (swz % 64) / 2;
}
__device__ __forceinline__ void q_tile_of(int wgid, int nM, int nN, int& pm, int& pn) {
    const int nwg = nM * nN;
    { const int q = nwg / Q_NXCD, r = nwg % Q_NXCD, xcd = wgid % Q_NXCD, off = wgid / Q_NXCD; wgid = (xcd < r ? xcd * (q + 1) : r * (q + 1) + (xcd - r) * q) + off; }
    const int nig = Q_WGM * nN, gid = wgid / nig, fm = gid * Q_WGM, gsz = min(nM - fm, Q_WGM);
    pm = fm + ((wgid % nig) % gsz); pn = (wgid % nig) / gsz;
}
__device__ __forceinline__ void gemm256(const hf* __restrict__ A, const hf* __restrict__ Bt, hf* __restrict__ C, int brow, int bcol, int mlimit, int nlimit, int ldc, unsigned char* smem) {
    constexpr int K = D;
    hf* shm = (hf*)smem;
    const int qtid = tid_();
#define SA(b,h) (shm+((b)*2+(h))*Q_HT)
#define SB(b,h) (shm+(4+(b)*2+(h))*Q_HT)
#define STAGE(P,BASE,br,kt) do{const char* _gb=(const char*)((BASE)+(long)(br)*K+(long)(kt)*Q_BK); \
    __builtin_amdgcn_global_load_lds((const unsigned*)(_gb+so0),(unsigned*)((char*)(P)+qtid*16),16,0,0); \
    __builtin_amdgcn_global_load_lds((const unsigned*)(_gb+so1),(unsigned*)((char*)(P)+qtid*16+8192),16,0,0);}while(0)
#define LDA(dst,b,h) _Pragma("unroll") for(int m=0;m<4;++m) _Pragma("unroll") for(int k=0;k<2;++k) \
    dst[m][k]=*reinterpret_cast<const hf8*>((char*)SA(b,h)+q_lds_byte(wr*64+m*16+fr,k*32+fq*8))
#define LDB(dst,b,h) _Pragma("unroll") for(int n=0;n<2;++n) _Pragma("unroll") for(int k=0;k<2;++k) \
    dst[n][k]=*reinterpret_cast<const hf8*>((char*)SB(b,h)+q_lds_byte(wc*32+n*16+fr,k*32+fq*8))
#define MMA(ai,bj,At,Bt_) do{__builtin_amdgcn_s_setprio(1); \
    _Pragma("unroll") for(int m=0;m<4;++m) _Pragma("unroll") for(int n=0;n<2;++n) _Pragma("unroll") for(int k=0;k<2;++k) \
      acc[ai][bj][m][n]=__builtin_amdgcn_mfma_f32_16x16x32_f16(Bt_[n][k],At[m][k],acc[ai][bj][m][n],0,0,0); \
    __builtin_amdgcn_s_setprio(0);}while(0)
#define WAIT_V(n) asm volatile("s_waitcnt vmcnt(" #n ")":::"memory")
#define WAIT_L(n) asm volatile("s_waitcnt lgkmcnt(" #n ")":::"memory")
#define BAR __builtin_amdgcn_s_barrier()
#define SCHED __builtin_amdgcn_sched_barrier(0)
    const int wid = qtid >> 6, lane = qtid & 63, wr = wid >> 2, wc = wid & 3, fr = lane & 15, fq = lane >> 4;
    unsigned so0, so1;
    { int r_, c_; q_stage_rc(qtid * 16, r_, c_); so0 = (unsigned)(r_ * K + c_) * 2u; q_stage_rc(qtid * 16 + 8192, r_, c_); so1 = (unsigned)(r_ * K + c_) * 2u; }
    f32x4 acc[2][2][4][2] = {};
    hf8 At[4][2], B0[2][2], B1[2][2];
    constexpr int nt = K / Q_BK;
    STAGE(SB(0,0),Bt,bcol,0); STAGE(SA(0,0),A,brow,0);
    STAGE(SB(0,1),Bt,bcol+Q_HALF,0); STAGE(SA(0,1),A,brow+Q_HALF,0);
    if(wr==1)BAR;
    WAIT_V(4); BAR;
    STAGE(SB(1,0),Bt,bcol,1); STAGE(SA(1,0),A,brow,1); STAGE(SB(1,1),Bt,bcol+Q_HALF,1);
    WAIT_V(6); BAR;
    for(int t=0;t<nt-2;t+=2){
        LDB(B0,0,0); SCHED; LDA(At,0,0); STAGE(SA(1,1),A,brow+Q_HALF,t+1);
        WAIT_L(8); BAR; WAIT_L(0); MMA(0,0,At,B0); BAR; SCHED;
        LDB(B1,0,1); STAGE(SB(0,0),Bt,bcol,t+2);
        BAR; WAIT_L(0); MMA(0,1,At,B1); BAR;
        LDA(At,0,1); STAGE(SA(0,0),A,brow,t+2);
        BAR; WAIT_L(0); MMA(1,0,At,B0); BAR; SCHED;
        STAGE(SB(0,1),Bt,bcol+Q_HALF,t+2);
        WAIT_V(6); BAR; MMA(1,1,At,B1); BAR;
        LDB(B0,1,0); SCHED; LDA(At,1,0); STAGE(SA(0,1),A,brow+Q_HALF,t+2);
        WAIT_L(8); BAR; WAIT_L(0); MMA(0,0,At,B0); BAR; SCHED;
        LDB(B1,1,1); STAGE(SB(1,0),Bt,bcol,t+3);
        BAR; WAIT_L(0); MMA(0,1,At,B1); BAR;
        LDA(At,1,1); STAGE(SA(1,0),A,brow,t+3);
        BAR; WAIT_L(0); MMA(1,0,At,B0); BAR; SCHED;
        STAGE(SB(1,1),Bt,bcol+Q_HALF,t+3);
        WAIT_V(6); BAR; MMA(1,1,At,B1); BAR;
    }
    { LDB(B0,0,0); LDA(At,0,0); STAGE(SA(1,1),A,brow+Q_HALF,nt-1);
      BAR; WAIT_L(0); MMA(0,0,At,B0); BAR;
      LDB(B1,0,1); BAR; WAIT_L(0); MMA(0,1,At,B1); BAR;
      LDA(At,0,1); WAIT_V(4); BAR; WAIT_L(0); MMA(1,0,At,B0); MMA(1,1,At,B1); BAR; }
    { LDB(B0,1,0); LDA(At,1,0); WAIT_V(2); BAR; WAIT_L(0); MMA(0,0,At,B0); BAR;
      LDB(B1,1,1); WAIT_V(0); BAR; WAIT_L(0); MMA(0,1,At,B1); BAR;
      LDA(At,1,1); BAR; WAIT_L(0); MMA(1,0,At,B0); MMA(1,1,At,B1); BAR; }
    if(wr==0)BAR;
#pragma unroll
    for(int ai=0;ai<2;++ai)
#pragma unroll
    for(int bj=0;bj<2;++bj)
#pragma unroll
    for(int m=0;m<4;++m){
        const int row = brow+ai*Q_HALF+wr*64+m*16+fr;
        const f32x4 a = acc[ai][bj][m][0], b = acc[ai][bj][m][1];
        const hf4 ha = {(hf)a[0], (hf)a[1], (hf)a[2], (hf)a[3]}, hb = {(hf)b[0], (hf)b[1], (hf)b[2], (hf)b[3]};
        const u32x2 ua = __builtin_bit_cast(u32x2, ha), ub = __builtin_bit_cast(u32x2, hb);
        const auto r0 = __builtin_amdgcn_permlane16_swap(ua.x, ub.x, false, false);
        const auto r1 = __builtin_amdgcn_permlane16_swap(ua.y, ub.y, false, false);
        const u32x4 o = {r0[0], r1[0], r0[1], r1[1]};
        const int col = bcol+bj*Q_HALF+wc*32 + ((fq & 1) ? 16 + (fq - 1) * 4 : fq * 4);
        if (row < mlimit && col < nlimit) {
            st16_wt(C + (size_t)row * ldc + col, o);
        }
    }
    __syncthreads();
#undef SA
#undef SB
#undef STAGE
#undef LDA
#undef LDB
#undef MMA
#undef WAIT_V
#undef WAIT_L
#undef BAR
#undef SCHED
}

__device__ __forceinline__ void phase2(const Params& p, int l, unsigned char* smem) {
    const hf* A = (const hf*)(p.ws + WS_H);
    const hf* Bt = (const hf*)(p.ws + WS_WTIN) + (size_t)l * PINP * D;
    hf* U = (hf*)(p.ws + WS_U);
    constexpr int NMT = MPAD / 256, NNT = PINP / 256;
    for (int t = blockIdx.x; t < NMT * NNT; t += gridDim.x) {
        int pm, pn;
        q_tile_of(t, NMT, NNT, pm, pn);
        gemm256(A, Bt, U, pm * 256, pn * 256, MROWS, PIN, PIN, smem);
    }
}
__device__ __forceinline__ void phase5b(const Params& p, int l, unsigned char* smem) {
    const hf* A = (const hf*)(p.ws + WS_MIX);
    const hf* Bt = (const hf*)(p.ws + WS_WTOUT) + (size_t)l * D * D;
    hf* C = (hf*)(p.out + O_Y) + l * 1024;
    for (int t = blockIdx.x; t < 64 * 4; t += gridDim.x) {
        int pm, pn;
        q_tile_of(t, 64, 4, pm, pn);
        gemm256(A, Bt, C, pm * 256, pn * 256, NTOK, D, 2048, smem);
    }
    for (int t = blockIdx.x; t < 256; t += gridDim.x) {
        const int tid = tid_(), lane = tid & 63, wave = tid >> 6;
        const int fr = lane & 15, fq = lane >> 4;
        const int m0 = 16384 + (t >> 5) * 64 + (wave >> 1) * 16, n0 = (t & 31) * 32 + (wave & 1) * 16;
        const hf* ap = A + (size_t)(m0 + fr) * D + fq * 8;
        const hf* bp = Bt + (size_t)(n0 + fr) * D + fq * 8;
        f32x4 acc0 = {0.f, 0.f, 0.f, 0.f}, acc1 = {0.f, 0.f, 0.f, 0.f};
#pragma unroll 4
        for (int k = 0; k < D; k += 64) {
            const hf8 a0 = *(const hf8*)(ap + k), b0 = *(const hf8*)(bp + k);
            const hf8 a1 = *(const hf8*)(ap + k + 32), b1 = *(const hf8*)(bp + k + 32);
            acc0 = __builtin_amdgcn_mfma_f32_16x16x32_f16(b0, a0, acc0, 0, 0, 0);
            acc1 = __builtin_amdgcn_mfma_f32_16x16x32_f16(b1, a1, acc1, 0, 0, 0);
        }
        const f32x4 a = acc0 + acc1;
        hf4 o = {(hf)a[0], (hf)a[1], (hf)a[2], (hf)a[3]};
        *(hf4*)(C + (size_t)(m0 + fr) * 2048 + n0 + fq * 4) = o;
    }
}

__device__ __forceinline__ void p3_lora(const Params& p, int l, int witem, int h0, int h1) {
    const int lane = tid_() & 63;
    const int fr = lane & 15, fq = lane >> 4;
    const hf* U = (const hf*)(p.ws + WS_U);
    hf* EA = (hf*)(p.ws + WS_EA);
    hf* KKB = (hf*)(p.ws + WS_H);
    const hf* WupT = (const hf*)(p.ws + WS_WUPT) + (size_t)l * 512 * 64;
    const hf* AupT = (const hf*)(p.ws + WS_AUPT) + (size_t)l * 512 * 64;
    const float* mu = p.mu + (size_t)l * PRW;
    const int tk = witem * 16 + fr;
    const int pr = prev_row(tk);
    const float pm = pr >= 0 ? 1.f : 0.f;
    const hf* ut = U + (size_t)tk * PIN;
    const hf* up = U + (size_t)(pr >= 0 ? pr : 0) * PIN;
    hf8 aw[2], aa[2];
#pragma unroll
    for (int ks = 0; ks < 2; ++ks) {
        const int kb = ks * 32 + fq * 8;
        const hf8 cw = *(const hf8*)(ut + 2048 + kb), ca = *(const hf8*)(ut + 2112 + kb);
        const hf8 pw = *(const hf8*)(up + 2048 + kb), pa = *(const hf8*)(up + 2112 + kb);
#pragma unroll
        for (int j = 0; j < 8; ++j) {
            float c = (float)cw[j], q = (float)pw[j] * pm;
            aw[ks][j] = (hf)tanh_fast(c + (q - c) * mu[2048 + kb + j]);
            c = (float)ca[j]; q = (float)pa[j] * pm;
            aa[ks][j] = (hf)(c + (q - c) * mu[2112 + kb + j]);
        }
    }
    auto store_pair = [&](hf* base, int n0, hf4 t0, hf4 t1) {
        const u32x2 ua = __builtin_bit_cast(u32x2, t0), ub = __builtin_bit_cast(u32x2, t1);
        const auto r0 = __builtin_amdgcn_permlane16_swap(ua.x, ub.x, false, false);
        const auto r1 = __builtin_amdgcn_permlane16_swap(ua.y, ub.y, false, false);
        const u32x4 o = {r0[0], r1[0], r0[1], r1[1]};
        const int col = n0 + ((fq & 1) ? 16 + (fq - 1) * 4 : fq * 4);
        st16_wt(base + (size_t)tk * D + col, o);
    };
    for (int h = h0; h < h1; ++h) {
        f32x4 av[4], kv[4];
        hf4 eo[4], ao[4];
        float ss = 0.f;
#pragma unroll
        for (int nt = 0; nt < 4; ++nt) {
            const int n0 = h * 64 + nt * 16;
            f32x4 cw = {0.f, 0.f, 0.f, 0.f}, ca = {0.f, 0.f, 0.f, 0.f};
#pragma unroll
            for (int ks = 0; ks < 2; ++ks) {
                const hf8 bw = *(const hf8*)(WupT + (size_t)(n0 + fr) * 64 + ks * 32 + fq * 8);
                const hf8 ba = *(const hf8*)(AupT + (size_t)(n0 + fr) * 64 + ks * 32 + fq * 8);
                cw = __builtin_amdgcn_mfma_f32_16x16x32_f16(bw, aw[ks], cw, 0, 0, 0);
                ca = __builtin_amdgcn_mfma_f32_16x16x32_f16(ba, aa[ks], ca, 0, 0, 0);
            }
            const int col = n0 + fq * 4;
            const f32x4 w0c = *(const f32x4*)(p.w0 + l * 512 + col), a0c = *(const f32x4*)(p.a0 + l * 512 + col);
            const f32x4 kkc = *(const f32x4*)(p.k_k + l * 512 + col), muk = *(const f32x4*)(mu + 512 + col), kac = *(const f32x4*)(p.k_a + l * 512 + col);
            const hf4 kc4 = *(const hf4*)(ut + 512 + col), kp4 = *(const hf4*)(up + 512 + col);
            const f32x4 kcf = {(float)kc4.x, (float)kc4.y, (float)kc4.z, (float)kc4.w};
            const f32x4 kpf = (f32x4){(float)kp4.x, (float)kp4.y, (float)kp4.z, (float)kp4.w} * pm;
            const f32x4 kl = kcf + (kpf - kcf) * muk;
            const f32x4 xe = w0c + cw, xa = a0c + ca;
            f32x4 e4, a4;
            e4.x = sigm(xe.x); e4.y = sigm(xe.y); e4.z = sigm(xe.z); e4.w = sigm(xe.w);
            a4.x = sigm(xa.x); a4.y = sigm(xa.y); a4.z = sigm(xa.z); a4.w = sigm(xa.w);
            e4 = e4 * 0.60653066f;
            const f32x4 km = kl * (1.f + (a4 - 1.f) * kac);
            const f32x4 kkr = kl * kkc;
            eo[nt] = (hf4){(hf)e4.x, (hf)e4.y, (hf)e4.z, (hf)e4.w};
            ao[nt] = (hf4){(hf)km.x, (hf)km.y, (hf)km.z, (hf)km.w};
            av[nt] = a4; kv[nt] = kkr;
            const f32x4 k2 = kkr * kkr;
            ss += (k2.x + k2.y) + (k2.z + k2.w);
        }
        store_pair(EA, h * 64, eo[0], eo[1]);
        store_pair(EA, h * 64 + 32, eo[2], eo[3]);
        store_pair(EA + 512, h * 64, ao[0], ao[1]);
        store_pair(EA + 512, h * 64 + 32, ao[2], ao[3]);
        ss += __shfl_xor(ss, 16);
        ss += __shfl_xor(ss, 32);
        const float inv = 1.f / fmaxf(sqrtf(ss), 1e-12f);
        hf4 ko[4], bo[4];
#pragma unroll
        for (int nt = 0; nt < 4; ++nt) {
#pragma unroll
            for (int j = 0; j < 4; ++j) { const float kk = kv[nt][j] * inv; ko[nt][j] = (hf)kk; bo[nt][j] = (hf)(kk * av[nt][j]); }
        }
        store_pair(KKB, h * 64, ko[0], ko[1]);
        store_pair(KKB, h * 64 + 32, ko[2], ko[3]);
        store_pair(KKB + 512, h * 64, bo[0], bo[1]);
        store_pair(KKB + 512, h * 64 + 32, bo[2], bo[3]);
    }
}

template <int NT>
__device__ __forceinline__ void conv_taps(const float* G, const float* w, float bias, float* acc) {
    typedef float cf2 __attribute__((ext_vector_type(2)));
    cf2 W2[32];
#pragma unroll
    for (int j = 0; j < 32; ++j) W2[j] = (cf2){j < 31 ? w[j] : 0.f, j > 0 ? w[j - 1] : 0.f};
    cf2 ap[NT / 2];
#pragma unroll
    for (int pi = 0; pi < NT / 2; ++pi) ap[pi] = (cf2){bias, bias};
#pragma unroll
    for (int r = 0; r < NT + 30; ++r) {
        const float g = G[r * 64];
        const cf2 gg = {g, g};
#pragma unroll
        for (int pi = 0; pi < NT / 2; ++pi) {
            const int j = r - 2 * pi;
            if (j >= 0 && j <= 31) ap[pi] = gg * W2[j] + ap[pi];
        }
    }
#pragma unroll
    for (int pi = 0; pi < NT / 2; ++pi) { acc[2 * pi] = ap[pi].x; acc[2 * pi + 1] = ap[pi].y; }
}

__device__ __forceinline__ void p3_conv_prompt(const Params& p, int l, int item, unsigned char* smem) {
    float* G = (float*)smem;
    hf* T = (hf*)(smem + 286 * 64 * 4) + (tid_() >> 6) * 512;
    const int g = item & 7, tt = (item >> 3) & 7, b = item >> 6;
    const int c0 = g * 64, t0 = tt * 256;
    const hf* U = (const hf*)(p.ws + WS_U);
    hf* MIX = (hf*)(p.ws + WS_MIX);
    const int tid = tid_();
    const int c = tid & 63, tq = tid >> 6;
    const int ch = c0 + c;
    float w[31];
#pragma unroll
    for (int j = 0; j < 31; ++j) w[j] = p.w_dw[((size_t)l * 31 + j) * 512 + ch];
    const float bias = p.b_dw[l * 512 + ch], gg = p.gn_c_g[l * 512 + ch], gb = p.gn_c_b[l * 512 + ch];
    hf gcv[32];
#pragma unroll
    for (int i = 0; i < 32; ++i) gcv[i] = U[(size_t)(b * 2048 + t0 + tq * 32 + i) * PIN + PRW + 1024 + ch];
    {
        hf2 ua[18], ub[18];
#pragma unroll
        for (int i = 0; i < 18; ++i) {
            const int e = min(tid + NTHR * i, 286 * 32 - 1);
            const int r = e >> 5, cp = (e & 31) * 2;
            const int t = max(t0 - 30 + r, 0);
            const hf* u = U + (size_t)(b * 2048 + t) * PIN + PRW + c0 + cp;
            ua[i] = *(const hf2*)u; ub[i] = *(const hf2*)(u + 512);
        }
#pragma unroll
        for (int i = 0; i < 18; ++i) {
            const int e = tid + NTHR * i;
            if (e < 286 * 32) {
                const int r = e >> 5, cp = (e & 31) * 2;
                const float m = (t0 - 30 + r) >= 0 ? 1.f : 0.f;
                G[r * 64 + cp] = m * (float)ua[i].x * sigm((float)ub[i].x);
                G[r * 64 + cp + 1] = m * (float)ua[i].y * sigm((float)ub[i].y);
            }
        }
    }
    __syncthreads();
#pragma unroll
    for (int sub = 0; sub < 4; ++sub) {
        const int tl = tq * 32 + sub * 8;
        float acc[8];
        conv_taps<8>(G + tl * 64 + c, w, bias, acc);
#pragma unroll
        for (int i = 0; i < 8; ++i) {
            const int tk = b * 2048 + t0 + tl + i;
            const float mean = wave_sum_all(acc[i]) * (1.f / 64.f);
            const float var = fmaxf(wave_sum_all(acc[i] * acc[i]) * (1.f / 64.f) - mean * mean, 0.f);
            const float yn = (acc[i] - mean) * rsqrtf(var + 1e-5f) * gg + gb;
            (void)tk;
            T[i * 64 + c] = (hf)silu2(yn, (float)gcv[sub * 8 + i]);
        }
        asm volatile("s_waitcnt lgkmcnt(0)" ::: "memory");
        {
            const int lane = tid & 63, tok = lane >> 3, ch8 = (lane & 7) * 8;
            const u32x4 v = *(const u32x4*)(T + tok * 64 + ch8);
            st16_wt(MIX + (size_t)(b * 2048 + t0 + tl + tok) * D + 512 + c0 + ch8, v);
        }
        asm volatile("s_waitcnt lgkmcnt(0)" ::: "memory");
    }
    if (tt == 7) {
        float* oc = p.out + O_CONV_P + ((size_t)l * 8 + b) * 30 * 512;
        for (int e = tid; e < 30 * 64; e += NTHR) {
            const int r = e >> 6, cc = e & 63;
            oc[(size_t)r * 512 + c0 + cc] = G[(256 + r) * 64 + cc];
        }
    }
    __syncthreads();
}

__device__ __forceinline__ void p3_conv_sample(const Params& p, int l, int item, unsigned char* smem) {
    float* G = (float*)smem;
    const int g = item & 7, s0 = (item >> 3) * 4;
    const int c0 = g * 64;
    const hf* U = (const hf*)(p.ws + WS_U);
    hf* MIX = (hf*)(p.ws + WS_MIX);
    const int tid = tid_();
    {
        float hv[15];
        hf ga[2], gbv[2];
#pragma unroll
        for (int i = 0; i < 15; ++i) {
            const int e = tid + NTHR * i, cc = e & 63, rr = (e >> 6) % 30, sl = (e >> 6) / 30;
            hv[i] = p.state_conv[(((size_t)l * 128 + s0 + sl) * 30 + rr) * 512 + c0 + cc];
        }
#pragma unroll
        for (int i = 0; i < 2; ++i) {
            const int e = tid + NTHR * i, cc = e & 63, tt = (e >> 6) & 3, sl = e >> 8;
            const hf* u = U + (size_t)(NTOKP + (s0 + sl) * 4 + tt) * PIN + PRW + c0 + cc;
            ga[i] = u[0]; gbv[i] = u[512];
        }
#pragma unroll
        for (int i = 0; i < 15; ++i) {
            const int e = tid + NTHR * i, cc = e & 63, rr = (e >> 6) % 30, sl = (e >> 6) / 30;
            G[(sl * 34 + rr) * 64 + cc] = hv[i];
        }
#pragma unroll
        for (int i = 0; i < 2; ++i) {
            const int e = tid + NTHR * i, cc = e & 63, tt = (e >> 6) & 3, sl = e >> 8;
            G[(sl * 34 + 30 + tt) * 64 + cc] = (float)ga[i] * sigm((float)gbv[i]);
        }
    }
    const int c = tid & 63, wv = tid >> 6;
    const int sl = wv >> 1, tp = (wv & 1) * 2;
    const int ch = c0 + c, bs = s0 + sl;
    float w[31];
#pragma unroll
    for (int j = 0; j < 31; ++j) w[j] = p.w_dw[((size_t)l * 31 + j) * 512 + ch];
    hf gcs[2];
#pragma unroll
    for (int i = 0; i < 2; ++i) gcs[i] = U[(size_t)(NTOKP + bs * 4 + tp + i) * PIN + PRW + 1024 + ch];
    __syncthreads();
    float acc[2];
    conv_taps<2>(G + (sl * 34 + tp) * 64 + c, w, p.b_dw[l * 512 + ch], acc);
    const float gg = p.gn_c_g[l * 512 + ch], gb = p.gn_c_b[l * 512 + ch];
#pragma unroll
    for (int i = 0; i < 2; ++i) {
        const int tk = NTOKP + bs * 4 + tp + i;
        const float mean = wave_sum(acc[i]) * (1.f / 64.f);
        const float d = acc[i] - mean;
        const float var = wave_sum(d * d) * (1.f / 64.f);
        const float yn = d * rsqrtf(var + 1e-5f) * gg + gb;
        MIX[(size_t)tk * D + 512 + ch] = (hf)silu2(yn, (float)gcs[i]);
    }
#pragma unroll
    for (int e = tid; e < 4 * 30 * 64; e += NTHR) {
        const int cc = e & 63, r = (e >> 6) % 30, s2 = (e >> 6) / 30;
        p.out[O_CONV_S + (((size_t)l * 128 + s0 + s2) * 30 + r) * 512 + c0 + cc] = G[(s2 * 34 + 4 + r) * 64 + cc];
    }
    __syncthreads();
}

__device__ __forceinline__ void phase3(const Params& p, int l, unsigned char* smem) {
    constexpr int W_LORA = NTOK / 16;
    constexpr int I_CP = 8 * 8 * 8;
    constexpr int I_CS = 32 * 8;
    {
        const int wave = tid_() >> 6;
        if (wave < 4) {
            const int wi = blockIdx.x + gridDim.x * wave;
            if (wi < W_LORA) p3_lora(p, l, wi, 0, 8);
        } else if (wave == 4) {
            const int piece = blockIdx.x;
            const int wi = 4 * (int)gridDim.x + (piece >> 3), hh = piece & 7;
            if (wi < W_LORA) p3_lora(p, l, wi, hh, hh + 1);
        }
    }
    for (int it = blockIdx.x; it < I_CP + I_CS; it += gridDim.x) {
        if (it < I_CP) p3_conv_prompt(p, l, it, smem);
        else p3_conv_sample(p, l, it - I_CP, smem);
    }
}

typedef float f32x2 __attribute__((ext_vector_type(2)));
struct WkvS { f32x2 lo, hi; };
__device__ __forceinline__ void wkv_step(WkvS& S, const float* op, float v, float& y) {
    const f32x4 r4 = *(const f32x4*)(op + 0 * 64);
    const f32x4 w4 = *(const f32x4*)(op + 1 * 64);
    const f32x4 m4 = *(const f32x4*)(op + 2 * 64);
    const f32x4 k4 = *(const f32x4*)(op + 3 * 64);
    const f32x4 b4 = *(const f32x4*)(op + 4 * 64);
    f32x2 d = S.lo * k4.lo + S.hi * k4.hi;
    const float sk = row_allreduce16(d.x + d.y);
    const f32x2 nsk = {-sk, -sk}, vv = {v, v};
    S.lo = vv * m4.lo + (nsk * b4.lo + S.lo * w4.lo);
    S.hi = vv * m4.hi + (nsk * b4.hi + S.hi * w4.hi);
    f32x2 e = S.lo * r4.lo + S.hi * r4.hi;
    y = row_allreduce16(e.x + e.y);
}

struct WkvOps { f32x4 r4, w4, m4, k4, b4; float v; };
__device__ __forceinline__ WkvOps wkv_load(const float* op, const float* vb) {
    WkvOps o;
    o.r4 = *(const f32x4*)(op + 0 * 64);
    o.w4 = *(const f32x4*)(op + 1 * 64);
    o.m4 = *(const f32x4*)(op + 2 * 64);
    o.k4 = *(const f32x4*)(op + 3 * 64);
    o.b4 = *(const f32x4*)(op + 4 * 64);
    o.v = *vb;
    return o;
}
struct WkvOpsS { f32x4 r4, m4, k4, b4; float v; };
__device__ __forceinline__ WkvOpsS wkv_load_s(const float* op, const float* vb) {
    WkvOpsS o;
    o.r4 = *(const f32x4*)(op + 0 * 64);
    o.m4 = *(const f32x4*)(op + 2 * 64);
    o.k4 = *(const f32x4*)(op + 3 * 64);
    o.b4 = *(const f32x4*)(op + 4 * 64);
    o.v = *vb;
    return o;
}
__device__ __forceinline__ float wkv_step_part(WkvS& S, const WkvOpsS& o, const f32x4& rprev) {
    f32x2 d = S.lo * o.k4.lo + S.hi * o.k4.hi;
    float s = d.x + d.y;
    const f32x2 vv = {o.v, o.v};
    f32x2 q = S.lo * rprev.lo + S.hi * rprev.hi;
    const f32x2 tl = vv * o.m4.lo + S.lo;
    const f32x2 th = vv * o.m4.hi + S.hi;
    s = row_allreduce16(s);
    const f32x2 nsk = {-s, -s};
    S.lo = nsk * o.b4.lo + tl;
    S.hi = nsk * o.b4.hi + th;
    return q.x + q.y;
}

__device__ __forceinline__ void wkv_step_pipe(WkvS& S, const WkvOps& o, float& eprev, float& enew) {
    f32x2 d = S.lo * o.k4.lo + S.hi * o.k4.hi;
    float s = d.x + d.y, e = eprev;
    s += dpp_mov<0x128>(s); e += dpp_mov<0x128>(e);
    s += dpp_mov<0x124>(s); e += dpp_mov<0x124>(e);
    s += dpp_mov<0x122>(s); e += dpp_mov<0x122>(e);
    s += dpp_mov<0x121>(s); e += dpp_mov<0x121>(e);
    eprev = e;
    const f32x2 nsk = {-s, -s}, vv = {o.v, o.v};
    S.lo = vv * o.m4.lo + (nsk * o.b4.lo + S.lo * o.w4.lo);
    S.hi = vv * o.m4.hi + (nsk * o.b4.hi + S.hi * o.w4.hi);
    f32x2 q = S.lo * o.r4.lo + S.hi * o.r4.hi;
    enew = q.x + q.y;
}

__device__ __forceinline__ void phase4(const Params& p, int l, unsigned char* smem) {
    constexpr int OPS = 324;
    float* OP = (float*)smem;
    float* VB = OP + 2 * 16 * OPS;
    float* YB = VB + 2 * 16 * 16;
    float* VS = YB + 2 * 16 * 16 * 17;
    float* GE = VS + 16 * 64;
    const int tid = tid_(), lane = tid & 63, wave = tid >> 6;
    const hf* U = (const hf*)(p.ws + WS_U);
    const hf* EA = (const hf*)(p.ws + WS_EA);
    const hf* KKB = (const hf*)(p.ws + WS_H);
    hf* MIX = (hf*)(p.ws + WS_MIX);
    const float* mu = p.mu + (size_t)l * PRW;
    const int blk = blockIdx.x;
    const int xcd = blk & 7, idx = blk >> 3;
    const int rg = idx & 3;
    const int pbh = xcd * 8 + (idx >> 2);
    const int pb = pbh >> 3, ph = pbh & 7;
    const bool producer = wave >= 4;
    const int pw = wave & 3;
    const int rl = lane >> 4, ks = lane & 15;
    constexpr int NCHP = 2048 / 16;

    const int cl = lane >> 4, pt = lane & 15;
    const int c4 = pw * 16 + cl * 4;
    const int pcol = ph * 64 + c4;
    const f32x4 mur4 = *(const f32x4*)(mu + pcol), muv4 = *(const f32x4*)(mu + 1024 + pcol);
    const int tkp = pb * 2048 + pt;
    const hf* uc = U + (size_t)tkp * PIN + pcol;
    const hf* eac = EA + (size_t)tkp * D + pcol;
    const hf* kbc = KKB + (size_t)tkp * D + pcol;
    struct PQ { hf4 r, v, rp, vp, e, a, kk, bb; };
    PQ qA, qB;
    auto load_prompt = [&](int ci, PQ& q) {
        const hf* u = uc + (size_t)ci * (16 * PIN);
        q.r = *(const hf4*)u; q.v = *(const hf4*)(u + 1024);
        q.rp = *(const hf4*)(u - PIN); q.vp = *(const hf4*)(u - PIN + 1024);
        const hf* e_ = eac + (size_t)ci * (16 * D);
        q.e = *(const hf4*)e_; q.a = *(const hf4*)(e_ + 512);
        const hf* k_ = kbc + (size_t)ci * (16 * D);
        q.kk = *(const hf4*)k_; q.bb = *(const hf4*)(k_ + 512);
    };
    auto cvt4 = [](hf4 x) { return (f32x4){(float)x.x, (float)x.y, (float)x.z, (float)x.w}; };
    auto scan16 = [](float x) {
        x += dpp_mov<0x111>(x);
        x += dpp_mov<0x112>(x);
        x += dpp_mov<0x114>(x);
        x += dpp_mov<0x118>(x);
        return x;
    };
    auto store_prompt = [&](int ci, int buf, const PQ& q) {
        const float pmask = (ci == 0 && pt == 0) ? 0.f : 1.f;
        const f32x4 rc = cvt4(q.r), vc = cvt4(q.v);
        const f32x4 rp = cvt4(q.rp) * pmask, vp = cvt4(q.vp) * pmask;
        const f32x4 e = cvt4(q.e);
        const f32x4 r = rc + (rp - rc) * mur4, v = vc + (vp - vc) * muv4;
        f32x4 cum;
        cum.x = scan16(e.x); cum.y = scan16(e.y); cum.z = scan16(e.z); cum.w = scan16(e.w);
        const f32x4 cpv = cum - e;
        f32x4 gin, gout, gprev;
        gin.x = __expf(-cum.x); gin.y = __expf(-cum.y); gin.z = __expf(-cum.z); gin.w = __expf(-cum.w);
        gout.x = __expf(cum.x); gout.y = __expf(cum.y); gout.z = __expf(cum.z); gout.w = __expf(cum.w);
        gprev.x = __expf(-cpv.x); gprev.y = __expf(-cpv.y); gprev.z = __expf(-cpv.z); gprev.w = __expf(-cpv.w);
        float* op = OP + buf * (16 * OPS) + pt * OPS + c4;
        *(f32x4*)(op + 0 * 64) = r * gin;
        *(f32x4*)(op + 2 * 64) = cvt4(q.a) * gout;
        *(f32x4*)(op + 3 * 64) = cvt4(q.kk) * gprev;
        *(f32x4*)(op + 4 * 64) = cvt4(q.bb) * gout;
        if (pt == 15) *(f32x4*)(GE + buf * 64 + c4) = gin;
        if (pw == rg) *(f32x4*)(VB + buf * 256 + pt * 16 + cl * 4) = v;
    };
    auto flush_y = [&](int ci, int buf) {
        const int tok = pw * 4 + (lane >> 4), row = lane & 15;
        const float* yb = YB + buf * (16 * 16 * 17) + (tok * 16 + row) * 17;
        float y0 = 0.f, y1 = 0.f, y2 = 0.f, y3 = 0.f;
#pragma unroll
        for (int j = 0; j < 16; j += 4) { y0 += yb[j]; y1 += yb[j + 1]; y2 += yb[j + 2]; y3 += yb[j + 3]; }
        MIX[(size_t)(pb * 2048 + ci * 16 + tok) * D + ph * 64 + rg * 16 + row] = (hf)((y0 + y1) + (y2 + y3));
    };

    WkvS S; S.lo = (f32x2){0.f, 0.f}; S.hi = (f32x2){0.f, 0.f};
    if (producer) { load_prompt(0, qB); store_prompt(0, 0, qB); load_prompt(1, qA); load_prompt(2, qB); }
    __syncthreads();
    auto consume = [&](int buf) {
        const float* op = OP + buf * (16 * OPS) + ks * 4;
        const float* vb = VB + buf * 256 + pw * 4 + rl;
        float* yb = YB + buf * (16 * 16 * 17) + (pw * 4 + rl) * 17 + ks;
        WkvOpsS ring[4];
        ring[0] = wkv_load_s(op, vb);
        ring[1] = wkv_load_s(op + OPS, vb + 16);
        ring[2] = wkv_load_s(op + 2 * OPS, vb + 32);
        f32x4 rprev = {0.f, 0.f, 0.f, 0.f};
#pragma unroll
        for (int t = 0; t < 16; ++t) {
            if (t + 3 < 16) ring[(t + 3) & 3] = wkv_load_s(op + (t + 3) * OPS, vb + (t + 3) * 16);
            __builtin_amdgcn_sched_barrier(0);
            const float e = wkv_step_part(S, ring[t & 3], rprev);
            if (t > 0) yb[(t - 1) * (16 * 17)] = e;
            rprev = ring[t & 3].r4;
            __builtin_amdgcn_sched_barrier(0);
        }
        {
            f32x2 q = S.lo * rprev.lo + S.hi * rprev.hi;
            yb[15 * (16 * 17)] = q.x + q.y;
            const f32x4 ge = *(const f32x4*)(GE + buf * 64 + ks * 4);
            S.lo = S.lo * ge.lo;
            S.hi = S.hi * ge.hi;
        }
    };
#pragma unroll 1
    for (int ci = 0; ci < NCHP; ci += 2) {
        if (producer) {
            store_prompt(ci + 1, 1, qA);
            if (ci + 3 < NCHP) load_prompt(ci + 3, qA);
            if (ci >= 1) flush_y(ci - 1, 1);
        } else consume(0);
        __syncthreads();
        if (producer) {
            if (ci + 2 < NCHP) store_prompt(ci + 2, 0, qB);
            if (ci + 4 < NCHP) load_prompt(ci + 4, qB);
            flush_y(ci, 0);
        } else consume(1);
        __syncthreads();
    }

    f32x4 St[4][4];
    if (producer) {
        flush_y(NCHP - 1, (NCHP - 1) & 1);
        const int id = blk * 4 + pw, bs = id >> 3, h = id & 7;
        const int col = h * 64 + lane;
        const float smur = mu[col], smuk = mu[512 + col], smuv = mu[1024 + col], ska = p.k_a[l * 512 + col];
        const int tk0 = NTOKP + bs * 4;
        const hf* up = U + (size_t)(NTOK + bs) * PIN + col;
        float rp = (float)up[0], kp = (float)up[512], vp = (float)up[1024];
#pragma unroll
        for (int i = 0; i < 4; ++i) {
            const int tk = tk0 + i, t = pw * 4 + i;
            const hf* ut = U + (size_t)tk * PIN + col;
            const float rc = (float)ut[0], kc = (float)ut[512], vc = (float)ut[1024];
            const float e = (float)EA[(size_t)tk * D + col], a = (float)EA[(size_t)tk * D + 512 + col];
            const float kk = (float)KKB[(size_t)tk * D + col], bb = (float)KKB[(size_t)tk * D + 512 + col];
            OP[(t * 5 + 0) * 64 + lane] = rc + (rp - rc) * smur;
            OP[(t * 5 + 1) * 64 + lane] = __expf(-e);
            OP[(t * 5 + 2) * 64 + lane] = a;
            OP[(t * 5 + 3) * 64 + lane] = kk;
            OP[(t * 5 + 4) * 64 + lane] = bb;
            VS[t * 64 + lane] = vc + (vp - vc) * smuv;
            rp = rc; kp = kc; vp = vc;
        }
    } else {
        *(f32x4*)(p.out + O_WKV_P + ((((size_t)l * 8 + pb) * 8 + ph) * 64 + rg * 16 + pw * 4 + rl) * 64 + ks * 4) = (f32x4){S.lo.x, S.lo.y, S.hi.x, S.hi.y};
#pragma unroll
        for (int q = 0; q < 4; ++q) {
            const int id = blk * 4 + q, bs = id >> 3, h = id & 7;
#pragma unroll
            for (int g = 0; g < 4; ++g) {
                const int row = pw * 16 + g * 4 + rl;
                St[q][g] = *(const f32x4*)(p.state_wkv + ((((size_t)l * 128 + bs) * 8 + h) * 64 + row) * 64 + ks * 4);
            }
        }
    }
    __syncthreads();
    if (!producer) {
#pragma unroll
        for (int q = 0; q < 4; ++q) {
            const int id = blk * 4 + q, bs = id >> 3, h = id & 7;
#pragma unroll
            for (int g = 0; g < 4; ++g) {
                const int row = pw * 16 + g * 4 + rl;
                WkvS Sq; Sq.lo = St[q][g].lo; Sq.hi = St[q][g].hi;
                float ykeep = 0.f;
#pragma unroll
                for (int t = 0; t < 4; ++t) {
                    float y;
                    wkv_step(Sq, OP + ((q * 4 + t) * 5) * 64 + ks * 4, VS[(q * 4 + t) * 64 + row], y);
                    ykeep = (ks == t) ? y : ykeep;
                }
                *(f32x4*)(p.out + O_WKV_S + ((((size_t)l * 128 + bs) * 8 + h) * 64 + row) * 64 + ks * 4) = (f32x4){Sq.lo.x, Sq.lo.y, Sq.hi.x, Sq.hi.y};
                if (ks < 4) MIX[(size_t)(NTOKP + bs * 4 + ks) * D + h * 64 + row] = (hf)ykeep;
            }
        }
    }
    __syncthreads();
}

__device__ __forceinline__ void phase5a(const Params& p, int l, hf* DST = nullptr) {
    const int tid = tid_(); const int lane = tid & 63, wave = tid >> 6;
    const hf* U = (const hf*)(p.ws + WS_U);
    const hf* EA = (const hf*)(p.ws + WS_EA);
    hf* MIX = (hf*)(p.ws + WS_MIX);
    hf* OUT = DST ? DST : MIX;
    const float* mu = p.mu + (size_t)l * PRW;
    const int ti = lane >> 4, c4 = (lane & 15) * 4;
    struct It { hf4 uc[4], up[4], a, y; };
    constexpr int NIT = (NTOK / 4) * 8;
    const int stride = gridDim.x * 8;
    auto load = [&](int it, It& q) {
        const int tk = (it >> 3) * 4 + ti, col = (it & 7) * 64 + c4;
        const int pr = prev_row(tk);
        const hf* ut = U + (size_t)tk * PIN + col;
        const hf* up = U + (size_t)(pr >= 0 ? pr : 0) * PIN + col;
#pragma unroll
        for (int c = 0; c < 4; ++c) { if (c == 1) continue; q.uc[c] = *(const hf4*)(ut + 512 * c); q.up[c] = *(const hf4*)(up + 512 * c); }
        q.a = *(const hf4*)(EA + (size_t)tk * D + 512 + col);
        q.y = *(const hf4*)(MIX + (size_t)tk * D + col);
    };
    auto cvt4 = [](hf4 x) { return (f32x4){(float)x.x, (float)x.y, (float)x.z, (float)x.w}; };
    auto compute = [&](int it, const It& q) {
        const int tk = (it >> 3) * 4 + ti, col = (it & 7) * 64 + c4;
        const float pm = prev_row(tk) >= 0 ? 1.f : 0.f;
        const f32x4 mr = *(const f32x4*)(mu + col), mk = *(const f32x4*)(mu + 512 + col), mv = *(const f32x4*)(mu + 1024 + col), mg = *(const f32x4*)(mu + 1536 + col);
        const f32x4 ka = *(const f32x4*)(p.k_a + l * 512 + col), rk = *(const f32x4*)(p.r_k + l * 512 + col);
        const f32x4 gg = *(const f32x4*)(p.gn_r_g + l * 512 + col), gb = *(const f32x4*)(p.gn_r_b + l * 512 + col);
        const f32x4 rc = cvt4(q.uc[0]), vc = cvt4(q.uc[2]), gc = cvt4(q.uc[3]);
        const f32x4 r = rc + (cvt4(q.up[0]) * pm - rc) * mr;
        const f32x4 v = vc + (cvt4(q.up[2]) * pm - vc) * mv, g = gc + (cvt4(q.up[3]) * pm - gc) * mg;
        const f32x4 km = cvt4(q.a);
        const f32x4 y = cvt4(q.y);
        const f32x4 y2 = y * y, bo = r * km * rk;
        float s1 = (y.x + y.y) + (y.z + y.w), s2 = (y2.x + y2.y) + (y2.z + y2.w), s3 = (bo.x + bo.y) + (bo.z + bo.w);
        s1 = row_allreduce16(s1); s2 = row_allreduce16(s2); s3 = row_allreduce16(s3);
        const float mean = s1 * (1.f / 64.f);
        const float var = fmaxf(s2 * (1.f / 64.f) - mean * mean, 0.f);
        const float rs = rsqrtf(var + 64e-5f);
        const f32x4 yn = (y - mean) * rs * gg + gb;
        const f32x4 t = yn + s3 * v;
        hf4 o = {(hf)(t.x * silu(g.x)), (hf)(t.y * silu(g.y)), (hf)(t.z * silu(g.z)), (hf)(t.w * silu(g.w))};
        const u32x2 uo = __builtin_bit_cast(u32x2, o);
        const unsigned n0 = (unsigned)__builtin_amdgcn_update_dpp(0, (int)uo.x, 0x101, 0xf, 0xf, false);
        const unsigned n1 = (unsigned)__builtin_amdgcn_update_dpp(0, (int)uo.y, 0x101, 0xf, 0xf, false);
        if ((lane & 1) == 0) st16_wt(OUT + (size_t)tk * D + col, (u32x4){uo.x, uo.y, n0, n1});
    };
    It qa, qb;
    const int nr = NIT / stride, nfull = nr * stride;
    auto item_of = [&](int r) {
        if (r < nr) return (int)(blockIdx.x * 8 + wave) + r * stride;
        const int e = (wave + (r - nr) * 8) * (int)gridDim.x + (int)blockIdx.x;
        return e < NIT - nfull ? nfull + e : NIT;
    };
    int rn = 0;
    int it = item_of(0);
    if (it < NIT) load(it, qa);
    while (it < NIT) {
        const int nx = item_of(++rn);
        if (nx < NIT) load(nx, qb);
        compute(it, qa);
        qa = qb;
        it = nx;
    }
}

__device__ __forceinline__ void phase6(const Params& p) {
    const int tid = tid_(); const int lane = tid & 63, wave = tid >> 6;
    const float* MOD = (const float*)(p.ws + WS_MOD);
    struct Row { f32x4 x[4]; hf4 m0[4], m1[4]; };
    const int stride = gridDim.x * 8;
    auto load = [&](int tk, Row& q) {
        const float* xr = x0_row(p, tk);
        const hf* mo = (const hf*)(p.out + O_Y + (size_t)tk * D);
#pragma unroll
        for (int j = 0; j < 4; ++j) {
            q.x[j] = *(const f32x4*)(xr + 256 * j + 4 * lane);
            q.m0[j] = *(const hf4*)(mo + 256 * j + 4 * lane);
            q.m1[j] = *(const hf4*)(mo + 1024 + 256 * j + 4 * lane);
        }
    };
    Row qa, qb;
    auto tok_of = [&](int it) {
        if (it < NTOKP / stride) return (int)(blockIdx.x * 8 + wave) + it * stride;
        const int e = (wave + (it - NTOKP / stride) * 8) * (int)gridDim.x + (int)blockIdx.x;
        return e < NTOK - NTOKP ? NTOKP + e : NTOK;
    };
    int itn = 0;
    int tk = tok_of(0);
    if (tk < NTOK) load(tk, qa);
    while (tk < NTOK) {
        const int nx = tok_of(++itn);
        if (nx < NTOK) load(nx, qb);
        const int sq = seq_of(tk);
        float* yr = p.out + O_Y + (size_t)tk * D;
        f32x4 m0[4], m1[4];
        float s0 = 0.f, s1 = 0.f;
#pragma unroll
        for (int j = 0; j < 4; ++j) {
            m0[j] = (f32x4){(float)qa.m0[j].x, (float)qa.m0[j].y, (float)qa.m0[j].z, (float)qa.m0[j].w};
            m1[j] = (f32x4){(float)qa.m1[j].x, (float)qa.m1[j].y, (float)qa.m1[j].z, (float)qa.m1[j].w};
            s0 += m0[j].x * m0[j].x + m0[j].y * m0[j].y + m0[j].z * m0[j].z + m0[j].w * m0[j].w;
            s1 += m1[j].x * m1[j].x + m1[j].y * m1[j].y + m1[j].z * m1[j].z + m1[j].w * m1[j].w;
        }
        const float r0 = rsqrtf(wave_sum_all(s0) * (1.f / D) + 1e-6f);
        const float r1 = rsqrtf(wave_sum_all(s1) * (1.f / D) + 1e-6f);
#pragma unroll
        for (int j = 0; j < 4; ++j) {
            f32x4 gp0 = *(const f32x4*)(p.g_post + 256 * j + 4 * lane);
            f32x4 gp1 = *(const f32x4*)(p.g_post + D + 256 * j + 4 * lane);
            f32x4 gt0 = *(const f32x4*)(MOD + (size_t)sq * 6144 + 2048 + 256 * j + 4 * lane);
            f32x4 gt1 = *(const f32x4*)(MOD + (size_t)sq * 6144 + 3072 + 2048 + 256 * j + 4 * lane);
            f32x4 y = qa.x[j] + gt0 * (m0[j] * r0 * gp0);
            y = y + gt1 * (m1[j] * r1 * gp1);
            *(f32x4*)(yr + 256 * j + 4 * lane) = y;
        }
        qa = qb;
        tk = nx;
    }
}

constexpr int NPHASES = 14;
__device__ __forceinline__ void run_phase(const Params& p, int ph, unsigned char* smem) {
    if (ph == 0) { phase0(p, smem); return; }
    if (ph == 13) { phase6(p); return; }
    const int l = (ph - 1) / 6, s = (ph - 1) % 6;
    switch (s) {
        case 0: phase1(p, l); break;
        case 1: phase2(p, l, smem); break;
        case 2: phase3(p, l, smem); break;
        case 3: phase4(p, l, smem); break;
        case 4: phase5a(p, l); break;
        default: phase5b(p, l, smem); break;
    }
}

#define GSYNC() xcd_barrier(xb)
__global__ void __launch_bounds__(NTHR) fwd_mega(Params p) {
    extern __shared__ __attribute__((aligned(16))) unsigned char smem[];
    volatile LAS unsigned* st = (volatile LAS unsigned*)(smem + LDS_BYTES - 16);
    if (threadIdx.x == 0) { st[0] = 0u; st[1] = 0u; }
    __syncthreads();
    XcdBarrier xb = xcd_barrier_post((unsigned*)(p.ws + WS_BAR), st);
    if (p.ws == nullptr) cg::this_grid().sync();
    phase0(p, smem); GSYNC();
    phase1(p, 0); GSYNC();
    phase2(p, 0, smem); GSYNC();
    phase3(p, 0, smem); GSYNC();
    phase4(p, 0, smem); GSYNC();
    phase5a(p, 0); GSYNC();
    phase5b(p, 0, smem); GSYNC();
    phase1(p, 1); GSYNC();
    phase2(p, 1, smem); GSYNC();
    phase3(p, 1, smem); GSYNC();
    phase4(p, 1, smem); GSYNC();
    phase5a(p, 1); GSYNC();
    phase5b(p, 1, smem); GSYNC();
    phase6(p);
}
__global__ void __launch_bounds__(NTHR) fwd_phase(Params p, int ph) {
    extern __shared__ __attribute__((aligned(16))) unsigned char smem[];
    run_phase(p, ph, smem);
}

extern "C" void kernel_launch(void* const* d_in, const int* in_sizes, int n_in, void* d_out, int out_size, void* d_ws, size_t ws_size,
                              hipStream_t stream) {
    static int ok = 0;
    if (ok == 0) {
        ok = 1;
        if (n_in != 27 || (size_t)out_size != O_END || ws_size < WS_END) {
            fprintf(stderr, "kernel_launch: unexpected sizes n_in %d out %d ws %zu (need %zu)\n", n_in, out_size, ws_size, (size_t)WS_END);
            ok = -1;
        }
        int dev = 0, cus = 0, per_cu = 0;
        (void)hipGetDevice(&dev);
        (void)hipDeviceGetAttribute(&cus, hipDeviceAttributeMultiprocessorCount, dev);
        (void)hipFuncSetAttribute((const void*)fwd_mega, hipFuncAttributeMaxDynamicSharedMemorySize, LDS_BYTES);
        (void)hipFuncSetAttribute((const void*)fwd_phase, hipFuncAttributeMaxDynamicSharedMemorySize, LDS_BYTES);
        (void)hipOccupancyMaxActiveBlocksPerMultiprocessor(&per_cu, (const void*)fwd_mega, NTHR, LDS_BYTES);
        if (cus * per_cu < GRID) {
            fprintf(stderr, "kernel_launch: resident capacity %d x %d < grid %d\n", cus, per_cu, GRID);
            ok = -1;
        }
    }
    if (ok < 0) return;
    Params p{};
    const float** pp = (const float**)&p;
    for (int i = 0; i < 27; ++i) pp[i] = (const float*)d_in[i];
    p.out = (float*)d_out;
    p.ws = (unsigned char*)d_ws;
#if MULTI_LAUNCH
    for (int ph = 0; ph < NPHASES; ++ph) hipLaunchKernelGGL(fwd_phase, dim3(GRID), dim3(NTHR), LDS_BYTES, stream, p, ph);
#else
    (void)hipMemsetAsync((unsigned char*)d_ws + WS_BAR, 0, 16384, stream);
    void* args[] = {&p};
    hipError_t e = hipLaunchCooperativeKernel((const void*)fwd_mega, dim3(GRID), dim3(NTHR), args, LDS_BYTES, stream);
    if (e != hipSuccess) fprintf(stderr, "cooperative launch failed: %s\n", hipGetErrorString(e));
#endif
}
```
